# Optimizing an MI355X kernel written in HIP

```python
import jax, jax.numpy as jnp
from jax import lax
import numpy as np

D_MODEL = 1024
BATCH = 2
SEQ = 8192
DEPTH = 1

RWKV_HEADS = 8
RWKV_HEAD_DIM = 64
RWKV_WIDTH = RWKV_HEADS * RWKV_HEAD_DIM
W_LORA = 64
A_LORA = 64
G_LORA = 128
GN_EPS = 64e-5
NSA_HEADS = 8
NSA_KV_GROUPS = 2
NSA_HEADS_PER_GROUP = NSA_HEADS // NSA_KV_GROUPS
NSA_HEAD_DIM = 64
NSA_WIDTH = NSA_HEADS * NSA_HEAD_DIM
NSA_KV_WIDTH = NSA_KV_GROUPS * NSA_HEAD_DIM
CMP_BLOCK = 32
CMP_STRIDE = 16
CMP_HIDDEN = 256
SEL_BLOCK = 64
N_SELECT = 16
WINDOW = 512
Q_BLOCK = 128
ROPE_THETA = 10000.0
RWKV_IN_W = 3 * RWKV_WIDTH + W_LORA + A_LORA + G_LORA
NSA_IN_W = NSA_WIDTH + 6 * NSA_KV_WIDTH + 3 * NSA_HEADS
IN_W = RWKV_IN_W + NSA_IN_W + 2 * D_MODEL
N_EXPERTS = 256
TOP_K = 8
N_GROUPS = 8
TOPK_GROUPS = 4
EXPERT_DIM = 256
SHARED_DIM = 256
ROUTED_SCALE = 2.5
MOE_BLOCK = 128
LN_EPS = 1e-5
DEEPNORM_ALPHA = (2 * DEPTH) ** 0.25
DEEPNORM_BETA = (8 * DEPTH) ** -0.25
NEG_INF = -1e30
FORCE_BONUS = 1e4

kernel_name = "rwkv7_nsa_gated_hybrid_moe_deepnorm"


def layer_norm(x, g, b):
    xf = x.astype(jnp.float32)
    mu = xf.mean(-1, keepdims=True)
    var = jnp.square(xf - mu).mean(-1, keepdims=True)
    return ((xf - mu) * lax.rsqrt(var + LN_EPS) * g + b).astype(x.dtype)


def rope(x, pos):
    half = x.shape[-1] // 2
    inv = ROPE_THETA ** (-jnp.arange(half, dtype=jnp.float32) / half)
    ang = pos.astype(jnp.float32)[:, None] * inv
    cos = jnp.cos(ang)[:, None, :]
    sin = jnp.sin(ang)[:, None, :]
    x1 = x[..., :half].astype(jnp.float32)
    x2 = x[..., half:].astype(jnp.float32)
    return jnp.concatenate([x1 * cos - x2 * sin, x2 * cos + x1 * sin], -1).astype(x.dtype)


def masked_softmax(s, mask):
    return jax.nn.softmax(jnp.where(mask, s, NEG_INF), axis=-1) * mask


def swiglu(h, w_gu, w_down):
    gate, up = jnp.split(h @ w_gu, 2, axis=-1)
    return (jax.nn.silu(gate) * up) @ w_down


def rwkv7_time_mix(p, mu, w0, w2, a0, a2, g2, k_k, k_a, r_k, lnx_w, lnx_b):
    B_, S_, _ = p.shape
    H, N = RWKV_HEADS, RWKV_HEAD_DIM
    f32 = jnp.float32
    prev = jnp.pad(p[:, :-1], ((0, 0), (1, 0), (0, 0)))
    p = p + (prev - p) * mu
    cut = [RWKV_WIDTH, 2 * RWKV_WIDTH, 3 * RWKV_WIDTH, 3 * RWKV_WIDTH + W_LORA, 3 * RWKV_WIDTH + W_LORA + A_LORA]
    r, k, v, wl, al, gl = jnp.split(p, cut, axis=-1)
    w = -jax.nn.softplus(-(w0 + jnp.tanh(wl) @ w2)) - 0.5
    a = jax.nn.sigmoid(a0 + al @ a2)
    g = jax.nn.sigmoid(gl) @ g2
    hs = lambda t: t.reshape(B_, S_, H, N).astype(f32)
    r, w, k, v, a = hs(r), hs(w), hs(k), hs(v), hs(a)
    kk = k * k_k.reshape(H, N).astype(f32)
    kk = kk / jnp.maximum(jnp.linalg.norm(kk, axis=-1, keepdims=True), 1e-12)
    k = k * (1.0 + (a - 1.0) * k_a.reshape(H, N).astype(f32))
    decay = jnp.exp(-jnp.exp(w))

    def step(state, inp):
        r_t, d_t, k_t, v_t, kk_t, b_t = inp
        sa = jnp.einsum('bhvk,bhk->bhv', state, -kk_t)
        state = (state * d_t[:, :, None, :] + sa[..., None] * b_t[:, :, None, :]
                 + v_t[..., None] * k_t[:, :, None, :])
        return state, jnp.einsum('bhvk,bhk->bhv', state, r_t)

    xs = tuple(jnp.moveaxis(t, 1, 0) for t in (r, decay, k, v, kk, kk * a))
    _, o = lax.scan(step, jnp.zeros((B_, H, N, N), f32), xs)
    o = jnp.moveaxis(o, 0, 1)
    m = o.mean(-1, keepdims=True)
    var = jnp.square(o - m).mean(-1, keepdims=True)
    o = ((o - m) * lax.rsqrt(var + GN_EPS)).reshape(B_, S_, RWKV_WIDTH) * lnx_w + lnx_b
    bonus = (r * k * r_k.astype(f32)).sum(-1, keepdims=True) * v
    o = (o + bonus.reshape(B_, S_, RWKV_WIDTH)) * g.astype(f32)
    return o.astype(p.dtype)


def compress_blocks(t, pe, w1, w2):
    B_, S_, G_, Dh = t.shape
    sub = t.reshape(B_, S_ // CMP_STRIDE, CMP_STRIDE, G_, Dh)
    n_sub = CMP_BLOCK // CMP_STRIDE
    n_cmp = S_ // CMP_STRIDE - n_sub + 1
    blocks = jnp.concatenate([sub[:, i:i + n_cmp] for i in range(n_sub)], axis=2)
    blocks = blocks + pe[None, None, :, None, :]
    blocks = blocks.transpose(0, 1, 3, 2, 4).reshape(B_, n_cmp, G_, CMP_BLOCK * Dh)
    return jax.nn.gelu(blocks @ w1) @ w2


def nsa_attention(p, pe_k, w1_k, w2_k, pe_v, w1_v, w2_v):
    B_, S_, _ = p.shape
    G, HPG, HD = NSA_KV_GROUPS, NSA_HEADS_PER_GROUP, NSA_HEAD_DIM
    f32 = jnp.float32
    cut = [NSA_WIDTH + i * NSA_KV_WIDTH for i in range(7)]
    q, kc_raw, vc_raw, ks, vs, kw, vw, gates = jnp.split(p, cut, axis=-1)
    pos = jnp.arange(S_)
    kv = lambda t: t.reshape(B_, S_, G, HD)
    q = rope(q.reshape(B_, S_, NSA_HEADS, HD), pos)
    ks, kw = rope(kv(ks), pos), rope(kv(kw), pos)
    vs, vw = kv(vs), kv(vw)
    n_sub = CMP_BLOCK // CMP_STRIDE
    n_cmp = S_ // CMP_STRIDE - n_sub + 1
    cmp_end = jnp.arange(n_cmp) * CMP_STRIDE + CMP_BLOCK - 1
    kc = rope(compress_blocks(kv(kc_raw), pe_k, w1_k, w2_k), cmp_end)
    vc = compress_blocks(kv(vc_raw), pe_v, w1_v, w2_v)
    n_sel = S_ // SEL_BLOCK
    ratio = SEL_BLOCK // CMP_STRIDE
    ci = jnp.arange(n_cmp)[:, None]
    sj = jnp.arange(n_sel)[None, :]
    cmp_to_sel = sum(((ci + n) // ratio == sj).astype(f32) for n in range(n_sub))
    n_pick = min(N_SELECT, n_sel)
    ks_t = ks.reshape(B_, n_sel, SEL_BLOCK, G, HD).transpose(0, 3, 1, 2, 4)
    vs_t = vs.reshape(B_, n_sel, SEL_BLOCK, G, HD).transpose(0, 3, 1, 2, 4)
    kw_pad = jnp.pad(kw, ((0, 0), (WINDOW, 0), (0, 0), (0, 0)))
    vw_pad = jnp.pad(vw, ((0, 0), (WINDOW, 0), (0, 0), (0, 0)))
    b_ix = jnp.arange(B_)[:, None, None, None]
    g_ix = jnp.arange(G)[None, :, None, None]
    scale = HD ** -0.5
    n_qb = S_ // Q_BLOCK
    qg = q.reshape(B_, n_qb, Q_BLOCK, G, HPG, HD).transpose(1, 0, 2, 3, 4, 5)
    gg = jax.nn.sigmoid(gates.astype(f32)).reshape(B_, n_qb, Q_BLOCK, G, HPG, 3).transpose(1, 0, 2, 3, 4, 5)

    def query_block(args):
        qb, q_blk, g_blk = args
        t = qb * Q_BLOCK + jnp.arange(Q_BLOCK)
        s = jnp.einsum('bqgnd,bcgd->bgnqc', q_blk, kc, preferred_element_type=f32) * scale
        p_c = masked_softmax(s, cmp_end[None, :] <= t[:, None])
        o_c = jnp.einsum('bgnqc,bcgd->bqgnd', p_c.astype(vc.dtype), vc)
        imp = jnp.einsum('bgnqc,cj->bgqj', p_c, cmp_to_sel)
        j = jnp.arange(n_sel)[None, :]
        cur = (t // SEL_BLOCK)[:, None]
        valid = j * SEL_BLOCK <= t[:, None]
        forced = ((j == 0) | (j == cur) | (j == cur - 1)).astype(f32)
        score = jnp.where(valid, imp + FORCE_BONUS * forced, -1.0)
        val, idx = lax.top_k(score, n_pick)
        ks_g = ks_t[b_ix, g_ix, idx]
        vs_g = vs_t[b_ix, g_ix, idx]
        key_pos = idx[..., None] * SEL_BLOCK + jnp.arange(SEL_BLOCK)
        m_s = (val >= 0.0)[..., None] & (key_pos <= t[None, None, :, None, None])
        s = jnp.einsum('bqgnd,bgqkld->bgnqkl', q_blk, ks_g, preferred_element_type=f32) * scale
        p_s = masked_softmax(s.reshape(B_, G, HPG, Q_BLOCK, n_pick * SEL_BLOCK),
                             m_s.reshape(B_, G, 1, Q_BLOCK, n_pick * SEL_BLOCK))
        p_s = p_s.reshape(B_, G, HPG, Q_BLOCK, n_pick, SEL_BLOCK)
        o_s = jnp.einsum('bgnqkl,bgqkld->bqgnd', p_s.astype(vs.dtype), vs_g)
        kwb = lax.dynamic_slice_in_dim(kw_pad, qb * Q_BLOCK, WINDOW + Q_BLOCK, axis=1)
        vwb = lax.dynamic_slice_in_dim(vw_pad, qb * Q_BLOCK, WINDOW + Q_BLOCK, axis=1)
        s_pos = qb * Q_BLOCK - WINDOW + jnp.arange(WINDOW + Q_BLOCK)
        d = t[:, None] - s_pos[None, :]
        m_w = (d >= 0) & (d < WINDOW) & (s_pos[None, :] >= 0)
        s = jnp.einsum('bqgnd,bkgd->bgnqk', q_blk, kwb, preferred_element_type=f32) * scale
        p_w = masked_softmax(s, m_w)
        o_w = jnp.einsum('bgnqk,bkgd->bqgnd', p_w.astype(vw.dtype), vwb)
        return g_blk[..., 0:1] * o_c + g_blk[..., 1:2] * o_s + g_blk[..., 2:3] * o_w

    o = lax.map(query_block, (jnp.arange(n_qb), qg, gg))
    return o.transpose(1, 0, 2, 3, 4, 5).reshape(B_, S_, NSA_WIDTH).astype(p.dtype)


def moe_ffn(x, router_w, router_bias, w_gu, w_down, sw_gu, sw_down):
    B_, S_, D_ = x.shape
    T = B_ * S_
    f32 = jnp.float32
    xf = x.reshape(T, D_)
    scores = jax.nn.sigmoid(jnp.matmul(xf, router_w, preferred_element_type=f32))
    choice = scores + router_bias.astype(f32)
    grp_score = lax.top_k(choice.reshape(T, N_GROUPS, N_EXPERTS // N_GROUPS), 2)[0].sum(-1)
    _, gidx = lax.top_k(grp_score, TOPK_GROUPS)
    gmask = jax.nn.one_hot(gidx, N_GROUPS, dtype=f32).sum(-2) > 0
    emask = jnp.repeat(gmask, N_EXPERTS // N_GROUPS, axis=-1)
    _, eidx = lax.top_k(jnp.where(emask, choice, NEG_INF), TOP_K)
    wts = jnp.take_along_axis(scores, eidx, axis=-1)
    wts = wts / wts.sum(-1, keepdims=True) * ROUTED_SCALE
    n_assign = T * TOP_K
    flat_e = eidx.reshape(-1)
    flat_tok = jnp.repeat(jnp.arange(T, dtype=jnp.int32), TOP_K)
    flat_w = wts.reshape(-1)
    counts = jnp.zeros(N_EXPERTS, jnp.int32).at[flat_e].add(1)
    padded = (counts + MOE_BLOCK - 1) // MOE_BLOCK * MOE_BLOCK
    pad_end = jnp.cumsum(padded)
    pad_start = pad_end - padded
    start = jnp.cumsum(counts) - counts
    order = jnp.argsort(flat_e)
    se = flat_e[order]
    dest = pad_start[se] + jnp.arange(n_assign, dtype=jnp.int32) - start[se]
    n_rows = n_assign + N_EXPERTS * MOE_BLOCK
    n_blocks = n_rows // MOE_BLOCK
    row_tok = jnp.zeros(n_rows, jnp.int32).at[dest].set(flat_tok[order])
    row_w = jnp.zeros(n_rows, f32).at[dest].set(flat_w[order])
    blk_e = jnp.minimum(jnp.searchsorted(pad_end, jnp.arange(n_blocks, dtype=jnp.int32) * MOE_BLOCK, side='right'),
                        N_EXPERTS - 1)

    def expert_block(args):
        tok, w, e = args
        return swiglu(xf[tok], w_gu[e], w_down[e]).astype(f32) * w[:, None]

    ys = lax.map(expert_block, (row_tok.reshape(n_blocks, MOE_BLOCK), row_w.reshape(n_blocks, MOE_BLOCK), blk_e))
    routed = jax.ops.segment_sum(ys.reshape(n_rows, D_), row_tok, num_segments=T)
    shared = swiglu(xf, sw_gu, sw_down).astype(f32)
    return (routed + shared).reshape(B_, S_, D_).astype(x.dtype)


def hybrid_mixer(x, w_in, tshift_mu, rwkv_w0, rwkv_w2, rwkv_a0, rwkv_a2, rwkv_g2, rwkv_k_k, rwkv_k_a,
                 rwkv_r_k, rwkv_lnx_w, rwkv_lnx_b, cmp_pe_k, cmp_w1_k, cmp_w2_k, cmp_pe_v, cmp_w1_v,
                 cmp_w2_v, w_branch_a, w_branch_b, w_out):
    p = x @ w_in
    p_a, p_b, p_g = jnp.split(p, [RWKV_IN_W, RWKV_IN_W + NSA_IN_W], axis=-1)
    y_a = rwkv7_time_mix(p_a, tshift_mu, rwkv_w0, rwkv_w2, rwkv_a0, rwkv_a2, rwkv_g2, rwkv_k_k,
                         rwkv_k_a, rwkv_r_k, rwkv_lnx_w, rwkv_lnx_b) @ w_branch_a
    y_b = nsa_attention(p_b, cmp_pe_k, cmp_w1_k, cmp_w2_k, cmp_pe_v, cmp_w1_v, cmp_w2_v) @ w_branch_b
    g_a, g_b = jnp.split(jax.nn.sigmoid(p_g), 2, axis=-1)
    return (g_a * y_a + g_b * y_b) @ w_out


def setup_inputs(seed: int = 0) -> dict:
    key = jax.random.key(seed)
    keys = iter(jax.random.split(key, 40))
    f32 = jnp.float32
    L = DEPTH
    nrm = lambda shape, s: jax.random.normal(next(keys), shape, f32) * s
    return {
        "x": nrm((BATCH, SEQ, D_MODEL), 1.0),
        "w_in": nrm((L, D_MODEL, IN_W), D_MODEL ** -0.5),
        "tshift_mu": jax.random.uniform(next(keys), (L, RWKV_IN_W), f32),
        "rwkv_w0": jax.random.uniform(next(keys), (L, RWKV_WIDTH), f32, -6.0, -1.0),
        "rwkv_w2": nrm((L, W_LORA, RWKV_WIDTH), 0.1 * W_LORA ** -0.5),
        "rwkv_a0": nrm((L, RWKV_WIDTH), 0.1),
        "rwkv_a2": nrm((L, A_LORA, RWKV_WIDTH), 0.1 * A_LORA ** -0.5),
        "rwkv_g2": nrm((L, G_LORA, RWKV_WIDTH), G_LORA ** -0.5),
        "rwkv_k_k": 0.85 + nrm((L, RWKV_WIDTH), 0.02),
        "rwkv_k_a": 1.0 + nrm((L, RWKV_WIDTH), 0.02),
        "rwkv_r_k": nrm((L, RWKV_HEADS, RWKV_HEAD_DIM), 0.1),
        "rwkv_lnx_w": 1.0 + nrm((L, RWKV_WIDTH), 0.02),
        "rwkv_lnx_b": nrm((L, RWKV_WIDTH), 0.02),
        "cmp_pe_k": nrm((L, CMP_BLOCK, NSA_HEAD_DIM), 0.02),
        "cmp_w1_k": nrm((L, CMP_BLOCK * NSA_HEAD_DIM, CMP_HIDDEN), (CMP_BLOCK * NSA_HEAD_DIM) ** -0.5),
        "cmp_w2_k": nrm((L, CMP_HIDDEN, NSA_HEAD_DIM), CMP_HIDDEN ** -0.5),
        "cmp_pe_v": nrm((L, CMP_BLOCK, NSA_HEAD_DIM), 0.02),
        "cmp_w1_v": nrm((L, CMP_BLOCK * NSA_HEAD_DIM, CMP_HIDDEN), (CMP_BLOCK * NSA_HEAD_DIM) ** -0.5),
        "cmp_w2_v": nrm((L, CMP_HIDDEN, NSA_HEAD_DIM), CMP_HIDDEN ** -0.5),
        "w_branch_a": nrm((L, RWKV_WIDTH, D_MODEL), RWKV_WIDTH ** -0.5),
        "w_branch_b": nrm((L, NSA_WIDTH, D_MODEL), NSA_WIDTH ** -0.5),
        "w_out": nrm((L, D_MODEL, D_MODEL), DEEPNORM_BETA * D_MODEL ** -0.5),
        "ln1_g": 1.0 + nrm((L, D_MODEL), 0.02),
        "ln1_b": nrm((L, D_MODEL), 0.02),
        "router_w": nrm((L, D_MODEL, N_EXPERTS), D_MODEL ** -0.5),
        "router_bias": nrm((L, N_EXPERTS), 0.01),
        "exp_w_gu": nrm((L, N_EXPERTS, D_MODEL, 2 * EXPERT_DIM), D_MODEL ** -0.5),
        "exp_w_down": nrm((L, N_EXPERTS, EXPERT_DIM, D_MODEL), DEEPNORM_BETA * EXPERT_DIM ** -0.5),
        "shared_w_gu": nrm((L, D_MODEL, 2 * SHARED_DIM), D_MODEL ** -0.5),
        "shared_w_down": nrm((L, SHARED_DIM, D_MODEL), DEEPNORM_BETA * SHARED_DIM ** -0.5),
        "ln2_g": 1.0 + nrm((L, D_MODEL), 0.02),
        "ln2_b": nrm((L, D_MODEL), 0.02),
    }


def reference(x, w_in, tshift_mu, rwkv_w0, rwkv_w2, rwkv_a0, rwkv_a2, rwkv_g2, rwkv_k_k, rwkv_k_a,
              rwkv_r_k, rwkv_lnx_w, rwkv_lnx_b, cmp_pe_k, cmp_w1_k, cmp_w2_k, cmp_pe_v, cmp_w1_v, cmp_w2_v,
              w_branch_a, w_branch_b, w_out, ln1_g, ln1_b, router_w, router_bias, exp_w_gu, exp_w_down,
              shared_w_gu, shared_w_down, ln2_g, ln2_b):
    for l in range(DEPTH):
        mix = hybrid_mixer(x, w_in[l], tshift_mu[l], rwkv_w0[l], rwkv_w2[l], rwkv_a0[l], rwkv_a2[l],
                           rwkv_g2[l], rwkv_k_k[l], rwkv_k_a[l], rwkv_r_k[l], rwkv_lnx_w[l], rwkv_lnx_b[l],
                           cmp_pe_k[l], cmp_w1_k[l], cmp_w2_k[l], cmp_pe_v[l], cmp_w1_v[l], cmp_w2_v[l],
                           w_branch_a[l], w_branch_b[l], w_out[l])
        x = layer_norm(DEEPNORM_ALPHA * x + mix, ln1_g[l], ln1_b[l])
        ffn = moe_ffn(x, router_w[l], router_bias[l], exp_w_gu[l], exp_w_down[l], shared_w_gu[l], shared_w_down[l])
        x = layer_norm(DEEPNORM_ALPHA * x + ffn, ln2_g[l], ln2_b[l])
    return x
```

```cpp
#include <hip/hip_runtime.h>
#include <hip/hip_cooperative_groups.h>
#include <cstdio>
#include <cstdint>
#include <cmath>

namespace {

constexpr int NB = 2, S = 8192, T = NB * S, D = 1024, INW = 5144;
constexpr int C_R = 0, C_K = 512, C_V = 1024, C_WL = 1536, C_AL = 1600, C_GL = 1664, RW_IN = 1792;
constexpr int C_Q = 1792, C_KC = 2304, C_VC = 2432, C_KS = 2560, C_VS = 2688, C_KW = 2816, C_VW = 2944, C_GT = 3072;
constexpr int C_GA = 3096, C_GB = 4120;
constexpr int NCMP = 511, NCROWS = NB * NCMP * 2;
constexpr int NE = 256, TOPK = 8, LISTCAP = 16384;
constexpr float ALPHA = 1.189207115002721f;
constexpr int NT = 256;

struct Params {
    const float *x, *w_in, *mu, *w0, *w2, *a0, *a2, *g2, *k_k, *k_a, *r_k, *lnx_w, *lnx_b;
    const float *pe_k, *w1_k, *w2_k, *pe_v, *w1_v, *w2_v, *wba, *wbb, *wout, *ln1g, *ln1b;
    const float *rw, *rbias, *egu, *edown, *sgu, *sdown, *ln2g, *ln2b;
    float* out;
    float *P, *R, *DC, *K2, *V, *KK, *BB, *G, *O, *YA, *QR, *KSR, *KWR, *KCraw, *KCR, *VC, *H1K, *H1V, *YB, *Z, *PRE1, *X1;
    float *LOGITS, *EW, *HGU, *Y, *HS, *SH;
    int *EIDX, *LIST, *CNT;
    int pad_[2];
};

__device__ __forceinline__ float wave_sum(float v) {
#pragma unroll
    for (int o = 1; o < 64; o <<= 1) v += __shfl_xor(v, o);
    return v;
}
__device__ __forceinline__ float wave_max(float v) {
#pragma unroll
    for (int o = 1; o < 64; o <<= 1) v = fmaxf(v, __shfl_xor(v, o));
    return v;
}
__device__ __forceinline__ float sigmoidf_(float x) { return 1.0f / (1.0f + expf(-x)); }
__device__ __forceinline__ float gelu_tanh(float x) { return 0.5f * x * (1.0f + tanhf(0.7978845608028654f * (x + 0.044715f * x * x * x))); }

template <class AL, class BL, class EP>
__device__ __forceinline__ void sgemm_unit(float* sm, int K, const AL& aload, const BL& bload, const EP& epi) {
    float (*As)[68] = (float (*)[68])sm;
    float (*Bs)[68] = (float (*)[68])(sm + 16 * 68);
    const int tid = threadIdx.x, ty = tid >> 4, tx = tid & 15;
    const int arow = tid >> 2, ak = (tid & 3) * 4, bk = tid >> 4, bn = (tid & 15) * 4;
    float acc[4][4];
#pragma unroll
    for (int i = 0; i < 4; ++i)
#pragma unroll
        for (int j = 0; j < 4; ++j) acc[i][j] = 0.f;
    for (int k0 = 0; k0 < K; k0 += 16) {
        const float4 av = aload(arow, k0 + ak);
        const float4 bv = bload(k0 + bk, bn);
        __syncthreads();
        As[ak + 0][arow] = av.x; As[ak + 1][arow] = av.y; As[ak + 2][arow] = av.z; As[ak + 3][arow] = av.w;
        *(float4*)&Bs[bk][bn] = bv;
        __syncthreads();
#pragma unroll
        for (int k = 0; k < 16; ++k) {
            const float4 a = *(const float4*)&As[k][ty * 4];
            const float4 b = *(const float4*)&Bs[k][tx * 4];
            acc[0][0] += a.x * b.x; acc[0][1] += a.x * b.y; acc[0][2] += a.x * b.z; acc[0][3] += a.x * b.w;
            acc[1][0] += a.y * b.x; acc[1][1] += a.y * b.y; acc[1][2] += a.y * b.z; acc[1][3] += a.y * b.w;
            acc[2][0] += a.z * b.x; acc[2][1] += a.z * b.y; acc[2][2] += a.z * b.z; acc[2][3] += a.z * b.w;
            acc[3][0] += a.w * b.x; acc[3][1] += a.w * b.y; acc[3][2] += a.w * b.z; acc[3][3] += a.w * b.w;
        }
    }
#pragma unroll
    for (int i = 0; i < 4; ++i) epi(ty * 4 + i, tx * 4, make_float4(acc[i][0], acc[i][1], acc[i][2], acc[i][3]));
}

template <class EP>
__device__ __forceinline__ void dense_gemm_phase(float* sm, int bid, int nb, const float* A, int lda, const float* B, int ldb, int M, int N, int K, const EP& epi) {
    const int ntn = (N + 63) / 64, nu = (M / 64) * ntn;
    for (int u = bid; u < nu; u += nb) {
        const int m0 = (u / ntn) * 64, n0 = (u % ntn) * 64;
        auto al = [&](int m, int k) { return *(const float4*)(A + (size_t)(m0 + m) * lda + k); };
        auto bl = [&](int k, int n) { return (n0 + n < N) ? *(const float4*)(B + (size_t)k * ldb + n0 + n) : make_float4(0.f, 0.f, 0.f, 0.f); };
        auto ep = [&](int m, int n, float4 v) { if (n0 + n < N) epi(m0 + m, n0 + n, v); };
        sgemm_unit(sm, K, al, bl, ep);
    }
}

__device__ void ph_inproj(const Params& p, float* sm, int bid, int nb) {
    float* P = p.P;
    dense_gemm_phase(sm, bid, nb, p.x, D, p.w_in, INW, T, INW, D, [=](int r, int c, float4 v) { *(float4*)(P + (size_t)r * INW + c) = v; });
}

__device__ void ph_rwkv_prep(const Params& p, float* sm, int bid, int nb) {
    float* xs = sm;
    float* th = sm + 1792;
    float* al = th + 64;
    float* sg = al + 64;
    const int tid = threadIdx.x;
    for (int t = bid; t < T; t += nb) {
        const int s = t & (S - 1);
        __syncthreads();
        for (int c = tid; c < RW_IN; c += NT) {
            const float cur = p.P[(size_t)t * INW + c];
            const float prev = (s > 0) ? p.P[(size_t)(t - 1) * INW + c] : 0.f;
            xs[c] = cur + (prev - cur) * p.mu[c];
        }
        __syncthreads();
        if (tid < 64) { th[tid] = tanhf(xs[C_WL + tid]); al[tid] = xs[C_AL + tid]; }
        if (tid < 128) sg[tid] = sigmoidf_(xs[C_GL + tid]);
        __syncthreads();
#pragma unroll 1
        for (int slot = 0; slot < 2; ++slot) {
            const int c = tid + slot * 256;
            float accw = 0.f, acca = 0.f, accg = 0.f;
#pragma unroll 4
            for (int j = 0; j < 64; ++j) { accw += th[j] * p.w2[j * 512 + c]; acca += al[j] * p.a2[j * 512 + c]; }
#pragma unroll 4
            for (int j = 0; j < 128; ++j) accg += sg[j] * p.g2[j * 512 + c];
            accw += p.w0[c]; acca += p.a0[c];
            const float nx = -accw;
            const float sp = (nx > 20.f) ? nx : log1pf(expf(nx));
            const float w = -sp - 0.5f;
            const float decay = expf(-expf(w));
            const float a = sigmoidf_(acca);
            const float kraw = xs[C_K + c];
            const float kkv = kraw * p.k_k[c];
            const float ss = wave_sum(kkv * kkv);
            const float nrm = fmaxf(sqrtf(ss), 1e-12f);
            const float kkn = kkv / nrm;
            const float k2 = kraw * (1.0f + (a - 1.0f) * p.k_a[c]);
            const size_t o = (size_t)t * 512 + c;
            p.R[o] = xs[C_R + c]; p.DC[o] = decay; p.K2[o] = k2; p.V[o] = xs[C_V + c]; p.KK[o] = kkn; p.BB[o] = kkn * a; p.G[o] = accg;
        }
    }
}

constexpr int SCH = 32;
__device__ void ph_scan(const Params& p, float* sm, int bid, int nb) {
    float* sr = sm;
    float* sd = sr + SCH * 64;
    float* sk = sd + SCH * 64;
    float* skk = sk + SCH * 64;
    float* sb = skk + SCH * 64;
    float* sv = sb + SCH * 64;
    float* so = sv + SCH * 16;
    const int tid = threadIdx.x, row = tid >> 4, q = tid & 15;
    for (int item = bid; item < 64; item += nb) {
        const int b = item >> 5, h = (item >> 2) & 7, qu = item & 3;
        float s0 = 0.f, s1 = 0.f, s2 = 0.f, s3 = 0.f;
        for (int t0 = 0; t0 < S; t0 += SCH) {
            __syncthreads();
            for (int i = tid; i < SCH * 16; i += NT) {
                const int st = i >> 4, part = i & 15;
                const size_t g = ((size_t)(b * S + t0 + st)) * 512 + h * 64 + part * 4;
                *(float4*)(sr + st * 64 + part * 4) = *(const float4*)(p.R + g);
                *(float4*)(sd + st * 64 + part * 4) = *(const float4*)(p.DC + g);
                *(float4*)(sk + st * 64 + part * 4) = *(const float4*)(p.K2 + g);
                *(float4*)(skk + st * 64 + part * 4) = *(const float4*)(p.KK + g);
                *(float4*)(sb + st * 64 + part * 4) = *(const float4*)(p.BB + g);
            }
            for (int i = tid; i < SCH * 16; i += NT) {
                const int st = i >> 4, r = i & 15;
                sv[i] = p.V[((size_t)(b * S + t0 + st)) * 512 + h * 64 + qu * 16 + r];
            }
            __syncthreads();
            for (int st = 0; st < SCH; ++st) {
                const float4 kk = *(const float4*)(skk + st * 64 + q * 4);
                const float4 dd = *(const float4*)(sd + st * 64 + q * 4);
                const float4 kv = *(const float4*)(sk + st * 64 + q * 4);
                const float4 bb = *(const float4*)(sb + st * 64 + q * 4);
                const float4 rr = *(const float4*)(sr + st * 64 + q * 4);
                const float vv = sv[st * 16 + row];
                float sa = -(s0 * kk.x + s1 * kk.y + s2 * kk.z + s3 * kk.w);
                sa += __shfl_xor(sa, 1); sa += __shfl_xor(sa, 2); sa += __shfl_xor(sa, 4); sa += __shfl_xor(sa, 8);
                s0 = s0 * dd.x + sa * bb.x + vv * kv.x;
                s1 = s1 * dd.y + sa * bb.y + vv * kv.y;
                s2 = s2 * dd.z + sa * bb.z + vv * kv.z;
                s3 = s3 * dd.w + sa * bb.w + vv * kv.w;
                float o = s0 * rr.x + s1 * rr.y + s2 * rr.z + s3 * rr.w;
                o += __shfl_xor(o, 1); o += __shfl_xor(o, 2); o += __shfl_xor(o, 4); o += __shfl_xor(o, 8);
                if (q == 0) so[st * 16 + row] = o;
            }
            __syncthreads();
            for (int i = tid; i < SCH * 16; i += NT) {
                const int st = i >> 4, r = i & 15;
                p.O[((size_t)(b * S + t0 + st)) * 512 + h * 64 + qu * 16 + r] = so[i];
            }
        }
    }
}

__device__ void ph_rwkv_post(const Params& p, float* sm, int bid, int nb) {
    const int tid = threadIdx.x;
    for (int t = bid; t < T; t += nb) {
#pragma unroll
        for (int slot = 0; slot < 2; ++slot) {
            const int c = tid + slot * 256;
            const size_t o = (size_t)t * 512 + c;
            const float ov = p.O[o];
            const float m = wave_sum(ov) * (1.0f / 64.0f);
            const float dl = ov - m;
            const float var = wave_sum(dl * dl) * (1.0f / 64.0f);
            const float on = dl * rsqrtf(var + 64e-5f) * p.lnx_w[c] + p.lnx_b[c];
            const float bon = wave_sum(p.R[o] * p.K2[o] * p.r_k[c]) * p.V[o];
            p.YA[o] = (on + bon) * p.G[o];
        }
    }
}

__device__ void ph_rope(const Params& p, float* sm, int bid, int nb) {
    const int tid = threadIdx.x;
    for (int t = bid; t < T; t += nb) {
        const int s = t & (S - 1);
        for (int pi = tid; pi < 12 * 32; pi += NT) {
            const int hs = pi >> 5, i = pi & 31;
            const float inv = (float)pow(10000.0, -(double)i / 32.0);
            const float ang = (float)s * inv;
            float sn, cs; sincosf(ang, &sn, &cs);
            const float* src; float* dst;
            if (hs < 8) { src = p.P + (size_t)t * INW + C_Q + hs * 64; dst = p.QR + (size_t)t * 512 + hs * 64; }
            else if (hs < 10) { src = p.P + (size_t)t * INW + C_KS + (hs - 8) * 64; dst = p.KSR + (size_t)t * 128 + (hs - 8) * 64; }
            else { src = p.P + (size_t)t * INW + C_KW + (hs - 10) * 64; dst = p.KWR + (size_t)t * 128 + (hs - 10) * 64; }
            const float x1 = src[i], x2 = src[i + 32];
            dst[i] = x1 * cs - x2 * sn;
            dst[i + 32] = x2 * cs + x1 * sn;
        }
    }
}

__device__ void ph_cmp1(const Params& p, float* sm, int bid, int nb) {
    const int nmt = (NCROWS + 63) / 64;
    const int nu = 2 * nmt * 4;
    for (int u = bid; u < nu; u += nb) {
        const int kv = u / (nmt * 4), m0 = ((u / 4) % nmt) * 64, n0 = (u % 4) * 64;
        const float* pe = kv ? p.pe_v : p.pe_k; const float* w1 = kv ? p.w1_v : p.w1_k; float* H1 = kv ? p.H1V : p.H1K;
        const int ccol = kv ? C_VC : C_KC;
        const float* P = p.P;
        auto al = [&](int m, int k) {
            const int r = m0 + m;
            if (r >= NCROWS) return make_float4(0.f, 0.f, 0.f, 0.f);
            const int g = r & 1, bc = r >> 1, b = bc / NCMP, c = bc % NCMP;
            const int tok = k >> 6, d = k & 63;
            const float4 v = *(const float4*)(P + (size_t)(b * S + 16 * c + tok) * INW + ccol + g * 64 + d);
            const float4 e = *(const float4*)(pe + tok * 64 + d);
            return make_float4(v.x + e.x, v.y + e.y, v.z + e.z, v.w + e.w);
        };
        auto bl = [&](int k, int n) { return *(const float4*)(w1 + (size_t)k * 256 + n0 + n); };
        auto ep = [&](int m, int n, float4 v) {
            const int r = m0 + m;
            if (r < NCROWS) *(float4*)(H1 + (size_t)r * 256 + n0 + n) = make_float4(gelu_tanh(v.x), gelu_tanh(v.y), gelu_tanh(v.z), gelu_tanh(v.w));
        };
        sgemm_unit(sm, 2048, al, bl, ep);
    }
}
__device__ void ph_cmp2(const Params& p, float* sm, int bid, int nb) {
    const int nmt = (NCROWS + 63) / 64;
    const int nu = 2 * nmt;
    for (int u = bid; u < nu; u += nb) {
        const int kv = u / nmt, m0 = (u % nmt) * 64;
        const float* H1 = kv ? p.H1V : p.H1K; const float* w2 = kv ? p.w2_v : p.w2_k; float* OUT = kv ? p.VC : p.KCraw;
        auto al = [&](int m, int k) { const int r = m0 + m; return (r < NCROWS) ? *(const float4*)(H1 + (size_t)r * 256 + k) : make_float4(0.f, 0.f, 0.f, 0.f); };
        auto bl = [&](int k, int n) { return *(const float4*)(w2 + (size_t)k * 64 + n); };
        auto ep = [&](int m, int n, float4 v) { const int r = m0 + m; if (r < NCROWS) *(float4*)(OUT + (size_t)r * 64 + n) = v; };
        sgemm_unit(sm, 256, al, bl, ep);
    }
}
__device__ void ph_cmp_rope(const Params& p, float* sm, int bid, int nb) {
    const int tid = threadIdx.x;
    for (int i = bid * NT + tid; i < NCROWS * 32; i += nb * NT) {
        const int r = i >> 5, d = i & 31;
        const int c = (r >> 1) % NCMP;
        const float inv = (float)pow(10000.0, -(double)d / 32.0);
        const float ang = (float)(16 * c + 31) * inv;
        float sn, cs; sincosf(ang, &sn, &cs);
        const float x1 = p.KCraw[(size_t)r * 64 + d], x2 = p.KCraw[(size_t)r * 64 + d + 32];
        p.KCR[(size_t)r * 64 + d] = x1 * cs - x2 * sn;
        p.KCR[(size_t)r * 64 + d + 32] = x2 * cs + x1 * sn;
    }
}

__device__ void ph_nsa(const Params& p, float* sm, int bid, int nb) {
    float* qs = sm;
    float* sc = sm + 256;
    float* impv = sc + 4096;
    float* scorev = impv + 128;
    int* sel = (int*)(scorev + 128);
    const int tid = threadIdx.x, wave = tid >> 6, lane = tid & 63;
    for (int item = bid; item < T * 2; item += nb) {
        const int g = item & 1, t = item >> 1, b = t >> 13, s = t & (S - 1);
        __syncthreads();
        qs[tid] = p.QR[(size_t)t * 512 + g * 256 + tid] * 0.125f;
        if (tid < 16) sel[tid] = -1;
        __syncthreads();
        const int nv = (s >= 31) ? ((s - 31) >> 4) + 1 : 0;
        for (int c = tid; c < 516; c += NT) {
            float d0 = 0.f, d1 = 0.f, d2 = 0.f, d3 = 0.f;
            if (c < nv) {
                const float* kr = p.KCR + ((size_t)(b * NCMP + c) * 2 + g) * 64;
                for (int d = 0; d < 64; d += 4) {
                    const float4 kq = *(const float4*)(kr + d);
                    const float4 q0 = *(const float4*)(qs + d), q1 = *(const float4*)(qs + 64 + d), q2 = *(const float4*)(qs + 128 + d), q3 = *(const float4*)(qs + 192 + d);
                    d0 += kq.x * q0.x + kq.y * q0.y + kq.z * q0.z + kq.w * q0.w;
                    d1 += kq.x * q1.x + kq.y * q1.y + kq.z * q1.z + kq.w * q1.w;
                    d2 += kq.x * q2.x + kq.y * q2.y + kq.z * q2.z + kq.w * q2.w;
                    d3 += kq.x * q3.x + kq.y * q3.y + kq.z * q3.z + kq.w * q3.w;
                }
            }
            sc[c] = d0; sc[1024 + c] = d1; sc[2048 + c] = d2; sc[3072 + c] = d3;
        }
        __syncthreads();
        {
            float* row = sc + wave * 1024;
            float mx = -1e30f;
            for (int c = lane; c < nv; c += 64) mx = fmaxf(mx, row[c]);
            mx = wave_max(mx);
            float sum = 0.f;
            for (int c = lane; c < nv; c += 64) { const float e = expf(row[c] - mx); row[c] = e; sum += e; }
            sum = wave_sum(sum);
            const float inv = (nv > 0) ? 1.0f / sum : 0.f;
            for (int c = lane; c < 516; c += 64) row[c] = (c < nv) ? row[c] * inv : 0.f;
        }
        __syncthreads();
        float oc = 0.f;
        {
            const float* row = sc + wave * 1024;
            const float* vb = p.VC + ((size_t)(b * NCMP) * 2 + g) * 64 + lane;
            for (int c = 0; c < nv; ++c) oc += row[c] * vb[(size_t)c * 128];
        }
        if (tid < 128) {
            const int j = tid, c0 = 4 * j;
            float acc = 0.f;
#pragma unroll
            for (int n = 0; n < 4; ++n) {
                const float* row = sc + n * 1024;
                acc += ((c0 > 0) ? row[c0 - 1] : 0.f) + 2.0f * (row[c0] + row[c0 + 1] + row[c0 + 2]) + row[c0 + 3];
            }
            impv[j] = acc;
        }
        __syncthreads();
        const int cur = s >> 6;
        if (tid < 128) {
            const int j = tid;
            const bool valid = (j <= cur);
            const bool forced = (j == 0) || (j == cur) || (j == cur - 1);
            scorev[j] = valid ? (impv[j] + (forced ? 1e4f : 0.f)) : -1.0f;
        }
        __syncthreads();
        if (tid < 128) {
            const float my = scorev[tid];
            int rank = 0;
            for (int i = 0; i < 128; ++i) { const float o = scorev[i]; rank += (o > my || (o == my && i < tid)) ? 1 : 0; }
            if (rank < 16) sel[rank] = (my >= 0.f) ? tid : -1;
        }
        __syncthreads();
        for (int i = 0; i < 4; ++i) {
            const int kidx = tid + 256 * i, slot = kidx >> 6, l = kidx & 63;
            const int blk = sel[slot];
            const int pos = blk * 64 + l;
            const bool ok = (blk >= 0) && (pos <= s);
            float d0 = 0.f, d1 = 0.f, d2 = 0.f, d3 = 0.f;
            if (ok) {
                const float* kr = p.KSR + ((size_t)(b * S + pos)) * 128 + g * 64;
                for (int d = 0; d < 64; d += 4) {
                    const float4 kq = *(const float4*)(kr + d);
                    const float4 q0 = *(const float4*)(qs + d), q1 = *(const float4*)(qs + 64 + d), q2 = *(const float4*)(qs + 128 + d), q3 = *(const float4*)(qs + 192 + d);
                    d0 += kq.x * q0.x + kq.y * q0.y + kq.z * q0.z + kq.w * q0.w;
                    d1 += kq.x * q1.x + kq.y * q1.y + kq.z * q1.z + kq.w * q1.w;
                    d2 += kq.x * q2.x + kq.y * q2.y + kq.z * q2.z + kq.w * q2.w;
                    d3 += kq.x * q3.x + kq.y * q3.y + kq.z * q3.z + kq.w * q3.w;
                }
            }
            sc[kidx] = ok ? d0 : -1e30f; sc[1024 + kidx] = ok ? d1 : -1e30f; sc[2048 + kidx] = ok ? d2 : -1e30f; sc[3072 + kidx] = ok ? d3 : -1e30f;
        }
        __syncthreads();
        {
            float* row = sc + wave * 1024;
            float mx = -1e30f;
            for (int c = lane; c < 1024; c += 64) mx = fmaxf(mx, row[c]);
            mx = wave_max(mx);
            float sum = 0.f;
            for (int c = lane; c < 1024; c += 64) { const float v = row[c]; const float e = (v > -1e29f) ? expf(v - mx) : 0.f; row[c] = e; sum += e; }
            sum = wave_sum(sum);
            const float inv = (sum > 0.f) ? 1.0f / sum : 0.f;
            for (int c = lane; c < 1024; c += 64) row[c] *= inv;
        }
        __syncthreads();
        float os = 0.f;
        {
            const float* row = sc + wave * 1024;
            for (int slot = 0; slot < 16; ++slot) {
                const int blk = sel[slot];
                if (blk < 0) continue;
                const float* vb = p.P + ((size_t)(b * S + blk * 64)) * INW + C_VS + g * 64 + lane;
                for (int l = 0; l < 64; ++l) os += row[slot * 64 + l] * vb[(size_t)l * INW];
            }
        }
        __syncthreads();
        const int nk = (s + 1 < 512) ? s + 1 : 512;
        const int first = s - nk + 1;
        for (int i = 0; i < 2; ++i) {
            const int kidx = tid + 256 * i;
            const bool ok = kidx < nk;
            float d0 = 0.f, d1 = 0.f, d2 = 0.f, d3 = 0.f;
            if (ok) {
                const float* kr = p.KWR + ((size_t)(b * S + first + kidx)) * 128 + g * 64;
                for (int d = 0; d < 64; d += 4) {
                    const float4 kq = *(const float4*)(kr + d);
                    const float4 q0 = *(const float4*)(qs + d), q1 = *(const float4*)(qs + 64 + d), q2 = *(const float4*)(qs + 128 + d), q3 = *(const float4*)(qs + 192 + d);
                    d0 += kq.x * q0.x + kq.y * q0.y + kq.z * q0.z + kq.w * q0.w;
                    d1 += kq.x * q1.x + kq.y * q1.y + kq.z * q1.z + kq.w * q1.w;
                    d2 += kq.x * q2.x + kq.y * q2.y + kq.z * q2.z + kq.w * q2.w;
                    d3 += kq.x * q3.x + kq.y * q3.y + kq.z * q3.z + kq.w * q3.w;
                }
            }
            sc[kidx] = ok ? d0 : -1e30f; sc[1024 + kidx] = ok ? d1 : -1e30f; sc[2048 + kidx] = ok ? d2 : -1e30f; sc[3072 + kidx] = ok ? d3 : -1e30f;
        }
        __syncthreads();
        {
            float* row = sc + wave * 1024;
            float mx = -1e30f;
            for (int c = lane; c < 512; c += 64) mx = fmaxf(mx, row[c]);
            mx = wave_max(mx);
            float sum = 0.f;
            for (int c = lane; c < 512; c += 64) { const float v = row[c]; const float e = (v > -1e29f) ? expf(v - mx) : 0.f; row[c] = e; sum += e; }
            sum = wave_sum(sum);
            const float inv = (sum > 0.f) ? 1.0f / sum : 0.f;
            for (int c = lane; c < 512; c += 64) row[c] *= inv;
        }
        __syncthreads();
        float ow = 0.f;
        {
            const float* row = sc + wave * 1024;
            const float* vb = p.P + ((size_t)(b * S + first)) * INW + C_VW + g * 64 + lane;
            for (int l = 0; l < nk; ++l) ow += row[l] * vb[(size_t)l * INW];
        }
        const int h = g * 4 + wave;
        const float* gp = p.P + (size_t)t * INW + C_GT + h * 3;
        const float g0 = sigmoidf_(gp[0]), g1 = sigmoidf_(gp[1]), g2 = sigmoidf_(gp[2]);
        p.YB[(size_t)t * 512 + h * 64 + lane] = g0 * oc + g1 * os + g2 * ow;
    }
}

__device__ void ph_branch_a(const Params& p, float* sm, int bid, int nb) {
    const float* P = p.P; float* Z = p.Z;
    dense_gemm_phase(sm, bid, nb, p.YA, 512, p.wba, D, T, D, 512, [=](int r, int c, float4 v) {
        const float4 gq = *(const float4*)(P + (size_t)r * INW + C_GA + c);
        *(float4*)(Z + (size_t)r * D + c) = make_float4(sigmoidf_(gq.x) * v.x, sigmoidf_(gq.y) * v.y, sigmoidf_(gq.z) * v.z, sigmoidf_(gq.w) * v.w);
    });
}
__device__ void ph_branch_b(const Params& p, float* sm, int bid, int nb) {
    const float* P = p.P; float* Z = p.Z;
    dense_gemm_phase(sm, bid, nb, p.YB, 512, p.wbb, D, T, D, 512, [=](int r, int c, float4 v) {
        const float4 gq = *(const float4*)(P + (size_t)r * INW + C_GB + c);
        float4 z = *(float4*)(Z + (size_t)r * D + c);
        z.x += sigmoidf_(gq.x) * v.x; z.y += sigmoidf_(gq.y) * v.y; z.z += sigmoidf_(gq.z) * v.z; z.w += sigmoidf_(gq.w) * v.w;
        *(float4*)(Z + (size_t)r * D + c) = z;
    });
}
__device__ void ph_outproj(const Params& p, float* sm, int bid, int nb) {
    const float* x = p.x; float* PRE1 = p.PRE1;
    dense_gemm_phase(sm, bid, nb, p.Z, D, p.wout, D, T, D, D, [=](int r, int c, float4 v) {
        const float4 xv = *(const float4*)(x + (size_t)r * D + c);
        *(float4*)(PRE1 + (size_t)r * D + c) = make_float4(ALPHA * xv.x + v.x, ALPHA * xv.y + v.y, ALPHA * xv.z + v.z, ALPHA * xv.w + v.w);
    });
}
__device__ __forceinline__ void ln_rows(float* sm, int bid, int nb, const float* src, float* dst, const float* gam, const float* bet) {
    const int tid = threadIdx.x, wave = tid >> 6, lane = tid & 63;
    for (int t = bid; t < T; t += nb) {
        const float4 v = *(const float4*)(src + (size_t)t * D + tid * 4);
        float s = (v.x + v.y) + (v.z + v.w);
        s = wave_sum(s);
        __syncthreads();
        if (lane == 0) sm[wave] = s;
        __syncthreads();
        const float mean = (sm[0] + sm[1] + sm[2] + sm[3]) * (1.0f / D);
        const float dx = v.x - mean, dy = v.y - mean, dz = v.z - mean, dw = v.w - mean;
        float q = (dx * dx + dy * dy) + (dz * dz + dw * dw);
        q = wave_sum(q);
        __syncthreads();
        if (lane == 0) sm[wave] = q;
        __syncthreads();
        const float rstd = rsqrtf((sm[0] + sm[1] + sm[2] + sm[3]) * (1.0f / D) + 1e-5f);
        const float4 gq = *(const float4*)(gam + tid * 4), bq = *(const float4*)(bet + tid * 4);
        *(float4*)(dst + (size_t)t * D + tid * 4) = make_float4(dx * rstd * gq.x + bq.x, dy * rstd * gq.y + bq.y, dz * rstd * gq.z + bq.z, dw * rstd * gq.w + bq.w);
    }
}
__device__ void ph_ln1(const Params& p, float* sm, int bid, int nb) { ln_rows(sm, bid, nb, p.PRE1, p.X1, p.ln1g, p.ln1b); }

__device__ void ph_router_gemm(const Params& p, float* sm, int bid, int nb) {
    float* L = p.LOGITS;
    dense_gemm_phase(sm, bid, nb, p.X1, D, p.rw, NE, T, NE, D, [=](int r, int c, float4 v) { *(float4*)(L + (size_t)r * NE + c) = v; });
}
__device__ void ph_router_sel(const Params& p, float* sm, int bid, int nb) {
    float* chs = sm;
    float* scs = sm + 256;
    float* gs = sm + 512;
    int* gsel = (int*)(sm + 520);
    float* ew = sm + 528;
    int* ei = (int*)(sm + 536);
    const int e = threadIdx.x;
    for (int t = bid; t < T; t += nb) {
        __syncthreads();
        const float sc = sigmoidf_(p.LOGITS[(size_t)t * NE + e]);
        const float ch = sc + p.rbias[e];
        chs[e] = ch; scs[e] = sc;
        __syncthreads();
        if (e < 8) {
            float m1 = -3e38f; int i1 = -1;
            for (int i = 0; i < 32; ++i) { const float v = chs[e * 32 + i]; if (v > m1) { m1 = v; i1 = i; } }
            float m2 = -3e38f;
            for (int i = 0; i < 32; ++i) { const float v = chs[e * 32 + i]; if (i != i1 && v > m2) m2 = v; }
            gs[e] = m1 + m2;
        }
        __syncthreads();
        if (e < 8) {
            const float my = gs[e]; int rank = 0;
            for (int i = 0; i < 8; ++i) { const float o = gs[i]; rank += (o > my || (o == my && i < e)) ? 1 : 0; }
            gsel[e] = (rank < 4) ? 1 : 0;
        }
        __syncthreads();
        const float mch = gsel[e >> 5] ? ch : -1e30f;
        __syncthreads();
        chs[e] = mch;
        __syncthreads();
        {
            int rank = 0;
            for (int i = 0; i < 256; ++i) { const float o = chs[i]; rank += (o > mch || (o == mch && i < e)) ? 1 : 0; }
            if (rank < 8) { ei[rank] = e; ew[rank] = sc; }
        }
        __syncthreads();
        if (e < 8) {
            const float sum = ((ew[0] + ew[1]) + (ew[2] + ew[3])) + ((ew[4] + ew[5]) + (ew[6] + ew[7]));
            p.EIDX[(size_t)t * 8 + e] = ei[e];
            p.EW[(size_t)t * 8 + e] = ew[e] / sum * 2.5f;
        }
    }
}
__device__ void ph_lists(const Params& p, float* sm, int bid, int nb) {
    int* wcnt = (int*)sm;
    const int tid = threadIdx.x, wave = tid >> 6, lane = tid & 63;
    for (int e = bid; e < NE; e += nb) {
        int base = 0;
        for (int a0 = 0; a0 < T * 8; a0 += NT) {
            const bool f = (p.EIDX[a0 + tid] == e);
            const unsigned long long m = __ballot(f);
            const int before = __popcll(m & ((1ull << lane) - 1ull));
            __syncthreads();
            if (lane == 0) wcnt[wave] = __popcll(m);
            __syncthreads();
            int off = base;
            for (int w = 0; w < wave; ++w) off += wcnt[w];
            if (f && off + before < LISTCAP) p.LIST[(size_t)e * LISTCAP + off + before] = a0 + tid;
            base += wcnt[0] + wcnt[1] + wcnt[2] + wcnt[3];
        }
        if (tid == 0) p.CNT[e] = base < LISTCAP ? base : LISTCAP;
    }
}
__device__ void ph_moe_gu(const Params& p, float* sm, int bid, int nb) {
    const int nu = NE * 256 * 8;
    for (int u = bid; u < nu; u += nb) {
        const int mt = u / (NE * 8), e = (u / 8) % NE, n0 = (u % 8) * 64;
        const int cnt = p.CNT[e];
        if (mt * 64 >= cnt) continue;
        const int* lst = p.LIST + (size_t)e * LISTCAP + mt * 64;
        const int nrow = cnt - mt * 64;
        const float* X1 = p.X1; const float* W = p.egu + (size_t)e * D * 512; float* HGU = p.HGU;
        auto al = [&](int m, int k) { if (m >= nrow) return make_float4(0.f, 0.f, 0.f, 0.f); const int a = lst[m]; return *(const float4*)(X1 + (size_t)(a >> 3) * D + k); };
        auto bl = [&](int k, int n) { return *(const float4*)(W + (size_t)k * 512 + n0 + n); };
        auto ep = [&](int m, int n, float4 v) { if (m < nrow) { const int a = lst[m]; *(float4*)(HGU + (size_t)a * 512 + n0 + n) = v; } };
        sgemm_unit(sm, D, al, bl, ep);
    }
}
__device__ void ph_moe_down(const Params& p, float* sm, int bid, int nb) {
    const int nu = NE * 256 * 16;
    for (int u = bid; u < nu; u += nb) {
        const int mt = u / (NE * 16), e = (u / 16) % NE, n0 = (u % 16) * 64;
        const int cnt = p.CNT[e];
        if (mt * 64 >= cnt) continue;
        const int* lst = p.LIST + (size_t)e * LISTCAP + mt * 64;
        const int nrow = cnt - mt * 64;
        const float* HGU = p.HGU; const float* W = p.edown + (size_t)e * 256 * D; float* Y = p.Y; const float* EW = p.EW;
        auto al = [&](int m, int k) {
            if (m >= nrow) return make_float4(0.f, 0.f, 0.f, 0.f);
            const int a = lst[m];
            const float4 gq = *(const float4*)(HGU + (size_t)a * 512 + k), uq = *(const float4*)(HGU + (size_t)a * 512 + 256 + k);
            return make_float4(gq.x * sigmoidf_(gq.x) * uq.x, gq.y * sigmoidf_(gq.y) * uq.y, gq.z * sigmoidf_(gq.z) * uq.z, gq.w * sigmoidf_(gq.w) * uq.w);
        };
        auto bl = [&](int k, int n) { return *(const float4*)(W + (size_t)k * D + n0 + n); };
        auto ep = [&](int m, int n, float4 v) { if (m < nrow) { const int a = lst[m]; const float w = EW[a]; *(float4*)(Y + (size_t)a * D + n0 + n) = make_float4(v.x * w, v.y * w, v.z * w, v.w * w); } };
        sgemm_unit(sm, 256, al, bl, ep);
    }
}
__device__ void ph_shared_gu(const Params& p, float* sm, int bid, int nb) {
    float* HS = p.HS;
    dense_gemm_phase(sm, bid, nb, p.X1, D, p.sgu, 512, T, 512, D, [=](int r, int c, float4 v) { *(float4*)(HS + (size_t)r * 512 + c) = v; });
}
__device__ void ph_shared_down(const Params& p, float* sm, int bid, int nb) {
    const int nu = (T / 64) * 16;
    for (int u = bid; u < nu; u += nb) {
        const int m0 = (u / 16) * 64, n0 = (u % 16) * 64;
        const float* HS = p.HS; const float* W = p.sdown; float* SH = p.SH;
        auto al = [&](int m, int k) {
            const float4 gq = *(const float4*)(HS + (size_t)(m0 + m) * 512 + k), uq = *(const float4*)(HS + (size_t)(m0 + m) * 512 + 256 + k);
            return make_float4(gq.x * sigmoidf_(gq.x) * uq.x, gq.y * sigmoidf_(gq.y) * uq.y, gq.z * sigmoidf_(gq.z) * uq.z, gq.w * sigmoidf_(gq.w) * uq.w);
        };
        auto bl = [&](int k, int n) { return *(const float4*)(W + (size_t)k * D + n0 + n); };
        auto ep = [&](int m, int n, float4 v) { *(float4*)(SH + (size_t)(m0 + m) * D + n0 + n) = v; };
        sgemm_unit(sm, 256, al, bl, ep);
    }
}
__device__ void ph_final(const Params& p, float* sm, int bid, int nb) {
    const int tid = threadIdx.x, wave = tid >> 6, lane = tid & 63;
    for (int t = bid; t < T; t += nb) {
        const float4 xv = *(const float4*)(p.X1 + (size_t)t * D + tid * 4);
        float4 v = *(const float4*)(p.SH + (size_t)t * D + tid * 4);
        float4 r = make_float4(0.f, 0.f, 0.f, 0.f);
#pragma unroll
        for (int k = 0; k < 8; ++k) { const float4 y = *(const float4*)(p.Y + ((size_t)t * 8 + k) * D + tid * 4); r.x += y.x; r.y += y.y; r.z += y.z; r.w += y.w; }
        v.x = ALPHA * xv.x + (r.x + v.x); v.y = ALPHA * xv.y + (r.y + v.y); v.z = ALPHA * xv.z + (r.z + v.z); v.w = ALPHA * xv.w + (r.w + v.w);
        float s = (v.x + v.y) + (v.z + v.w);
        s = wave_sum(s);
        __syncthreads();
        if (lane == 0) sm[wave] = s;
        __syncthreads();
        const float mean = (sm[0] + sm[1] + sm[2] + sm[3]) * (1.0f / D);
        const float dx = v.x - mean, dy = v.y - mean, dz = v.z - mean, dw = v.w - mean;
        float q = (dx * dx + dy * dy) + (dz * dz + dw * dw);
        q = wave_sum(q);
        __syncthreads();
        if (lane == 0) sm[wave] = q;
        __syncthreads();
        const float rstd = rsqrtf((sm[0] + sm[1] + sm[2] + sm[3]) * (1.0f / D) + 1e-5f);
        const float4 gq = *(const float4*)(p.ln2g + tid * 4), bq = *(const float4*)(p.ln2b + tid * 4);
        *(float4*)(p.out + (size_t)t * D + tid * 4) = make_float4(dx * rstd * gq.x + bq.x, dy * rstd * gq.y + bq.y, dz * rstd * gq.z + bq.z, dw * rstd * gq.w + bq.w);
    }
}

constexpr int SM_FLOATS = 12288;

#define DEF_KERNEL(name) \
    __global__ void __launch_bounds__(NT) k_##name(Params p) { __shared__ __attribute__((aligned(16))) float sm[SM_FLOATS]; ph_##name(p, sm, (int)blockIdx.x, (int)gridDim.x); }
DEF_KERNEL(inproj)
DEF_KERNEL(rwkv_prep)
DEF_KERNEL(scan)
DEF_KERNEL(rwkv_post)
DEF_KERNEL(rope)
DEF_KERNEL(cmp1)
DEF_KERNEL(cmp2)
DEF_KERNEL(cmp_rope)
DEF_KERNEL(nsa)
DEF_KERNEL(branch_a)
DEF_KERNEL(branch_b)
DEF_KERNEL(outproj)
DEF_KERNEL(ln1)
DEF_KERNEL(router_gemm)
DEF_KERNEL(router_sel)
DEF_KERNEL(lists)
DEF_KERNEL(moe_gu)
DEF_KERNEL(moe_down)
DEF_KERNEL(shared_gu)
DEF_KERNEL(shared_down)
DEF_KERNEL(final)

}

extern "C" void kernel_launch(void* const* d_in, const int* in_sizes, int n_in, void* d_out, int out_size, void* d_ws, size_t ws_size, hipStream_t stream) {
    Params p{};
    const float* const* in = (const float* const*)d_in;
    p.x = in[0]; p.w_in = in[1]; p.mu = in[2]; p.w0 = in[3]; p.w2 = in[4]; p.a0 = in[5]; p.a2 = in[6]; p.g2 = in[7]; p.k_k = in[8]; p.k_a = in[9];
    p.r_k = in[10]; p.lnx_w = in[11]; p.lnx_b = in[12]; p.pe_k = in[13]; p.w1_k = in[14]; p.w2_k = in[15]; p.pe_v = in[16]; p.w1_v = in[17]; p.w2_v = in[18];
    p.wba = in[19]; p.wbb = in[20]; p.wout = in[21]; p.ln1g = in[22]; p.ln1b = in[23]; p.rw = in[24]; p.rbias = in[25]; p.egu = in[26]; p.edown = in[27];
    p.sgu = in[28]; p.sdown = in[29]; p.ln2g = in[30]; p.ln2b = in[31];
    p.out = (float*)d_out;
    char* w = (char*)d_ws; size_t off = 0;
    auto carve = [&](size_t bytes) { char* r = w + off; off += (bytes + 255) & ~(size_t)255; return r; };
    p.P = (float*)carve((size_t)T * INW * 4);
    p.R = (float*)carve((size_t)T * 512 * 4); p.DC = (float*)carve((size_t)T * 512 * 4); p.K2 = (float*)carve((size_t)T * 512 * 4); p.V = (float*)carve((size_t)T * 512 * 4);
    p.KK = (float*)carve((size_t)T * 512 * 4); p.BB = (float*)carve((size_t)T * 512 * 4); p.G = (float*)carve((size_t)T * 512 * 4);
    p.O = (float*)carve((size_t)T * 512 * 4); p.YA = (float*)carve((size_t)T * 512 * 4);
    p.QR = (float*)carve((size_t)T * 512 * 4); p.KSR = (float*)carve((size_t)T * 128 * 4); p.KWR = (float*)carve((size_t)T * 128 * 4);
    p.KCraw = (float*)carve((size_t)NCROWS * 64 * 4); p.KCR = (float*)carve((size_t)NCROWS * 64 * 4); p.VC = (float*)carve((size_t)NCROWS * 64 * 4);
    p.H1K = (float*)carve((size_t)NCROWS * 256 * 4); p.H1V = (float*)carve((size_t)NCROWS * 256 * 4);
    p.YB = (float*)carve((size_t)T * 512 * 4);
    p.Z = (float*)carve((size_t)T * D * 4); p.PRE1 = (float*)carve((size_t)T * D * 4); p.X1 = (float*)carve((size_t)T * D * 4);
    p.LOGITS = (float*)carve((size_t)T * NE * 4); p.EW = (float*)carve((size_t)T * 8 * 4); p.EIDX = (int*)carve((size_t)T * 8 * 4);
    p.LIST = (int*)carve((size_t)NE * LISTCAP * 4); p.CNT = (int*)carve(1024);
    p.HS = (float*)carve((size_t)T * 512 * 4); p.SH = (float*)carve((size_t)T * D * 4);
    p.HGU = (float*)carve((size_t)T * 8 * 512 * 4);
    p.Y = (float*)carve((size_t)T * 8 * D * 4);
    if (off > ws_size) { fprintf(stderr, "kernel_launch: workspace too small: need %zu have %zu\n", off, ws_size); return; }
    const int G = 2048;
#define LAUNCH(name, grid) hipLaunchKernelGGL(k_##name, dim3(grid), dim3(NT), 0, stream, p)
    LAUNCH(inproj, G);
    LAUNCH(rwkv_prep, G);
    LAUNCH(scan, 64);
    LAUNCH(rwkv_post, G);
    LAUNCH(rope, G);
    LAUNCH(cmp1, 256);
    LAUNCH(cmp2, 64);
    LAUNCH(cmp_rope, 256);
    LAUNCH(nsa, 4096);
    LAUNCH(branch_a, G);
    LAUNCH(branch_b, G);
    LAUNCH(outproj, G);
    LAUNCH(ln1, G);
    LAUNCH(router_gemm, G);
    LAUNCH(router_sel, G);
    LAUNCH(lists, 256);
    LAUNCH(moe_gu, G);
    LAUNCH(moe_down, G);
    LAUNCH(shared_gu, G);
    LAUNCH(shared_down, G);
    LAUNCH(final, G);
}
```

```cpp
#include <hip/hip_runtime.h>
#include <hip/hip_cooperative_groups.h>
#include <cstdio>
#include <cstdint>
#include <cmath>

namespace {

constexpr int NB = 2, S = 8192, T = NB * S, D = 1024, INW = 5144;
constexpr int C_R = 0, C_K = 512, C_V = 1024, C_WL = 1536, C_AL = 1600, C_GL = 1664, RW_IN = 1792;
constexpr int C_Q = 1792, C_KC = 2304, C_VC = 2432, C_KS = 2560, C_VS = 2688, C_KW = 2816, C_VW = 2944, C_GT = 3072;
constexpr int C_GA = 3096, C_GB = 4120;
constexpr int NCMP = 511, NCROWS = NB * NCMP * 2;
constexpr int NE = 256, TOPK = 8, LISTCAP = 16384;
constexpr float ALPHA = 1.189207115002721f;
constexpr int NT = 256;

struct Params {
    const float *x, *w_in, *mu, *w0, *w2, *a0, *a2, *g2, *k_k, *k_a, *r_k, *lnx_w, *lnx_b;
    const float *pe_k, *w1_k, *w2_k, *pe_v, *w1_v, *w2_v, *wba, *wbb, *wout, *ln1g, *ln1b;
    const float *rw, *rbias, *egu, *edown, *sgu, *sdown, *ln2g, *ln2b;
    float* out;
    float *P, *R, *DC, *K2, *V, *KK, *BB, *G, *O, *YA, *QR, *KSR, *KWR, *KCraw, *KCR, *VC, *H1K, *H1V, *YB, *Z, *PRE1, *X1;
    float *LOGITS, *EW, *HGU, *Y, *HS, *SH;
    int *EIDX, *LIST, *CNT;
    int pad_[2];
};

__device__ __forceinline__ float wave_sum(float v) {
#pragma unroll
    for (int o = 1; o < 64; o <<= 1) v += __shfl_xor(v, o);
    return v;
}
__device__ __forceinline__ float wave_max(float v) {
#pragma unroll
    for (int o = 1; o < 64; o <<= 1) v = fmaxf(v, __shfl_xor(v, o));
    return v;
}
__device__ __forceinline__ float sigmoidf_(float x) { return 1.0f / (1.0f + expf(-x)); }
__device__ __forceinline__ float gelu_tanh(float x) { return 0.5f * x * (1.0f + tanhf(0.7978845608028654f * (x + 0.044715f * x * x * x))); }

template <class AL, class BL, class EP>
__device__ __forceinline__ void sgemm_unit(float* sm, int K, const AL& aload, const BL& bload, const EP& epi) {
    float (*As)[68] = (float (*)[68])sm;
    float (*Bs)[68] = (float (*)[68])(sm + 16 * 68);
    const int tid = threadIdx.x, ty = tid >> 4, tx = tid & 15;
    const int arow = tid >> 2, ak = (tid & 3) * 4, bk = tid >> 4, bn = (tid & 15) * 4;
    float acc[4][4];
#pragma unroll
    for (int i = 0; i < 4; ++i)
#pragma unroll
        for (int j = 0; j < 4; ++j) acc[i][j] = 0.f;
    for (int k0 = 0; k0 < K; k0 += 16) {
        const float4 av = aload(arow, k0 + ak);
        const float4 bv = bload(k0 + bk, bn);
        __syncthreads();
        As[ak + 0][arow] = av.x; As[ak + 1][arow] = av.y; As[ak + 2][arow] = av.z; As[ak + 3][arow] = av.w;
        *(float4*)&Bs[bk][bn] = bv;
        __syncthreads();
#pragma unroll
        for (int k = 0; k < 16; ++k) {
            const float4 a = *(const float4*)&As[k][ty * 4];
            const float4 b = *(const float4*)&Bs[k][tx * 4];
            acc[0][0] += a.x * b.x; acc[0][1] += a.x * b.y; acc[0][2] += a.x * b.z; acc[0][3] += a.x * b.w;
            acc[1][0] += a.y * b.x; acc[1][1] += a.y * b.y; acc[1][2] += a.y * b.z; acc[1][3] += a.y * b.w;
            acc[2][0] += a.z * b.x; acc[2][1] += a.z * b.y; acc[2][2] += a.z * b.z; acc[2][3] += a.z * b.w;
            acc[3][0] += a.w * b.x; acc[3][1] += a.w * b.y; acc[3][2] += a.w * b.z; acc[3][3] += a.w * b.w;
        }
    }
#pragma unroll
    for (int i = 0; i < 4; ++i) epi(ty * 4 + i, tx * 4, make_float4(acc[i][0], acc[i][1], acc[i][2], acc[i][3]));
}

template <class EP>
__device__ __forceinline__ void dense_gemm_phase(float* sm, int bid, int nb, const float* A, int lda, const float* B, int ldb, int M, int N, int K, const EP& epi) {
    const int ntn = (N + 63) / 64, nu = (M / 64) * ntn;
    for (int u = bid; u < nu; u += nb) {
        const int m0 = (u / ntn) * 64, n0 = (u % ntn) * 64;
        auto al = [&](int m, int k) { return *(const float4*)(A + (size_t)(m0 + m) * lda + k); };
        auto bl = [&](int k, int n) { return (n0 + n < N) ? *(const float4*)(B + (size_t)k * ldb + n0 + n) : make_float4(0.f, 0.f, 0.f, 0.f); };
        auto ep = [&](int m, int n, float4 v) { if (n0 + n < N) epi(m0 + m, n0 + n, v); };
        sgemm_unit(sm, K, al, bl, ep);
    }
}

__device__ void ph_inproj(const Params& p, float* sm, int bid, int nb) {
    float* P = p.P;
    dense_gemm_phase(sm, bid, nb, p.x, D, p.w_in, INW, T, INW, D, [=](int r, int c, float4 v) { *(float4*)(P + (size_t)r * INW + c) = v; });
}

__device__ void ph_rwkv_prep(const Params& p, float* sm, int bid, int nb) {
    float* xs = sm;
    float* th = sm + 1792;
    float* al = th + 64;
    float* sg = al + 64;
    const int tid = threadIdx.x;
    for (int t = bid; t < T; t += nb) {
        const int s = t & (S - 1);
        __syncthreads();
        for (int c = tid; c < RW_IN; c += NT) {
            const float cur = p.P[(size_t)t * INW + c];
            const float prev = (s > 0) ? p.P[(size_t)(t - 1) * INW + c] : 0.f;
            xs[c] = cur + (prev - cur) * p.mu[c];
        }
        __syncthreads();
        if (tid < 64) { th[tid] = tanhf(xs[C_WL + tid]); al[tid] = xs[C_AL + tid]; }
        if (tid < 128) sg[tid] = sigmoidf_(xs[C_GL + tid]);
        __syncthreads();
#pragma unroll 1
        for (int slot = 0; slot < 2; ++slot) {
            const int c = tid + slot * 256;
            float accw = 0.f, acca = 0.f, accg = 0.f;
#pragma unroll 4
            for (int j = 0; j < 64; ++j) { accw += th[j] * p.w2[j * 512 + c]; acca += al[j] * p.a2[j * 512 + c]; }
#pragma unroll 4
            for (int j = 0; j < 128; ++j) accg += sg[j] * p.g2[j * 512 + c];
            accw += p.w0[c]; acca += p.a0[c];
            const float nx = -accw;
            const float sp = (nx > 20.f) ? nx : log1pf(expf(nx));
            const float w = -sp - 0.5f;
            const float decay = expf(-expf(w));
            const float a = sigmoidf_(acca);
            const float kraw = xs[C_K + c];
            const float kkv = kraw * p.k_k[c];
            const float ss = wave_sum(kkv * kkv);
            const float nrm = fmaxf(sqrtf(ss), 1e-12f);
            const float kkn = kkv / nrm;
            const float k2 = kraw * (1.0f + (a - 1.0f) * p.k_a[c]);
            const size_t o = (size_t)t * 512 + c;
            p.R[o] = xs[C_R + c]; p.DC[o] = decay; p.K2[o] = k2; p.V[o] = xs[C_V + c]; p.KK[o] = kkn; p.BB[o] = kkn * a; p.G[o] = accg;
        }
    }
}

constexpr int SCH = 32;
__device__ void ph_scan(const Params& p, float* sm, int bid, int nb) {
    float* sr = sm;
    float* sd = sr + SCH * 64;
    float* sk = sd + SCH * 64;
    float* skk = sk + SCH * 64;
    float* sb = skk + SCH * 64;
    float* sv = sb + SCH * 64;
    float* so = sv + SCH * 16;
    const int tid = threadIdx.x, row = tid >> 4, q = tid & 15;
    for (int item = bid; item < 64; item += nb) {
        const int b = item >> 5, h = (item >> 2) & 7, qu = item & 3;
        float s0 = 0.f, s1 = 0.f, s2 = 0.f, s3 = 0.f;
        for (int t0 = 0; t0 < S; t0 += SCH) {
            __syncthreads();
            for (int i = tid; i < SCH * 16; i += NT) {
                const int st = i >> 4, part = i & 15;
                const size_t g = ((size_t)(b * S + t0 + st)) * 512 + h * 64 + part * 4;
                *(float4*)(sr + st * 64 + part * 4) = *(const float4*)(p.R + g);
                *(float4*)(sd + st * 64 + part * 4) = *(const float4*)(p.DC + g);
                *(float4*)(sk + st * 64 + part * 4) = *(const float4*)(p.K2 + g);
                *(float4*)(skk + st * 64 + part * 4) = *(const float4*)(p.KK + g);
                *(float4*)(sb + st * 64 + part * 4) = *(const float4*)(p.BB + g);
            }
            for (int i = tid; i < SCH * 16; i += NT) {
                const int st = i >> 4, r = i & 15;
                sv[i] = p.V[((size_t)(b * S + t0 + st)) * 512 + h * 64 + qu * 16 + r];
            }
            __syncthreads();
            for (int st = 0; st < SCH; ++st) {
                const float4 kk = *(const float4*)(skk + st * 64 + q * 4);
                const float4 dd = *(const float4*)(sd + st * 64 + q * 4);
                const float4 kv = *(const float4*)(sk + st * 64 + q * 4);
                const float4 bb = *(const float4*)(sb + st * 64 + q * 4);
                const float4 rr = *(const float4*)(sr + st * 64 + q * 4);
                const float vv = sv[st * 16 + row];
                float sa = -(s0 * kk.x + s1 * kk.y + s2 * kk.z + s3 * kk.w);
                sa += __shfl_xor(sa, 1); sa += __shfl_xor(sa, 2); sa += __shfl_xor(sa, 4); sa += __shfl_xor(sa, 8);
                s0 = s0 * dd.x + sa * bb.x + vv * kv.x;
                s1 = s1 * dd.y + sa * bb.y + vv * kv.y;
                s2 = s2 * dd.z + sa * bb.z + vv * kv.z;
                s3 = s3 * dd.w + sa * bb.w + vv * kv.w;
                float o = s0 * rr.x + s1 * rr.y + s2 * rr.z + s3 * rr.w;
                o += __shfl_xor(o, 1); o += __shfl_xor(o, 2); o += __shfl_xor(o, 4); o += __shfl_xor(o, 8);
                if (q == 0) so[st * 16 + row] = o;
            }
            __syncthreads();
            for (int i = tid; i < SCH * 16; i += NT) {
                const int st = i >> 4, r = i & 15;
                p.O[((size_t)(b * S + t0 + st)) * 512 + h * 64 + qu * 16 + r] = so[i];
            }
        }
    }
}

__device__ void ph_rwkv_post(const Params& p, float* sm, int bid, int nb) {
    const int tid = threadIdx.x;
    for (int t = bid; t < T; t += nb) {
#pragma unroll
        for (int slot = 0; slot < 2; ++slot) {
            const int c = tid + slot * 256;
            const size_t o = (size_t)t * 512 + c;
            const float ov = p.O[o];
            const float m = wave_sum(ov) * (1.0f / 64.0f);
            const float dl = ov - m;
            const float var = wave_sum(dl * dl) * (1.0f / 64.0f);
            const float on = dl * rsqrtf(var + 64e-5f) * p.lnx_w[c] + p.lnx_b[c];
            const float bon = wave_sum(p.R[o] * p.K2[o] * p.r_k[c]) * p.V[o];
            p.YA[o] = (on + bon) * p.G[o];
        }
    }
}

__device__ void ph_rope(const Params& p, float* sm, int bid, int nb) {
    const int tid = threadIdx.x;
    for (int t = bid; t < T; t += nb) {
        const int s = t & (S - 1);
        for (int pi = tid; pi < 12 * 32; pi += NT) {
            const int hs = pi >> 5, i = pi & 31;
            const float inv = (float)pow(10000.0, -(double)i / 32.0);
            const float ang = (float)s * inv;
            float sn, cs; sincosf(ang, &sn, &cs);
            const float* src; float* dst;
            if (hs < 8) { src = p.P + (size_t)t * INW + C_Q + hs * 64; dst = p.QR + (size_t)t * 512 + hs * 64; }
            else if (hs < 10) { src = p.P + (size_t)t * INW + C_KS + (hs - 8) * 64; dst = p.KSR + (size_t)t * 128 + (hs - 8) * 64; }
            else { src = p.P + (size_t)t * INW + C_KW + (hs - 10) * 64; dst = p.KWR + (size_t)t * 128 + (hs - 10) * 64; }
            const float x1 = src[i], x2 = src[i + 32];
            dst[i] = x1 * cs - x2 * sn;
            dst[i + 32] = x2 * cs + x1 * sn;
        }
    }
}

__device__ void ph_cmp1(const Params& p, float* sm, int bid, int nb) {
    const int nmt = (NCROWS + 63) / 64;
    const int nu = 2 * nmt * 4;
    for (int u = bid; u < nu; u += nb) {
        const int kv = u / (nmt * 4), m0 = ((u / 4) % nmt) * 64, n0 = (u % 4) * 64;
        const float* pe = kv ? p.pe_v : p.pe_k; const float* w1 = kv ? p.w1_v : p.w1_k; float* H1 = kv ? p.H1V : p.H1K;
        const int ccol = kv ? C_VC : C_KC;
        const float* P = p.P;
        auto al = [&](int m, int k) {
            const int r = m0 + m;
            if (r >= NCROWS) return make_float4(0.f, 0.f, 0.f, 0.f);
            const int g = r & 1, bc = r >> 1, b = bc / NCMP, c = bc % NCMP;
            const int tok = k >> 6, d = k & 63;
            const float4 v = *(const float4*)(P + (size_t)(b * S + 16 * c + tok) * INW + ccol + g * 64 + d);
            const float4 e = *(const float4*)(pe + tok * 64 + d);
            return make_float4(v.x + e.x, v.y + e.y, v.z + e.z, v.w + e.w);
        };
        auto bl = [&](int k, int n) { return *(const float4*)(w1 + (size_t)k * 256 + n0 + n); };
        auto ep = [&](int m, int n, float4 v) {
            const int r = m0 + m;
            if (r < NCROWS) *(float4*)(H1 + (size_t)r * 256 + n0 + n) = make_float4(gelu_tanh(v.x), gelu_tanh(v.y), gelu_tanh(v.z), gelu_tanh(v.w));
        };
        sgemm_unit(sm, 2048, al, bl, ep);
    }
}
__device__ void ph_cmp2(const Params& p, float* sm, int bid, int nb) {
    const int nmt = (NCROWS + 63) / 64;
    const int nu = 2 * nmt;
    for (int u = bid; u < nu; u += nb) {
        const int kv = u / nmt, m0 = (u % nmt) * 64;
        const float* H1 = kv ? p.H1V : p.H1K; const float* w2 = kv ? p.w2_v : p.w2_k; float* OUT = kv ? p.VC : p.KCraw;
        auto al = [&](int m, int k) { const int r = m0 + m; return (r < NCROWS) ? *(const float4*)(H1 + (size_t)r * 256 + k) : make_float4(0.f, 0.f, 0.f, 0.f); };
        auto bl = [&](int k, int n) { return *(const float4*)(w2 + (size_t)k * 64 + n); };
        auto ep = [&](int m, int n, float4 v) { const int r = m0 + m; if (r < NCROWS) *(float4*)(OUT + (size_t)r * 64 + n) = v; };
        sgemm_unit(sm, 256, al, bl, ep);
    }
}
__device__ void ph_cmp_rope(const Params& p, float* sm, int bid, int nb) {
    const int tid = threadIdx.x;
    for (int i = bid * NT + tid; i < NCROWS * 32; i += nb * NT) {
        const int r = i >> 5, d = i & 31;
        const int c = (r >> 1) % NCMP;
        const float inv = (float)pow(10000.0, -(double)d / 32.0);
        const float ang = (float)(16 * c + 31) * inv;
        float sn, cs; sincosf(ang, &sn, &cs);
        const float x1 = p.KCraw[(size_t)r * 64 + d], x2 = p.KCraw[(size_t)r * 64 + d + 32];
        p.KCR[(size_t)r * 64 + d] = x1 * cs - x2 * sn;
        p.KCR[(size_t)r * 64 + d + 32] = x2 * cs + x1 * sn;
    }
}

__device__ void ph_nsa(const Params& p, float* sm, int bid, int nb) {
    float* qs = sm;
    float* sc = sm + 256;
    float* impv = sc + 4096;
    float* scorev = impv + 128;
    int* sel = (int*)(scorev + 128);
    const int tid = threadIdx.x, wave = tid >> 6, lane = tid & 63;
    for (int item = bid; item < T * 2; item += nb) {
        const int g = item & 1, t = item >> 1, b = t >> 13, s = t & (S - 1);
        __syncthreads();
        qs[tid] = p.QR[(size_t)t * 512 + g * 256 + tid] * 0.125f;
        if (tid < 16) sel[tid] = -1;
        __syncthreads();
        const int nv = (s >= 31) ? ((s - 31) >> 4) + 1 : 0;
        for (int c = tid; c < 516; c += NT) {
            float d0 = 0.f, d1 = 0.f, d2 = 0.f, d3 = 0.f;
            if (c < nv) {
                const float* kr = p.KCR + ((size_t)(b * NCMP + c) * 2 + g) * 64;
                for (int d = 0; d < 64; d += 4) {
                    const float4 kq = *(const float4*)(kr + d);
                    const float4 q0 = *(const float4*)(qs + d), q1 = *(const float4*)(qs + 64 + d), q2 = *(const float4*)(qs + 128 + d), q3 = *(const float4*)(qs + 192 + d);
                    d0 += kq.x * q0.x + kq.y * q0.y + kq.z * q0.z + kq.w * q0.w;
                    d1 += kq.x * q1.x + kq.y * q1.y + kq.z * q1.z + kq.w * q1.w;
                    d2 += kq.x * q2.x + kq.y * q2.y + kq.z * q2.z + kq.w * q2.w;
                    d3 += kq.x * q3.x + kq.y * q3.y + kq.z * q3.z + kq.w * q3.w;
                }
            }
            sc[c] = d0; sc[1024 + c] = d1; sc[2048 + c] = d2; sc[3072 + c] = d3;
        }
        __syncthreads();
        {
            float* row = sc + wave * 1024;
            float mx = -1e30f;
            for (int c = lane; c < nv; c += 64) mx = fmaxf(mx, row[c]);
            mx = wave_max(mx);
            float sum = 0.f;
            for (int c = lane; c < nv; c += 64) { const float e = expf(row[c] - mx); row[c] = e; sum += e; }
            sum = wave_sum(sum);
            const float inv = (nv > 0) ? 1.0f / sum : 0.f;
            for (int c = lane; c < 516; c += 64) row[c] = (c < nv) ? row[c] * inv : 0.f;
        }
        __syncthreads();
        float oc = 0.f;
        {
            const float* row = sc + wave * 1024;
            const float* vb = p.VC + ((size_t)(b * NCMP) * 2 + g) * 64 + lane;
            for (int c = 0; c < nv; ++c) oc += row[c] * vb[(size_t)c * 128];
        }
        if (tid < 128) {
            const int j = tid, c0 = 4 * j;
            float acc = 0.f;
#pragma unroll
            for (int n = 0; n < 4; ++n) {
                const float* row = sc + n * 1024;
                acc += ((c0 > 0) ? row[c0 - 1] : 0.f) + 2.0f * (row[c0] + row[c0 + 1] + row[c0 + 2]) + row[c0 + 3];
            }
            impv[j] = acc;
        }
        __syncthreads();
        const int cur = s >> 6;
        if (tid < 128) {
            const int j = tid;
            const bool valid = (j <= cur);
            const bool forced = (j == 0) || (j == cur) || (j == cur - 1);
            scorev[j] = valid ? (impv[j] + (forced ? 1e4f : 0.f)) : -1.0f;
        }
        __syncthreads();
        if (tid < 128) {
            const float my = scorev[tid];
            int rank = 0;
            for (int i = 0; i < 128; ++i) { const float o = scorev[i]; rank += (o > my || (o == my && i < tid)) ? 1 : 0; }
            if (rank < 16) sel[rank] = (my >= 0.f) ? tid : -1;
        }
        __syncthreads();
        for (int i = 0; i < 4; ++i) {
            const int kidx = tid + 256 * i, slot = kidx >> 6, l = kidx & 63;
            const int blk = sel[slot];
            const int pos = blk * 64 + l;
            const bool ok = (blk >= 0) && (pos <= s);
            float d0 = 0.f, d1 = 0.f, d2 = 0.f, d3 = 0.f;
            if (ok) {
                const float* kr = p.KSR + ((size_t)(b * S + pos)) * 128 + g * 64;
                for (int d = 0; d < 64; d += 4) {
                    const float4 kq = *(const float4*)(kr + d);
                    const float4 q0 = *(const float4*)(qs + d), q1 = *(const float4*)(qs + 64 + d), q2 = *(const float4*)(qs + 128 + d), q3 = *(const float4*)(qs + 192 + d);
                    d0 += kq.x * q0.x + kq.y * q0.y + kq.z * q0.z + kq.w * q0.w;
                    d1 += kq.x * q1.x + kq.y * q1.y + kq.z * q1.z + kq.w * q1.w;
                    d2 += kq.x * q2.x + kq.y * q2.y + kq.z * q2.z + kq.w * q2.w;
                    d3 += kq.x * q3.x + kq.y * q3.y + kq.z * q3.z + kq.w * q3.w;
                }
            }
            sc[kidx] = ok ? d0 : -1e30f; sc[1024 + kidx] = ok ? d1 : -1e30f; sc[2048 + kidx] = ok ? d2 : -1e30f; sc[3072 + kidx] = ok ? d3 : -1e30f;
        }
        __syncthreads();
        {
            float* row = sc + wave * 1024;
            float mx = -1e30f;
            for (int c = lane; c < 1024; c += 64) mx = fmaxf(mx, row[c]);
            mx = wave_max(mx);
            float sum = 0.f;
            for (int c = lane; c < 1024; c += 64) { const float v = row[c]; const float e = (v > -1e29f) ? expf(v - mx) : 0.f; row[c] = e; sum += e; }
            sum = wave_sum(sum);
            const float inv = (sum > 0.f) ? 1.0f / sum : 0.f;
            for (int c = lane; c < 1024; c += 64) row[c] *= inv;
        }
        __syncthreads();
        float os = 0.f;
        {
            const float* row = sc + wave * 1024;
            for (int slot = 0; slot < 16; ++slot) {
                const int blk = sel[slot];
                if (blk < 0) continue;
                const float* vb = p.P + ((size_t)(b * S + blk * 64)) * INW + C_VS + g * 64 + lane;
                for (int l = 0; l < 64; ++l) os += row[slot * 64 + l] * vb[(size_t)l * INW];
            }
        }
        __syncthreads();
        const int nk = (s + 1 < 512) ? s + 1 : 512;
        const int first = s - nk + 1;
        for (int i = 0; i < 2; ++i) {
            const int kidx = tid + 256 * i;
            const bool ok = kidx < nk;
            float d0 = 0.f, d1 = 0.f, d2 = 0.f, d3 = 0.f;
            if (ok) {
                const float* kr = p.KWR + ((size_t)(b * S + first + kidx)) * 128 + g * 64;
                for (int d = 0; d < 64; d += 4) {
                    const float4 kq = *(const float4*)(kr + d);
                    const float4 q0 = *(const float4*)(qs + d), q1 = *(const float4*)(qs + 64 + d), q2 = *(const float4*)(qs + 128 + d), q3 = *(const float4*)(qs + 192 + d);
                    d0 += kq.x * q0.x + kq.y * q0.y + kq.z * q0.z + kq.w * q0.w;
                    d1 += kq.x * q1.x + kq.y * q1.y + kq.z * q1.z + kq.w * q1.w;
                    d2 += kq.x * q2.x + kq.y * q2.y + kq.z * q2.z + kq.w * q2.w;
                    d3 += kq.x * q3.x + kq.y * q3.y + kq.z * q3.z + kq.w * q3.w;
                }
            }
            sc[kidx] = ok ? d0 : -1e30f; sc[1024 + kidx] = ok ? d1 : -1e30f; sc[2048 + kidx] = ok ? d2 : -1e30f; sc[3072 + kidx] = ok ? d3 : -1e30f;
        }
        __syncthreads();
        {
            float* row = sc + wave * 1024;
            float mx = -1e30f;
            for (int c = lane; c < 512; c += 64) mx = fmaxf(mx, row[c]);
            mx = wave_max(mx);
            float sum = 0.f;
            for (int c = lane; c < 512; c += 64) { const float v = row[c]; const float e = (v > -1e29f) ? expf(v - mx) : 0.f; row[c] = e; sum += e; }
            sum = wave_sum(sum);
            const float inv = (sum > 0.f) ? 1.0f / sum : 0.f;
            for (int c = lane; c < 512; c += 64) row[c] *= inv;
        }
        __syncthreads();
        float ow = 0.f;
        {
            const float* row = sc + wave * 1024;
            const float* vb = p.P + ((size_t)(b * S + first)) * INW + C_VW + g * 64 + lane;
            for (int l = 0; l < nk; ++l) ow += row[l] * vb[(size_t)l * INW];
        }
        const int h = g * 4 + wave;
        const float* gp = p.P + (size_t)t * INW + C_GT + h * 3;
        const float g0 = sigmoidf_(gp[0]), g1 = sigmoidf_(gp[1]), g2 = sigmoidf_(gp[2]);
        p.YB[(size_t)t * 512 + h * 64 + lane] = g0 * oc + g1 * os + g2 * ow;
    }
}

__device__ void ph_branch_a(const Params& p, float* sm, int bid, int nb) {
    const float* P = p.P; float* Z = p.Z;
    dense_gemm_phase(sm, bid, nb, p.YA, 512, p.wba, D, T, D, 512, [=](int r, int c, float4 v) {
        const float4 gq = *(const float4*)(P + (size_t)r * INW + C_GA + c);
        *(float4*)(Z + (size_t)r * D + c) = make_float4(sigmoidf_(gq.x) * v.x, sigmoidf_(gq.y) * v.y, sigmoidf_(gq.z) * v.z, sigmoidf_(gq.w) * v.w);
    });
}
__device__ void ph_branch_b(const Params& p, float* sm, int bid, int nb) {
    const float* P = p.P; float* Z = p.Z;
    dense_gemm_phase(sm, bid, nb, p.YB, 512, p.wbb, D, T, D, 512, [=](int r, int c, float4 v) {
        const float4 gq = *(const float4*)(P + (size_t)r * INW + C_GB + c);
        float4 z = *(float4*)(Z + (size_t)r * D + c);
        z.x += sigmoidf_(gq.x) * v.x; z.y += sigmoidf_(gq.y) * v.y; z.z += sigmoidf_(gq.z) * v.z; z.w += sigmoidf_(gq.w) * v.w;
        *(float4*)(Z + (size_t)r * D + c) = z;
    });
}
__device__ void ph_outproj(const Params& p, float* sm, int bid, int nb) {
    const float* x = p.x; float* PRE1 = p.PRE1;
    dense_gemm_phase(sm, bid, nb, p.Z, D, p.wout, D, T, D, D, [=](int r, int c, float4 v) {
        const float4 xv = *(const float4*)(x + (size_t)r * D + c);
        *(float4*)(PRE1 + (size_t)r * D + c) = make_float4(ALPHA * xv.x + v.x, ALPHA * xv.y + v.y, ALPHA * xv.z + v.z, ALPHA * xv.w + v.w);
    });
}
__device__ __forceinline__ void ln_rows(float* sm, int bid, int nb, const float* src, float* dst, const float* gam, const float* bet) {
    const int tid = threadIdx.x, wave = tid >> 6, lane = tid & 63;
    for (int t = bid; t < T; t += nb) {
        const float4 v = *(const float4*)(src + (size_t)t * D + tid * 4);
        float s = (v.x + v.y) + (v.z + v.w);
        s = wave_sum(s);
        __syncthreads();
        if (lane == 0) sm[wave] = s;
        __syncthreads();
        const float mean = (sm[0] + sm[1] + sm[2] + sm[3]) * (1.0f / D);
        const float dx = v.x - mean, dy = v.y - mean, dz = v.z - mean, dw = v.w - mean;
        float q = (dx * dx + dy * dy) + (dz * dz + dw * dw);
        q = wave_sum(q);
        __syncthreads();
        if (lane == 0) sm[wave] = q;
        __syncthreads();
        const float rstd = rsqrtf((sm[0] + sm[1] + sm[2] + sm[3]) * (1.0f / D) + 1e-5f);
        const float4 gq = *(const float4*)(gam + tid * 4), bq = *(const float4*)(bet + tid * 4);
        *(float4*)(dst + (size_t)t * D + tid * 4) = make_float4(dx * rstd * gq.x + bq.x, dy * rstd * gq.y + bq.y, dz * rstd * gq.z + bq.z, dw * rstd * gq.w + bq.w);
    }
}
__device__ void ph_ln1(const Params& p, float* sm, int bid, int nb) { ln_rows(sm, bid, nb, p.PRE1, p.X1, p.ln1g, p.ln1b); }

__device__ void ph_router_gemm(const Params& p, float* sm, int bid, int nb) {
    float* L = p.LOGITS;
    dense_gemm_phase(sm, bid, nb, p.X1, D, p.rw, NE, T, NE, D, [=](int r, int c, float4 v) { *(float4*)(L + (size_t)r * NE + c) = v; });
}
__device__ void ph_router_sel(const Params& p, float* sm, int bid, int nb) {
    float* chs = sm;
    float* scs = sm + 256;
    float* gs = sm + 512;
    int* gsel = (int*)(sm + 520);
    float* ew = sm + 528;
    int* ei = (int*)(sm + 536);
    const int e = threadIdx.x;
    for (int t = bid; t < T; t += nb) {
        __syncthreads();
        const float sc = sigmoidf_(p.LOGITS[(size_t)t * NE + e]);
        const float ch = sc + p.rbias[e];
        chs[e] = ch; scs[e] = sc;
        __syncthreads();
        if (e < 8) {
            float m1 = -3e38f; int i1 = -1;
            for (int i = 0; i < 32; ++i) { const float v = chs[e * 32 + i]; if (v > m1) { m1 = v; i1 = i; } }
            float m2 = -3e38f;
            for (int i = 0; i < 32; ++i) { const float v = chs[e * 32 + i]; if (i != i1 && v > m2) m2 = v; }
            gs[e] = m1 + m2;
        }
        __syncthreads();
        if (e < 8) {
            const float my = gs[e]; int rank = 0;
            for (int i = 0; i < 8; ++i) { const float o = gs[i]; rank += (o > my || (o == my && i < e)) ? 1 : 0; }
            gsel[e] = (rank < 4) ? 1 : 0;
        }
        __syncthreads();
        const float mch = gsel[e >> 5] ? ch : -1e30f;
        __syncthreads();
        chs[e] = mch;
        __syncthreads();
        {
            int rank = 0;
            for (int i = 0; i < 256; ++i) { const float o = chs[i]; rank += (o > mch || (o == mch && i < e)) ? 1 : 0; }
            if (rank < 8) { ei[rank] = e; ew[rank] = sc; }
        }
        __syncthreads();
        if (e < 8) {
            const float sum = ((ew[0] + ew[1]) + (ew[2] + ew[3])) + ((ew[4] + ew[5]) + (ew[6] + ew[7]));
            p.EIDX[(size_t)t * 8 + e] = ei[e];
            p.EW[(size_t)t * 8 + e] = ew[e] / sum * 2.5f;
        }
    }
}
__device__ void ph_lists(const Params& p, float* sm, int bid, int nb) {
    int* wcnt = (int*)sm;
    const int tid = threadIdx.x, wave = tid >> 6, lane = tid & 63;
    for (int e = bid; e < NE; e += nb) {
        int base = 0;
        for (int a0 = 0; a0 < T * 8; a0 += NT) {
            const bool f = (p.EIDX[a0 + tid] == e);
            const unsigned long long m = __ballot(f);
            const int before = __popcll(m & ((1ull << lane) - 1ull));
            __syncthreads();
            if (lane == 0) wcnt[wave] = __popcll(m);
            __syncthreads();
            int off = base;
            for (int w = 0; w < wave; ++w) off += wcnt[w];
            if (f && off + before < LISTCAP) p.LIST[(size_t)e * LISTCAP + off + before] = a0 + tid;
            base += wcnt[0] + wcnt[1] + wcnt[2] + wcnt[3];
        }
        if (tid == 0) p.CNT[e] = base < LISTCAP ? base : LISTCAP;
    }
}
__device__ void ph_moe_gu(const Params& p, float* sm, int bid, int nb) {
    const int nu = NE * 256 * 8;
    for (int u = bid; u < nu; u += nb) {
        const int mt = u / (NE * 8), e = (u / 8) % NE, n0 = (u % 8) * 64;
        const int cnt = p.CNT[e];
        if (mt * 64 >= cnt) continue;
        const int* lst = p.LIST + (size_t)e * LISTCAP + mt * 64;
        const int nrow = cnt - mt * 64;
        const float* X1 = p.X1; const float* W = p.egu + (size_t)e * D * 512; float* HGU = p.HGU;
        auto al = [&](int m, int k) { if (m >= nrow) return make_float4(0.f, 0.f, 0.f, 0.f); const int a = lst[m]; return *(const float4*)(X1 + (size_t)(a >> 3) * D + k); };
        auto bl = [&](int k, int n) { return *(const float4*)(W + (size_t)k * 512 + n0 + n); };
        auto ep = [&](int m, int n, float4 v) { if (m < nrow) { const int a = lst[m]; *(float4*)(HGU + (size_t)a * 512 + n0 + n) = v; } };
        sgemm_unit(sm, D, al, bl, ep);
    }
}
__device__ void ph_moe_down(const Params& p, float* sm, int bid, int nb) {
    const int nu = NE * 256 * 16;
    for (int u = bid; u < nu; u += nb) {
        const int mt = u / (NE * 16), e = (u / 16) % NE, n0 = (u % 16) * 64;
        const int cnt = p.CNT[e];
        if (mt * 64 >= cnt) continue;
        const int* lst = p.LIST + (size_t)e * LISTCAP + mt * 64;
        const int nrow = cnt - mt * 64;
        const float* HGU = p.HGU; const float* W = p.edown + (size_t)e * 256 * D; float* Y = p.Y; const float* EW = p.EW;
        auto al = [&](int m, int k) {
            if (m >= nrow) return make_float4(0.f, 0.f, 0.f, 0.f);
            const int a = lst[m];
            const float4 gq = *(const float4*)(HGU + (size_t)a * 512 + k), uq = *(const float4*)(HGU + (size_t)a * 512 + 256 + k);
            return make_float4(gq.x * sigmoidf_(gq.x) * uq.x, gq.y * sigmoidf_(gq.y) * uq.y, gq.z * sigmoidf_(gq.z) * uq.z, gq.w * sigmoidf_(gq.w) * uq.w);
        };
        auto bl = [&](int k, int n) { return *(const float4*)(W + (size_t)k * D + n0 + n); };
        auto ep = [&](int m, int n, float4 v) { if (m < nrow) { const int a = lst[m]; const float w = EW[a]; *(float4*)(Y + (size_t)a * D + n0 + n) = make_float4(v.x * w, v.y * w, v.z * w, v.w * w); } };
        sgemm_unit(sm, 256, al, bl, ep);
    }
}
__device__ void ph_shared_gu(const Params& p, float* sm, int bid, int nb) {
    float* HS = p.HS;
    dense_gemm_phase(sm, bid, nb, p.X1, D, p.sgu, 512, T, 512, D, [=](int r, int c, float4 v) { *(float4*)(HS + (size_t)r * 512 + c) = v; });
}
__device__ void ph_shared_down(const Params& p, float* sm, int bid, int nb) {
    const int nu = (T / 64) * 16;
    for (int u = bid; u < nu; u += nb) {
        const int m0 = (u / 16) * 64, n0 = (u % 16) * 64;
        const float* HS = p.HS; const float* W = p.sdown; float* SH = p.SH;
        auto al = [&](int m, int k) {
            const float4 gq = *(const float4*)(HS + (size_t)(m0 + m) * 512 + k), uq = *(const float4*)(HS + (size_t)(m0 + m) * 512 + 256 + k);
            return make_float4(gq.x * sigmoidf_(gq.x) * uq.x, gq.y * sigmoidf_(gq.y) * uq.y, gq.z * sigmoidf_(gq.z) * uq.z, gq.w * sigmoidf_(gq.w) * uq.w);
        };
        auto bl = [&](int k, int n) { return *(const float4*)(W + (size_t)k * D + n0 + n); };
        auto ep = [&](int m, int n, float4 v) { *(float4*)(SH + (size_t)(m0 + m) * D + n0 + n) = v; };
        sgemm_unit(sm, 256, al, bl, ep);
    }
}
__device__ void ph_final(const Params& p, float* sm, int bid, int nb) {
    const int tid = threadIdx.x, wave = tid >> 6, lane = tid & 63;
    for (int t = bid; t < T; t += nb) {
        const float4 xv = *(const float4*)(p.X1 + (size_t)t * D + tid * 4);
        float4 v = *(const float4*)(p.SH + (size_t)t * D + tid * 4);
        float4 r = make_float4(0.f, 0.f, 0.f, 0.f);
#pragma unroll
        for (int k = 0; k < 8; ++k) { const float4 y = *(const float4*)(p.Y + ((size_t)t * 8 + k) * D + tid * 4); r.x += y.x; r.y += y.y; r.z += y.z; r.w += y.w; }
        v.x = ALPHA * xv.x + (r.x + v.x); v.y = ALPHA * xv.y + (r.y + v.y); v.z = ALPHA * xv.z + (r.z + v.z); v.w = ALPHA * xv.w + (r.w + v.w);
        float s = (v.x + v.y) + (v.z + v.w);
        s = wave_sum(s);
        __syncthreads();
        if (lane == 0) sm[wave] = s;
        __syncthreads();
        const float mean = (sm[0] + sm[1] + sm[2] + sm[3]) * (1.0f / D);
        const float dx = v.x - mean, dy = v.y - mean, dz = v.z - mean, dw = v.w - mean;
        float q = (dx * dx + dy * dy) + (dz * dz + dw * dw);
        q = wave_sum(q);
        __syncthreads();
        if (lane == 0) sm[wave] = q;
        __syncthreads();
        const float rstd = rsqrtf((sm[0] + sm[1] + sm[2] + sm[3]) * (1.0f / D) + 1e-5f);
        const float4 gq = *(const float4*)(p.ln2g + tid * 4), bq = *(const float4*)(p.ln2b + tid * 4);
        *(float4*)(p.out + (size_t)t * D + tid * 4) = make_float4(dx * rstd * gq.x + bq.x, dy * rstd * gq.y + bq.y, dz * rstd * gq.z + bq.z, dw * rstd * gq.w + bq.w);
    }
}

constexpr int SM_FLOATS = 12288;

#define DEF_KERNEL(name) \
    __global__ void __launch_bounds__(NT) k_##name(Params p) { __shared__ __attribute__((aligned(16))) float sm[SM_FLOATS]; ph_##name(p, sm, (int)blockIdx.x, (int)gridDim.x); }


namespace cg = cooperative_groups;
__global__ void __launch_bounds__(NT) mega(Params p) {
    __shared__ __attribute__((aligned(16))) float sm[SM_FLOATS];
    cg::grid_group grid = cg::this_grid();
    const int bid = (int)blockIdx.x, nb = (int)gridDim.x;
    ph_inproj(p, sm, bid, nb); grid.sync();
    ph_rwkv_prep(p, sm, bid, nb); ph_rope(p, sm, bid, nb); ph_cmp1(p, sm, bid, nb); grid.sync();
    ph_cmp2(p, sm, bid, nb); grid.sync();
    ph_cmp_rope(p, sm, bid, nb); grid.sync();
    if (bid < 64) ph_scan(p, sm, bid, 64); else ph_nsa(p, sm, bid - 64, nb - 64);
    grid.sync();
    ph_rwkv_post(p, sm, bid, nb); grid.sync();
    ph_branch_a(p, sm, bid, nb); ph_branch_b(p, sm, bid, nb); grid.sync();
    ph_outproj(p, sm, bid, nb); grid.sync();
    ph_ln1(p, sm, bid, nb); grid.sync();
    ph_router_gemm(p, sm, bid, nb); ph_shared_gu(p, sm, bid, nb); grid.sync();
    ph_router_sel(p, sm, bid, nb); ph_shared_down(p, sm, bid, nb); grid.sync();
    ph_lists(p, sm, bid, nb); grid.sync();
    ph_moe_gu(p, sm, bid, nb); grid.sync();
    ph_moe_down(p, sm, bid, nb); grid.sync();
    ph_final(p, sm, bid, nb);
}
}

extern "C" void kernel_launch(void* const* d_in, const int* in_sizes, int n_in, void* d_out, int out_size, void* d_ws, size_t ws_size, hipStream_t stream) {
    Params p{};
    const float* const* in = (const float* const*)d_in;
    p.x = in[0]; p.w_in = in[1]; p.mu = in[2]; p.w0 = in[3]; p.w2 = in[4]; p.a0 = in[5]; p.a2 = in[6]; p.g2 = in[7]; p.k_k = in[8]; p.k_a = in[9];
    p.r_k = in[10]; p.lnx_w = in[11]; p.lnx_b = in[12]; p.pe_k = in[13]; p.w1_k = in[14]; p.w2_k = in[15]; p.pe_v = in[16]; p.w1_v = in[17]; p.w2_v = in[18];
    p.wba = in[19]; p.wbb = in[20]; p.wout = in[21]; p.ln1g = in[22]; p.ln1b = in[23]; p.rw = in[24]; p.rbias = in[25]; p.egu = in[26]; p.edown = in[27];
    p.sgu = in[28]; p.sdown = in[29]; p.ln2g = in[30]; p.ln2b = in[31];
    p.out = (float*)d_out;
    char* w = (char*)d_ws; size_t off = 0;
    auto carve = [&](size_t bytes) { char* r = w + off; off += (bytes + 255) & ~(size_t)255; return r; };
    p.P = (float*)carve((size_t)T * INW * 4);
    p.R = (float*)carve((size_t)T * 512 * 4); p.DC = (float*)carve((size_t)T * 512 * 4); p.K2 = (float*)carve((size_t)T * 512 * 4); p.V = (float*)carve((size_t)T * 512 * 4);
    p.KK = (float*)carve((size_t)T * 512 * 4); p.BB = (float*)carve((size_t)T * 512 * 4); p.G = (float*)carve((size_t)T * 512 * 4);
    p.O = (float*)carve((size_t)T * 512 * 4); p.YA = (float*)carve((size_t)T * 512 * 4);
    p.QR = (float*)carve((size_t)T * 512 * 4); p.KSR = (float*)carve((size_t)T * 128 * 4); p.KWR = (float*)carve((size_t)T * 128 * 4);
    p.KCraw = (float*)carve((size_t)NCROWS * 64 * 4); p.KCR = (float*)carve((size_t)NCROWS * 64 * 4); p.VC = (float*)carve((size_t)NCROWS * 64 * 4);
    p.H1K = (float*)carve((size_t)NCROWS * 256 * 4); p.H1V = (float*)carve((size_t)NCROWS * 256 * 4);
    p.YB = (float*)carve((size_t)T * 512 * 4);
    p.Z = (float*)carve((size_t)T * D * 4); p.PRE1 = (float*)carve((size_t)T * D * 4); p.X1 = (float*)carve((size_t)T * D * 4);
    p.LOGITS = (float*)carve((size_t)T * NE * 4); p.EW = (float*)carve((size_t)T * 8 * 4); p.EIDX = (int*)carve((size_t)T * 8 * 4);
    p.LIST = (int*)carve((size_t)NE * LISTCAP * 4); p.CNT = (int*)carve(1024);
    p.HS = (float*)carve((size_t)T * 512 * 4); p.SH = (float*)carve((size_t)T * D * 4);
    p.HGU = (float*)carve((size_t)T * 8 * 512 * 4);
    p.Y = (float*)carve((size_t)T * 8 * D * 4);
    if (off > ws_size) { fprintf(stderr, "kernel_launch: workspace too small: need %zu have %zu\n", off, ws_size); return; }
    static int grid_blocks = 0;
    if (!grid_blocks) {
        int dev = 0, cus = 0, per_cu = 0;
        hipGetDevice(&dev);
        hipDeviceGetAttribute(&cus, hipDeviceAttributeMultiprocessorCount, dev);
        hipOccupancyMaxActiveBlocksPerMultiprocessor(&per_cu, mega, NT, 0);
        if (per_cu > 2) per_cu = 2;
        if (per_cu < 1) per_cu = 1;
        grid_blocks = cus * per_cu;
    }
    void* args[] = {&p};
    hipError_t e = hipLaunchCooperativeKernel((void*)mega, dim3(grid_blocks), dim3(NT), args, 0, stream);
    if (e != hipSuccess) fprintf(stderr, "cooperative launch failed: %s (grid %d)\n", hipGetErrorString(e), grid_blocks);
}
```

```cpp
#include <hip/hip_runtime.h>
#include <hip/hip_cooperative_groups.h>
#include <cstdio>
#include <cstdint>
#include <cmath>

namespace {

constexpr int NB = 2, S = 8192, T = NB * S, D = 1024, INW = 5144;
constexpr int C_R = 0, C_K = 512, C_V = 1024, C_WL = 1536, C_AL = 1600, C_GL = 1664, RW_IN = 1792;
constexpr int C_Q = 1792, C_KC = 2304, C_VC = 2432, C_KS = 2560, C_VS = 2688, C_KW = 2816, C_VW = 2944, C_GT = 3072;
constexpr int C_GA = 3096, C_GB = 4120;
constexpr int NCMP = 511, NCROWS = NB * NCMP * 2;
constexpr int NE = 256, TOPK = 8, LISTCAP = 16384;
constexpr float ALPHA = 1.189207115002721f;
constexpr float QSCALE = 0.125f * 1.4426950408889634f;
constexpr int NT = 256;

struct Params {
    const float *x, *w_in, *mu, *w0, *w2, *a0, *a2, *g2, *k_k, *k_a, *r_k, *lnx_w, *lnx_b;
    const float *pe_k, *w1_k, *w2_k, *pe_v, *w1_v, *w2_v, *wba, *wbb, *wout, *ln1g, *ln1b;
    const float *rw, *rbias, *egu, *edown, *sgu, *sdown, *ln2g, *ln2b;
    float* out;
    float *P, *R, *DC, *K2, *V, *KK, *BB, *G, *O, *YA, *QR, *KSR, *KWR, *KCraw, *KCR, *VC, *H1K, *H1V, *YB, *Z, *PRE1, *X1;
    float *LOGITS, *EW, *Y, *SH;
    unsigned short *ACT, *ACTS, *Xb, *YAb, *YBb, *Zb, *X1b;
    unsigned short *Qb, *KSb, *VSb, *KWb, *VWb, *KCb, *VCb;
    float *GT, *OC, *OS, *OW, *OCf, *OSf, *OWf;
    unsigned *SELM, *SELMf;
    int *EIDX, *LIST, *CNT;
    int pad_[2];
};

__device__ __forceinline__ float wave_sum(float v) {
#pragma unroll
    for (int o = 1; o < 64; o <<= 1) v += __shfl_xor(v, o);
    return v;
}
__device__ __forceinline__ float wave_max(float v) {
#pragma unroll
    for (int o = 1; o < 64; o <<= 1) v = fmaxf(v, __shfl_xor(v, o));
    return v;
}
__device__ __forceinline__ float sigmoidf_(float x) { return 1.0f / (1.0f + expf(-x)); }
__device__ __forceinline__ float gelu_tanh(float x) { return 0.5f * x * (1.0f + tanhf(0.7978845608028654f * (x + 0.044715f * x * x * x))); }

template <class AL, class BL, class EP>
__device__ __forceinline__ void sgemm_unit(float* sm, int K, const AL& aload, const BL& bload, const EP& epi) {
    float (*As)[68] = (float (*)[68])sm;
    float (*Bs)[68] = (float (*)[68])(sm + 16 * 68);
    const int tid = threadIdx.x, ty = tid >> 4, tx = tid & 15;
    const int arow = tid >> 2, ak = (tid & 3) * 4, bk = tid >> 4, bn = (tid & 15) * 4;
    float acc[4][4];
#pragma unroll
    for (int i = 0; i < 4; ++i)
#pragma unroll
        for (int j = 0; j < 4; ++j) acc[i][j] = 0.f;
    for (int k0 = 0; k0 < K; k0 += 16) {
        const float4 av = aload(arow, k0 + ak);
        const float4 bv = bload(k0 + bk, bn);
        __syncthreads();
        As[ak + 0][arow] = av.x; As[ak + 1][arow] = av.y; As[ak + 2][arow] = av.z; As[ak + 3][arow] = av.w;
        *(float4*)&Bs[bk][bn] = bv;
        __syncthreads();
#pragma unroll
        for (int k = 0; k < 16; ++k) {
            const float4 a = *(const float4*)&As[k][ty * 4];
            const float4 b = *(const float4*)&Bs[k][tx * 4];
            acc[0][0] += a.x * b.x; acc[0][1] += a.x * b.y; acc[0][2] += a.x * b.z; acc[0][3] += a.x * b.w;
            acc[1][0] += a.y * b.x; acc[1][1] += a.y * b.y; acc[1][2] += a.y * b.z; acc[1][3] += a.y * b.w;
            acc[2][0] += a.z * b.x; acc[2][1] += a.z * b.y; acc[2][2] += a.z * b.z; acc[2][3] += a.z * b.w;
            acc[3][0] += a.w * b.x; acc[3][1] += a.w * b.y; acc[3][2] += a.w * b.z; acc[3][3] += a.w * b.w;
        }
    }
#pragma unroll
    for (int i = 0; i < 4; ++i) epi(ty * 4 + i, tx * 4, make_float4(acc[i][0], acc[i][1], acc[i][2], acc[i][3]));
}

template <class EP>
__device__ __forceinline__ void dense_gemm_phase(float* sm, int bid, int nb, const float* A, int lda, const float* B, int ldb, int M, int N, int K, const EP& epi) {
    const int ntn = (N + 63) / 64, nu = (M / 64) * ntn;
    for (int u = bid; u < nu; u += nb) {
        const int m0 = (u / ntn) * 64, n0 = (u % ntn) * 64;
        auto al = [&](int m, int k) { return *(const float4*)(A + (size_t)(m0 + m) * lda + k); };
        auto bl = [&](int k, int n) { return (n0 + n < N) ? *(const float4*)(B + (size_t)k * ldb + n0 + n) : make_float4(0.f, 0.f, 0.f, 0.f); };
        auto ep = [&](int m, int n, float4 v) { if (n0 + n < N) epi(m0 + m, n0 + n, v); };
        sgemm_unit(sm, K, al, bl, ep);
    }
}

typedef short s16x8 __attribute__((ext_vector_type(8)));
typedef short s16x4 __attribute__((ext_vector_type(4)));
typedef float f32x4 __attribute__((ext_vector_type(4)));
typedef float f32x2 __attribute__((ext_vector_type(2)));
typedef __bf16 bf16x2_t __attribute__((ext_vector_type(2)));
typedef unsigned short bf16_t;
#define LAS __attribute__((address_space(3)))
__device__ __forceinline__ unsigned cvtpk(float lo, float hi) { f32x2 v = {lo, hi}; bf16x2_t b = __builtin_convertvector(v, bf16x2_t); return __builtin_bit_cast(unsigned, b); }
__device__ __forceinline__ float bf2f(unsigned short h) { return __uint_as_float(((unsigned)h) << 16); }
__device__ __forceinline__ int bimg_off(int k, int ch) { return 256 * k + 16 * (ch ^ (((k & 3) << 2) | ((k >> 2) & 3))); }

template <bool B_F32, bool GLU, class AR, class BC, class EP>
__device__ __forceinline__ void mgemm_unit(char* lds, int K, const AR& arow, const void* Bp, int ldb, const BC& bcol, const EP& epi) {
    const int tid = threadIdx.x, lane = tid & 63, wid = tid >> 6, wm = wid >> 1, wn = wid & 1, fr = lane & 15, fq = lane >> 4;
    const int ac = tid & 7;
    const char* ap[4];
#pragma unroll
    for (int i = 0; i < 4; ++i) ap[i] = (const char*)arow((tid >> 3) + 32 * i);
    const int ao0 = (tid >> 3) * 128 + ((ac ^ ((tid >> 4) & 7)) << 4);
    const char* bp; int bo_e, bo_o;
    if constexpr (B_F32) {
        const int n4 = tid & 31, kb = tid >> 5; const int col = bcol(n4 * 4);
        bp = (const char*)((const float*)Bp + col) + (size_t)kb * ldb * 4;
        bo_e = 16384 + bimg_off(kb, n4 >> 1) + 8 * (n4 & 1); bo_o = 16384 + bimg_off(kb + 8, n4 >> 1) + 8 * (n4 & 1);
    } else {
        const int ch = tid & 15, kb = tid >> 4; const int col = bcol(ch * 8);
        bp = (const char*)((const bf16_t*)Bp + col) + (size_t)kb * ldb * 2;
        bo_e = 16384 + bimg_off(kb, ch); bo_o = 0;
    }
    const int a_base = (wm * 64 + fr) * 128, a_sw = (fr >> 1) & 7;
    const int li = lane & 15, wq = li >> 2, wp = li & 3;
    uint4 rab[4]; float4 rbf[8]; uint4 rbb[4];
    auto load_tiles = [&](int kt) {
#pragma unroll
        for (int i = 0; i < 4; ++i) rab[i] = *(const uint4*)(ap[i] + (size_t)(kt * 64 + ac * 8) * 2);
        if constexpr (B_F32) {
#pragma unroll
            for (int i = 0; i < 8; ++i) rbf[i] = *(const float4*)(bp + (size_t)(kt * 64 + 8 * i) * ldb * 4);
        } else {
#pragma unroll
            for (int i = 0; i < 4; ++i) rbb[i] = *(const uint4*)(bp + (size_t)(kt * 64 + 16 * i) * ldb * 2);
        }
    };
    auto store_tiles = [&](char* buf) {
#pragma unroll
        for (int i = 0; i < 4; ++i) *(uint4*)(buf + ao0 + 4096 * i) = rab[i];
        if constexpr (B_F32) {
#pragma unroll
            for (int i = 0; i < 8; ++i) { uint2 v; v.x = cvtpk(rbf[i].x, rbf[i].y); v.y = cvtpk(rbf[i].z, rbf[i].w); *(uint2*)(buf + ((i & 1) ? bo_o : bo_e) + 4096 * (i >> 1)) = v; }
        } else {
#pragma unroll
            for (int i = 0; i < 4; ++i) *(uint4*)(buf + bo_e + 4096 * i) = rbb[i];
        }
    };
    f32x4 acc[4][4];
#pragma unroll
    for (int i = 0; i < 4; ++i)
#pragma unroll
        for (int j = 0; j < 4; ++j) acc[i][j] = (f32x4){0.f, 0.f, 0.f, 0.f};
    const int nk = K / 64;
    __syncthreads();
    load_tiles(0);
    store_tiles(lds);
    __syncthreads();
    for (int kt = 0; kt < nk; ++kt) {
        char* cur = lds + (kt & 1) * 32768;
        if (kt + 1 < nk) load_tiles(kt + 1);
#pragma unroll
        for (int ks = 0; ks < 2; ++ks) {
            s16x8 af[4], wf[4];
            const int axor = ((ks * 4 + fq) ^ a_sw) << 4;
#pragma unroll
            for (int mi = 0; mi < 4; ++mi) af[mi] = *(const s16x8*)(cur + a_base + mi * 2048 + axor);
            const int r1 = ks * 32 + 8 * fq + wq, r2 = r1 + 4;
#pragma unroll
            for (int ni = 0; ni < 4; ++ni) {
                const int chunk = wn * 8 + ni * 2 + (wp >> 1);
                const LAS char* p1 = (const LAS char*)(cur + 16384 + bimg_off(r1, chunk) + 8 * (wp & 1));
                const LAS char* p2 = (const LAS char*)(cur + 16384 + bimg_off(r2, chunk) + 8 * (wp & 1));
                const s16x4 t1 = __builtin_bit_cast(s16x4, __builtin_amdgcn_ds_read_tr16_b64_v4i16((LAS s16x4*)p1));
                const s16x4 t2 = __builtin_bit_cast(s16x4, __builtin_amdgcn_ds_read_tr16_b64_v4i16((LAS s16x4*)p2));
                wf[ni] = (s16x8){t1[0], t1[1], t1[2], t1[3], t2[0], t2[1], t2[2], t2[3]};
            }
#pragma unroll
            for (int mi = 0; mi < 4; ++mi)
#pragma unroll
                for (int ni = 0; ni < 4; ++ni) acc[mi][ni] = __builtin_amdgcn_mfma_f32_16x16x32_bf16(wf[ni], af[mi], acc[mi][ni], 0, 0, 0);
        }
        if (kt + 1 < nk) store_tiles(lds + ((kt + 1) & 1) * 32768);
        __syncthreads();
    }
#pragma unroll
    for (int mi = 0; mi < 4; ++mi) {
        const int m = wm * 64 + mi * 16 + fr;
        if constexpr (GLU) {
#pragma unroll
            for (int ni = 0; ni < 2; ++ni) {
                const f32x4 g = acc[mi][ni], u = acc[mi][ni + 2];
                f32x4 r;
#pragma unroll
                for (int j = 0; j < 4; ++j) r[j] = g[j] / (1.0f + expf(-g[j])) * u[j];
                epi(m, wn * 32 + ni * 16 + fq * 4, r);
            }
        } else {
#pragma unroll
            for (int ni = 0; ni < 4; ++ni) epi(m, wn * 64 + ni * 16 + fq * 4, acc[mi][ni]);
        }
    }
}

__device__ __forceinline__ unsigned short f2bf(float v) { return (unsigned short)(cvtpk(v, 0.f) & 0xffffu); }
__device__ __forceinline__ void ph_cvt_x(const Params& p, float* sm, int bid, int nb) {
    const size_t n8 = (size_t)T * D / 8;
    for (size_t i = (size_t)bid * NT + threadIdx.x; i < n8; i += (size_t)nb * NT) {
        const float4 a = *(const float4*)(p.x + i * 8), b = *(const float4*)(p.x + i * 8 + 4);
        uint4 v; v.x = cvtpk(a.x, a.y); v.y = cvtpk(a.z, a.w); v.z = cvtpk(b.x, b.y); v.w = cvtpk(b.z, b.w);
        *(uint4*)(p.Xb + i * 8) = v;
    }
}
__device__ __forceinline__ void ph_inproj(const Params& p, float* sm, int bid, int nb) {
    float* P = p.P; const bf16_t* x = p.Xb;
    const int ntn = (INW + 127) / 128, nu = (T / 128) * ntn;
    for (int u = bid; u < nu; u += nb) {
        const int m0 = (u / ntn) * 128, n0 = (u % ntn) * 128;
        auto ar = [&](int r) { return (const void*)(x + (size_t)(m0 + r) * D); };
        auto bc = [&](int c) { return (n0 + c < INW) ? n0 + c : INW - 8; };
        auto ep = [&](int m, int n, f32x4 v) { if (n0 + n < INW) *(f32x4*)(P + (size_t)(m0 + m) * INW + n0 + n) = v; };
        mgemm_unit<true, false>((char*)sm, D, ar, p.w_in, INW, bc, ep);
    }
}

__device__ __forceinline__ void ph_rwkv_prep(const Params& p, float* sm, int bid, int nb) {
    float* xs = sm;
    float* th = sm + 1792;
    float* al = th + 64;
    float* sg = al + 64;
    const int tid = threadIdx.x;
    for (int t = bid; t < T; t += nb) {
        const int s = t & (S - 1);
        __syncthreads();
        for (int c = tid; c < RW_IN; c += NT) {
            const float cur = p.P[(size_t)t * INW + c];
            const float prev = (s > 0) ? p.P[(size_t)(t - 1) * INW + c] : 0.f;
            xs[c] = cur + (prev - cur) * p.mu[c];
        }
        __syncthreads();
        if (tid < 64) { th[tid] = tanhf(xs[C_WL + tid]); al[tid] = xs[C_AL + tid]; }
        if (tid < 128) sg[tid] = sigmoidf_(xs[C_GL + tid]);
        __syncthreads();
#pragma unroll 1
        for (int slot = 0; slot < 2; ++slot) {
            const int c = tid + slot * 256;
            float accw = 0.f, acca = 0.f, accg = 0.f;
#pragma unroll 4
            for (int j = 0; j < 64; ++j) { accw += th[j] * p.w2[j * 512 + c]; acca += al[j] * p.a2[j * 512 + c]; }
#pragma unroll 4
            for (int j = 0; j < 128; ++j) accg += sg[j] * p.g2[j * 512 + c];
            accw += p.w0[c]; acca += p.a0[c];
            const float nx = -accw;
            const float sp = (nx > 20.f) ? nx : log1pf(expf(nx));
            const float w = -sp - 0.5f;
            const float decay = expf(-expf(w));
            const float a = sigmoidf_(acca);
            const float kraw = xs[C_K + c];
            const float kkv = kraw * p.k_k[c];
            const float ss = wave_sum(kkv * kkv);
            const float nrm = fmaxf(sqrtf(ss), 1e-12f);
            const float kkn = kkv / nrm;
            const float k2 = kraw * (1.0f + (a - 1.0f) * p.k_a[c]);
            const size_t o = (size_t)t * 512 + c;
            p.R[o] = xs[C_R + c]; p.DC[o] = decay; p.K2[o] = k2; p.V[o] = xs[C_V + c]; p.KK[o] = kkn; p.BB[o] = kkn * a; p.G[o] = accg;
        }
    }
}

constexpr int SCH = 32;
__device__ __forceinline__ void ph_scan(const Params& p, float* sm, int bid, int nb) {
    float* sr = sm;
    float* sd = sr + SCH * 64;
    float* sk = sd + SCH * 64;
    float* skk = sk + SCH * 64;
    float* sb = skk + SCH * 64;
    float* sv = sb + SCH * 64;
    float* so = sv + SCH * 16;
    const int tid = threadIdx.x, row = tid >> 4, q = tid & 15;
    for (int item = bid; item < 64; item += nb) {
        const int b = item >> 5, h = (item >> 2) & 7, qu = item & 3;
        float s0 = 0.f, s1 = 0.f, s2 = 0.f, s3 = 0.f;
        for (int t0 = 0; t0 < S; t0 += SCH) {
            __syncthreads();
            for (int i = tid; i < SCH * 16; i += NT) {
                const int st = i >> 4, part = i & 15;
                const size_t g = ((size_t)(b * S + t0 + st)) * 512 + h * 64 + part * 4;
                *(float4*)(sr + st * 64 + part * 4) = *(const float4*)(p.R + g);
                *(float4*)(sd + st * 64 + part * 4) = *(const float4*)(p.DC + g);
                *(float4*)(sk + st * 64 + part * 4) = *(const float4*)(p.K2 + g);
                *(float4*)(skk + st * 64 + part * 4) = *(const float4*)(p.KK + g);
                *(float4*)(sb + st * 64 + part * 4) = *(const float4*)(p.BB + g);
            }
            for (int i = tid; i < SCH * 16; i += NT) {
                const int st = i >> 4, r = i & 15;
                sv[i] = p.V[((size_t)(b * S + t0 + st)) * 512 + h * 64 + qu * 16 + r];
            }
            __syncthreads();
            for (int st = 0; st < SCH; ++st) {
                const float4 kk = *(const float4*)(skk + st * 64 + q * 4);
                const float4 dd = *(const float4*)(sd + st * 64 + q * 4);
                const float4 kv = *(const float4*)(sk + st * 64 + q * 4);
                const float4 bb = *(const float4*)(sb + st * 64 + q * 4);
                const float4 rr = *(const float4*)(sr + st * 64 + q * 4);
                const float vv = sv[st * 16 + row];
                float sa = -(s0 * kk.x + s1 * kk.y + s2 * kk.z + s3 * kk.w);
                sa += __shfl_xor(sa, 1); sa += __shfl_xor(sa, 2); sa += __shfl_xor(sa, 4); sa += __shfl_xor(sa, 8);
                s0 = s0 * dd.x + sa * bb.x + vv * kv.x;
                s1 = s1 * dd.y + sa * bb.y + vv * kv.y;
                s2 = s2 * dd.z + sa * bb.z + vv * kv.z;
                s3 = s3 * dd.w + sa * bb.w + vv * kv.w;
                float o = s0 * rr.x + s1 * rr.y + s2 * rr.z + s3 * rr.w;
                o += __shfl_xor(o, 1); o += __shfl_xor(o, 2); o += __shfl_xor(o, 4); o += __shfl_xor(o, 8);
                if (q == 0) so[st * 16 + row] = o;
            }
            __syncthreads();
            for (int i = tid; i < SCH * 16; i += NT) {
                const int st = i >> 4, r = i & 15;
                p.O[((size_t)(b * S + t0 + st)) * 512 + h * 64 + qu * 16 + r] = so[i];
            }
        }
    }
}

__device__ __forceinline__ void ph_rwkv_post(const Params& p, float* sm, int bid, int nb) {
    const int tid = threadIdx.x;
    for (int t = bid; t < T; t += nb) {
#pragma unroll
        for (int slot = 0; slot < 2; ++slot) {
            const int c = tid + slot * 256;
            const size_t o = (size_t)t * 512 + c;
            const float ov = p.O[o];
            const float m = wave_sum(ov) * (1.0f / 64.0f);
            const float dl = ov - m;
            const float var = wave_sum(dl * dl) * (1.0f / 64.0f);
            const float on = dl * rsqrtf(var + 64e-5f) * p.lnx_w[c] + p.lnx_b[c];
            const float bon = wave_sum(p.R[o] * p.K2[o] * p.r_k[c]) * p.V[o];
            p.YAb[o] = f2bf((on + bon) * p.G[o]);
        }
    }
}

__device__ __forceinline__ void ph_rope(const Params& p, float* sm, int bid, int nb) {
    const int tid = threadIdx.x;
    for (int t = bid; t < T; t += nb) {
        const int s = t & (S - 1);
        for (int pi = tid; pi < 12 * 32; pi += NT) {
            const int hs = pi >> 5, i = pi & 31;
            const float inv = (float)pow(10000.0, -(double)i / 32.0);
            const float ang = (float)s * inv;
            float sn, cs; sincosf(ang, &sn, &cs);
            const float* src;
            if (hs < 8) src = p.P + (size_t)t * INW + C_Q + hs * 64;
            else if (hs < 10) src = p.P + (size_t)t * INW + C_KS + (hs - 8) * 64;
            else src = p.P + (size_t)t * INW + C_KW + (hs - 10) * 64;
            const float x1 = src[i], x2 = src[i + 32];
            const float y1 = x1 * cs - x2 * sn, y2 = x2 * cs + x1 * sn;
            if (hs < 8) { p.Qb[(size_t)t * 512 + hs * 64 + i] = f2bf(y1 * QSCALE); p.Qb[(size_t)t * 512 + hs * 64 + i + 32] = f2bf(y2 * QSCALE); }
            else if (hs < 10) { p.KSb[(size_t)t * 128 + (hs - 8) * 64 + i] = f2bf(y1); p.KSb[(size_t)t * 128 + (hs - 8) * 64 + i + 32] = f2bf(y2); }
            else { p.KWb[(size_t)t * 128 + (hs - 10) * 64 + i] = f2bf(y1); p.KWb[(size_t)t * 128 + (hs - 10) * 64 + i + 32] = f2bf(y2); }
        }
        if (tid < 128) { p.VSb[(size_t)t * 128 + tid] = f2bf(p.P[(size_t)t * INW + C_VS + tid]); p.VWb[(size_t)t * 128 + tid] = f2bf(p.P[(size_t)t * INW + C_VW + tid]); }
        if (tid < 24) p.GT[(size_t)t * 24 + tid] = sigmoidf_(p.P[(size_t)t * INW + C_GT + tid]);
    }
}

__device__ __forceinline__ void ph_cmp1(const Params& p, float* sm, int bid, int nb) {
    const int nmt = (NCROWS + 63) / 64;
    const int nu = 2 * nmt * 4;
    for (int u = bid; u < nu; u += nb) {
        const int kv = u / (nmt * 4), m0 = ((u / 4) % nmt) * 64, n0 = (u % 4) * 64;
        const float* pe = kv ? p.pe_v : p.pe_k; const float* w1 = kv ? p.w1_v : p.w1_k; float* H1 = kv ? p.H1V : p.H1K;
        const int ccol = kv ? C_VC : C_KC;
        const float* P = p.P;
        auto al = [&](int m, int k) {
            const int r = m0 + m;
            if (r >= NCROWS) return make_float4(0.f, 0.f, 0.f, 0.f);
            const int g = r & 1, bc = r >> 1, b = bc / NCMP, c = bc % NCMP;
            const int tok = k >> 6, d = k & 63;
            const float4 v = *(const float4*)(P + (size_t)(b * S + 16 * c + tok) * INW + ccol + g * 64 + d);
            const float4 e = *(const float4*)(pe + tok * 64 + d);
            return make_float4(v.x + e.x, v.y + e.y, v.z + e.z, v.w + e.w);
        };
        auto bl = [&](int k, int n) { return *(const float4*)(w1 + (size_t)k * 256 + n0 + n); };
        auto ep = [&](int m, int n, float4 v) {
            const int r = m0 + m;
            if (r < NCROWS) *(float4*)(H1 + (size_t)r * 256 + n0 + n) = make_float4(gelu_tanh(v.x), gelu_tanh(v.y), gelu_tanh(v.z), gelu_tanh(v.w));
        };
        sgemm_unit(sm, 2048, al, bl, ep);
    }
}
__device__ __forceinline__ void ph_cmp2(const Params& p, float* sm, int bid, int nb) {
    const int nmt = (NCROWS + 63) / 64;
    const int nu = 2 * nmt;
    for (int u = bid; u < nu; u += nb) {
        const int kv = u / nmt, m0 = (u % nmt) * 64;
        const float* H1 = kv ? p.H1V : p.H1K; const float* w2 = kv ? p.w2_v : p.w2_k; float* OUT = kv ? p.VC : p.KCraw;
        auto al = [&](int m, int k) { const int r = m0 + m; return (r < NCROWS) ? *(const float4*)(H1 + (size_t)r * 256 + k) : make_float4(0.f, 0.f, 0.f, 0.f); };
        auto bl = [&](int k, int n) { return *(const float4*)(w2 + (size_t)k * 64 + n); };
        auto ep = [&](int m, int n, float4 v) { const int r = m0 + m; if (r < NCROWS) *(float4*)(OUT + (size_t)r * 64 + n) = v; };
        sgemm_unit(sm, 256, al, bl, ep);
    }
}
__device__ __forceinline__ void ph_cmp_rope(const Params& p, float* sm, int bid, int nb) {
    const int tid = threadIdx.x;
    for (int i = bid * NT + tid; i < NCROWS * 32; i += nb * NT) {
        const int r = i >> 5, d = i & 31;
        const int c = (r >> 1) % NCMP;
        const float inv = (float)pow(10000.0, -(double)d / 32.0);
        const float ang = (float)(16 * c + 31) * inv;
        float sn, cs; sincosf(ang, &sn, &cs);
        const float x1 = p.KCraw[(size_t)r * 64 + d], x2 = p.KCraw[(size_t)r * 64 + d + 32];
        const float y1 = x1 * cs - x2 * sn, y2 = x2 * cs + x1 * sn;
        const int g = r & 1, b = (r >> 1) / NCMP;
        const size_t ob = ((size_t)((b * 2 + g) * 512 + c)) * 64;
        p.KCb[ob + d] = f2bf(y1); p.KCb[ob + d + 32] = f2bf(y2);
        p.VCb[ob + d] = f2bf(p.VC[(size_t)r * 64 + d]); p.VCb[ob + d + 32] = f2bf(p.VC[(size_t)r * 64 + d + 32]);
    }
    for (int i = bid * NT + tid; i < 4 * 64; i += nb * NT) { const size_t ob = ((size_t)((i >> 6) * 512 + 511)) * 64 + (i & 63); p.KCb[ob] = 0; p.VCb[ob] = 0; }
}

__device__ __forceinline__ int kimg_off(int key, int c) { return key * 128 + ((c ^ ((key >> 1) & 7)) << 4); }
__device__ __forceinline__ int vimg_off(int key, int c) { return key * 128 + ((c ^ (((key >> 1) & 3) << 1)) << 4); }
__device__ __forceinline__ float fast_exp2(float x) { return __builtin_amdgcn_exp2f(x); }

struct NsaCtx {
    char* lds; int tid, lane, wave, fr, fq, li;
    s16x8 qf[2][2];
    int tq[2];
};

__device__ __forceinline__ void nsa_qk(const NsaCtx& c, const char* cur, f32x4 (&s)[2][4]) {
#pragma unroll
    for (int kt = 0; kt < 4; ++kt) {
#pragma unroll
        for (int ks = 0; ks < 2; ++ks) {
            const s16x8 kf = *(const s16x8*)(cur + kimg_off(kt * 16 + c.fr, ks * 4 + c.fq));
#pragma unroll
            for (int qt = 0; qt < 2; ++qt) {
                if (ks == 0) s[qt][kt] = __builtin_amdgcn_mfma_f32_16x16x32_bf16(kf, c.qf[qt][0], (f32x4){0.f, 0.f, 0.f, 0.f}, 0, 0, 0);
                else s[qt][kt] = __builtin_amdgcn_mfma_f32_16x16x32_bf16(kf, c.qf[qt][1], s[qt][kt], 0, 0, 0);
            }
        }
    }
}
__device__ __forceinline__ void nsa_pv(const NsaCtx& c, const char* cur, const f32x4 (&pr)[2][4], f32x4 (&O)[2][4]) {
    s16x8 pb[2][2];
#pragma unroll
    for (int qt = 0; qt < 2; ++qt)
#pragma unroll
        for (int k2 = 0; k2 < 2; ++k2) {
            const f32x4 a = pr[qt][2 * k2], b = pr[qt][2 * k2 + 1];
            const unsigned w0 = cvtpk(a[0], a[1]), w1 = cvtpk(a[2], a[3]), w2 = cvtpk(b[0], b[1]), w3 = cvtpk(b[2], b[3]);
            pb[qt][k2] = __builtin_bit_cast(s16x8, make_uint4(w0, w1, w2, w3));
        }
    const int q_ = c.li >> 2, p_ = c.li & 3;
#pragma unroll
    for (int dt = 0; dt < 4; ++dt)
#pragma unroll
        for (int k2 = 0; k2 < 2; ++k2) {
            const int key1 = k2 * 32 + 4 * c.fq + q_, key2 = key1 + 16;
            const int chunk = dt * 2 + (p_ >> 1);
            const LAS char* a1 = (const LAS char*)(cur + 8192 + vimg_off(key1, chunk) + 8 * (p_ & 1));
            const LAS char* a2 = (const LAS char*)(cur + 8192 + vimg_off(key2, chunk) + 8 * (p_ & 1));
            const s16x4 t1 = __builtin_bit_cast(s16x4, __builtin_amdgcn_ds_read_tr16_b64_v4i16((LAS s16x4*)a1));
            const s16x4 t2 = __builtin_bit_cast(s16x4, __builtin_amdgcn_ds_read_tr16_b64_v4i16((LAS s16x4*)a2));
            const s16x8 vf = (s16x8){t1[0], t1[1], t1[2], t1[3], t2[0], t2[1], t2[2], t2[3]};
#pragma unroll
            for (int qt = 0; qt < 2; ++qt) O[qt][dt] = __builtin_amdgcn_mfma_f32_16x16x32_bf16(vf, pb[qt][k2], O[qt][dt], 0, 0, 0);
        }
}
#define KVREGS uint4 rk0, rk1, rv0, rv1
#define KVARGS rk0, rk1, rv0, rv1
__device__ __forceinline__ void nsa_gload(const NsaCtx& c, uint4& rk0, uint4& rk1, uint4& rv0, uint4& rv1, const bf16_t* Kg, const bf16_t* Vg, int stride, int tile) {
    { const int idx = c.tid, key = idx >> 3, ch = idx & 7; const size_t off = (size_t)(tile * 64 + key) * stride + ch * 8; rk0 = *(const uint4*)(Kg + off); rv0 = *(const uint4*)(Vg + off); }
    { const int idx = 256 + c.tid, key = idx >> 3, ch = idx & 7; const size_t off = (size_t)(tile * 64 + key) * stride + ch * 8; rk1 = *(const uint4*)(Kg + off); rv1 = *(const uint4*)(Vg + off); }
}
__device__ __forceinline__ void nsa_lstore(const NsaCtx& c, const uint4& rk0, const uint4& rk1, const uint4& rv0, const uint4& rv1, char* buf) {
    { const int idx = c.tid, key = idx >> 3, ch = idx & 7; *(uint4*)(buf + kimg_off(key, ch)) = rk0; *(uint4*)(buf + 8192 + vimg_off(key, ch)) = rv0; }
    { const int idx = 256 + c.tid, key = idx >> 3, ch = idx & 7; *(uint4*)(buf + kimg_off(key, ch)) = rk1; *(uint4*)(buf + 8192 + vimg_off(key, ch)) = rv1; }
}
__device__ __forceinline__ bool selbit4(const unsigned (&w)[4], int tile) {
    const int wi = tile >> 5; const unsigned x = (wi == 0) ? w[0] : (wi == 1) ? w[1] : (wi == 2) ? w[2] : w[3];
    return ((x >> (tile & 31)) & 1u) != 0u;
}
__device__ __forceinline__ float xmax16_32(float v) { v = fmaxf(v, __shfl_xor(v, 16)); v = fmaxf(v, __shfl_xor(v, 32)); return v; }
__device__ __forceinline__ float xsum16_32(float v) { v += __shfl_xor(v, 16); v += __shfl_xor(v, 32); return v; }

template <int BR>
__device__ __forceinline__ void nsa_flash(const NsaCtx& c, const bf16_t* Kg, const bf16_t* Vg, int stride, int tile_lo, int tile_hi, const unsigned (&selw)[2][4],
                                          float (&m)[2], float (&l)[2], f32x4 (&O)[2][4]) {
    if (tile_lo > tile_hi) return;
    KVREGS;
    __syncthreads();
    nsa_gload(c, KVARGS, Kg, Vg, stride, tile_lo);
    nsa_lstore(c, KVARGS, c.lds);
    __syncthreads();
    for (int tile = tile_lo; tile <= tile_hi; ++tile) {
        char* cur = c.lds + ((tile - tile_lo) & 1) * 16384;
        if (tile < tile_hi) nsa_gload(c, KVARGS, Kg, Vg, stride, tile + 1);
        bool need = true;
        if (BR == 1) {
            const bool mine = selbit4(selw[0], tile) || selbit4(selw[1], tile);
            need = __ballot(mine) != 0ull;
        }
        if (need) {
            f32x4 s[2][4];
            nsa_qk(c, cur, s);
#pragma unroll
            for (int qt = 0; qt < 2; ++qt) {
                const int t = c.tq[qt];
                bool rowok = true;
                if (BR == 1) rowok = selbit4(selw[qt], tile);
                float tmax = -1e30f;
#pragma unroll
                for (int kt = 0; kt < 4; ++kt)
#pragma unroll
                    for (int r = 0; r < 4; ++r) {
                        const int kap = tile * 64 + kt * 16 + 4 * c.fq + r;
                        bool ok = rowok && (kap <= t);
                        if (BR == 2) ok = ok && (kap + 511 >= t);
                        const float v = ok ? s[qt][kt][r] : -1e30f;
                        s[qt][kt][r] = v; tmax = fmaxf(tmax, v);
                    }
                tmax = xmax16_32(tmax);
                const float mn = fmaxf(m[qt], tmax);
                const float alpha = fast_exp2(m[qt] - mn);
                m[qt] = mn;
                float rs = 0.f;
#pragma unroll
                for (int kt = 0; kt < 4; ++kt)
#pragma unroll
                    for (int r = 0; r < 4; ++r) { const float v = s[qt][kt][r]; const float pv = (v > -1e29f) ? fast_exp2(v - mn) : 0.f; s[qt][kt][r] = pv; rs += pv; }
                l[qt] = l[qt] * alpha + rs;
#pragma unroll
                for (int dt = 0; dt < 4; ++dt) O[qt][dt] *= alpha;
            }
            nsa_pv(c, cur, s, O);
        }
        if (tile < tile_hi) nsa_lstore(c, KVARGS, c.lds + ((tile - tile_lo + 1) & 1) * 16384);
        __syncthreads();
    }
}
template <bool NORM, int MODE>
__device__ __forceinline__ void nsa_accum(const NsaCtx& c, const float (&gate)[2], const float (&l)[2], const f32x4 (&O)[2][4], bf16_t* const (&yrow)[2]) {
#pragma unroll
    for (int qt = 0; qt < 2; ++qt) {
        float inv = 1.0f;
        if (NORM) { const float lt = xsum16_32(l[qt]); inv = (lt > 0.f) ? 1.0f / lt : 0.f; }
        inv *= gate[qt];
        float* acc = (float*)(c.lds + 32768) + (c.wave * 32 + qt * 16 + c.li) * 64 + 4 * c.fq;
#pragma unroll
        for (int dt = 0; dt < 4; ++dt) {
            f32x4 v = O[qt][dt] * inv;
            if (MODE >= 1) v += *(const f32x4*)(acc + dt * 16);
            if (MODE <= 1) *(f32x4*)(acc + dt * 16) = v;
            else { uint2 w; w.x = cvtpk(v[0], v[1]); w.y = cvtpk(v[2], v[3]); *(uint2*)(yrow[qt] + dt * 16) = w; }
        }
    }
}

__device__ __forceinline__ void ph_nsa_fast(const Params& p, float* sm, int bid, int nb) {
    NsaCtx c;
    c.lds = (char*)sm; c.tid = threadIdx.x; c.lane = c.tid & 63; c.wave = c.tid >> 6; c.fr = c.lane & 15; c.fq = c.lane >> 4; c.li = c.lane & 15;
    float* impA = (float*)(c.lds + 32768); float* impE = (float*)(c.lds + 49152); unsigned* selm = (unsigned*)(c.lds + 49152);
    for (int u = bid; u < 1024; u += nb) {
        const int tt = 255 - (u >> 2), b = (u >> 1) & 1, g = u & 1, t0 = tt * 32;
        const int head = c.li & 3;
#pragma unroll
        for (int qt = 0; qt < 2; ++qt) {
            c.tq[qt] = t0 + c.wave * 8 + qt * 4 + (c.li >> 2);
            const bf16_t* qrow = p.Qb + (size_t)(b * S + c.tq[qt]) * 512 + (g * 4 + head) * 64 + 8 * c.fq;
            c.qf[qt][0] = *(const s16x8*)qrow; c.qf[qt][1] = *(const s16x8*)(qrow + 32);
        }
        unsigned selw[2][4];
        float gt0[2], gt1[2], gt2[2];
        bf16_t* yrow[2];
#pragma unroll
        for (int qt = 0; qt < 2; ++qt) {
#pragma unroll
            for (int w = 0; w < 4; ++w) selw[qt][w] = 0u;
            const float* gp = p.GT + (size_t)(b * S + c.tq[qt]) * 24 + (g * 4 + head) * 3;
            gt0[qt] = gp[0]; gt1[qt] = gp[1]; gt2[qt] = gp[2];
            yrow[qt] = p.YBb + (size_t)(b * S + c.tq[qt]) * 512 + (g * 4 + head) * 64 + 4 * c.fq;
        }
        f32x4 Oc[2][4];
#if 1
        {
            const bf16_t* Kg = p.KCb + (size_t)((b * 2 + g) * 512) * 64; const bf16_t* Vg = p.VCb + (size_t)((b * 2 + g) * 512) * 64;
            const int tl = t0 + 31; const int nvmax = (tl >= 31) ? ((tl - 31) >> 4) + 1 : 0; const int ntile = (nvmax + 63) >> 6;
            float m[2] = {-1e30f, -1e30f}, l[2] = {0.f, 0.f};
#pragma unroll
            for (int qt = 0; qt < 2; ++qt)
#pragma unroll
                for (int dt = 0; dt < 4; ++dt) Oc[qt][dt] = (f32x4){0.f, 0.f, 0.f, 0.f};
            __syncthreads();
            for (int i = c.tid; i < 32 * 128; i += NT) { impA[i] = 0.f; impE[i] = 0.f; }
            KVREGS;
            for (int pass = 0; pass < 2; ++pass) {
                float linv[2] = {0.f, 0.f};
                if (pass == 1) {
#pragma unroll
                    for (int qt = 0; qt < 2; ++qt) { const float lt = xsum16_32(l[qt]); linv[qt] = (lt > 0.f) ? 1.0f / lt : 0.f; }
                }
                if (ntile > 0) {
                    __syncthreads();
                    nsa_gload(c, KVARGS, Kg, Vg, 64, 0); nsa_lstore(c, KVARGS, c.lds); __syncthreads();
                    for (int tile = 0; tile < ntile; ++tile) {
                        char* cur = c.lds + (tile & 1) * 16384;
                        if (tile + 1 < ntile) nsa_gload(c, KVARGS, Kg, Vg, 64, tile + 1);
                        f32x4 s[2][4];
                        nsa_qk(c, cur, s);
#pragma unroll
                        for (int qt = 0; qt < 2; ++qt) {
                            const int t = c.tq[qt];
                            if (pass == 0) {
                                float tmax = -1e30f;
#pragma unroll
                                for (int kt = 0; kt < 4; ++kt)
#pragma unroll
                                    for (int r = 0; r < 4; ++r) { const int cc = tile * 64 + kt * 16 + 4 * c.fq + r; const float v = (16 * cc + 31 <= t) ? s[qt][kt][r] : -1e30f; s[qt][kt][r] = v; tmax = fmaxf(tmax, v); }
                                tmax = xmax16_32(tmax);
                                const float mn = fmaxf(m[qt], tmax); const float alpha = fast_exp2(m[qt] - mn); m[qt] = mn;
                                float rs = 0.f;
#pragma unroll
                                for (int kt = 0; kt < 4; ++kt)
#pragma unroll
                                    for (int r = 0; r < 4; ++r) { const float v = s[qt][kt][r]; rs += (v > -1e29f) ? fast_exp2(v - mn) : 0.f; }
                                l[qt] = l[qt] * alpha + rs;
                            } else {
#pragma unroll
                                for (int kt = 0; kt < 4; ++kt) {
#pragma unroll
                                    for (int r = 0; r < 4; ++r) { const int cc = tile * 64 + kt * 16 + 4 * c.fq + r; s[qt][kt][r] = (16 * cc + 31 <= t) ? fast_exp2(s[qt][kt][r] - m[qt]) * linv[qt] : 0.f; }
                                    float e = s[qt][kt][3];
                                    float a = 2.0f * ((s[qt][kt][0] + s[qt][kt][1]) + (s[qt][kt][2] + e)) - e;
                                    a += __shfl_xor(a, 1); a += __shfl_xor(a, 2); e += __shfl_xor(e, 1); e += __shfl_xor(e, 2);
                                    if (head == 0) { const int j = tile * 16 + kt * 4 + c.fq; const int tokl = c.wave * 8 + qt * 4 + (c.li >> 2); impA[tokl * 128 + j] = a; impE[tokl * 128 + j] = e; }
                                }
                            }
                        }
                        if (pass == 1) nsa_pv(c, cur, s, Oc);
                        if (tile + 1 < ntile) nsa_lstore(c, KVARGS, c.lds + ((tile + 1) & 1) * 16384);
                        __syncthreads();
                    }
                }
            }
        }
#endif
#if 1
        {
            __syncthreads();
            float scv[16];
#pragma unroll
            for (int i = 0; i < 16; ++i) {
                const int e = c.tid + 256 * i, tok = e >> 7, j = e & 127; const int t = t0 + tok, cur = t >> 6;
                const bool valid = (j <= cur), forced = (j == 0) || (j == cur) || (j == cur - 1);
                scv[i] = valid ? (impA[e] + ((j > 0) ? impE[e - 1] : 0.f) + (forced ? 1e4f : 0.f)) : -1.0f;
            }
            __syncthreads();
#pragma unroll
            for (int i = 0; i < 16; ++i) impA[c.tid + 256 * i] = scv[i];
            __syncthreads();
#pragma unroll 1
            for (int i = 0; i < 16; ++i) {
                const int e = c.tid + 256 * i, tok = e >> 7, j = e & 127;
                const float my = impA[e];
                int rank = 0;
                const float* row = impA + tok * 128;
                for (int jj = 0; jj < 128; jj += 4) {
                    const float4 o = *(const float4*)(row + jj);
                    rank += (o.x > my || (o.x == my && jj < j)) ? 1 : 0;
                    rank += (o.y > my || (o.y == my && jj + 1 < j)) ? 1 : 0;
                    rank += (o.z > my || (o.z == my && jj + 2 < j)) ? 1 : 0;
                    rank += (o.w > my || (o.w == my && jj + 3 < j)) ? 1 : 0;
                }
                const unsigned long long mk = __ballot(rank < 16 && my >= 0.f);
                if (c.lane == 0) { selm[tok * 4 + (c.wave & 1) * 2] = (unsigned)mk; selm[tok * 4 + (c.wave & 1) * 2 + 1] = (unsigned)(mk >> 32); }
            }
            __syncthreads();
#pragma unroll
            for (int qt = 0; qt < 2; ++qt) {
                const int tokl = c.wave * 8 + qt * 4 + (c.li >> 2);
#pragma unroll
                for (int w = 0; w < 4; ++w) selw[qt][w] = selm[tokl * 4 + w];
            }
            __syncthreads();
            { const float dummy[2] = {0.f, 0.f}; nsa_accum<false, 0>(c, gt0, dummy, Oc, yrow); }
        }
#endif
#if 1
        {
            float m[2] = {-1e30f, -1e30f}, l[2] = {0.f, 0.f};
            f32x4 O[2][4];
#pragma unroll
            for (int qt = 0; qt < 2; ++qt)
#pragma unroll
                for (int dt = 0; dt < 4; ++dt) O[qt][dt] = (f32x4){0.f, 0.f, 0.f, 0.f};
            nsa_flash<1>(c, p.KSb + (size_t)(b * S) * 128 + g * 64, p.VSb + (size_t)(b * S) * 128 + g * 64, 128, 0, (t0 + 31) >> 6, selw, m, l, O);
            nsa_accum<true, 1>(c, gt1, l, O, yrow);
        }
#endif
#if 1
        {
            float m[2] = {-1e30f, -1e30f}, l[2] = {0.f, 0.f};
            f32x4 O[2][4];
#pragma unroll
            for (int qt = 0; qt < 2; ++qt)
#pragma unroll
                for (int dt = 0; dt < 4; ++dt) O[qt][dt] = (f32x4){0.f, 0.f, 0.f, 0.f};
            const int lo = (t0 >= 511) ? ((t0 - 511) >> 6) : 0;
            nsa_flash<2>(c, p.KWb + (size_t)(b * S) * 128 + g * 64, p.VWb + (size_t)(b * S) * 128 + g * 64, 128, lo, (t0 + 31) >> 6, selw, m, l, O);
            nsa_accum<true, 2>(c, gt2, l, O, yrow);
        }
#endif
    }
}
__device__ __forceinline__ void ph_branch_a(const Params& p, float* sm, int bid, int nb) {
    const float* P = p.P; float* Z = p.Z; const bf16_t* YA = p.YAb;
    const int nu = (T / 128) * (D / 128);
    for (int u = bid; u < nu; u += nb) {
        const int m0 = (u / (D / 128)) * 128, n0 = (u % (D / 128)) * 128;
        auto ar = [&](int r) { return (const void*)(YA + (size_t)(m0 + r) * 512); };
        auto bc = [&](int c) { return n0 + c; };
        auto ep = [&](int m, int n, f32x4 v) {
            const size_t r = m0 + m; const int c = n0 + n;
            const f32x4 gq = *(const f32x4*)(P + r * INW + C_GA + c);
            f32x4 o;
#pragma unroll
            for (int j = 0; j < 4; ++j) o[j] = sigmoidf_(gq[j]) * v[j];
            *(f32x4*)(Z + r * D + c) = o;
        };
        mgemm_unit<true, false>((char*)sm, 512, ar, p.wba, D, bc, ep);
    }
}
__device__ __forceinline__ void ph_branch_b(const Params& p, float* sm, int bid, int nb) {
    const float* P = p.P; float* Z = p.Z; const bf16_t* YB = p.YBb; bf16_t* Zb = p.Zb;
    const int nu = (T / 128) * (D / 128);
    for (int u = bid; u < nu; u += nb) {
        const int m0 = (u / (D / 128)) * 128, n0 = (u % (D / 128)) * 128;
        auto ar = [&](int r) { return (const void*)(YB + (size_t)(m0 + r) * 512); };
        auto bc = [&](int c) { return n0 + c; };
        auto ep = [&](int m, int n, f32x4 v) {
            const size_t r = m0 + m; const int c = n0 + n;
            const f32x4 gq = *(const f32x4*)(P + r * INW + C_GB + c);
            f32x4 o = *(const f32x4*)(Z + r * D + c);
#pragma unroll
            for (int j = 0; j < 4; ++j) o[j] += sigmoidf_(gq[j]) * v[j];
            uint2 w; w.x = cvtpk(o[0], o[1]); w.y = cvtpk(o[2], o[3]);
            *(uint2*)(Zb + r * D + c) = w;
        };
        mgemm_unit<true, false>((char*)sm, 512, ar, p.wbb, D, bc, ep);
    }
}
__device__ __forceinline__ void ph_outproj(const Params& p, float* sm, int bid, int nb) {
    const float* x = p.x; float* PRE1 = p.PRE1; const bf16_t* Z = p.Zb;
    const int nu = (T / 128) * (D / 128);
    for (int u = bid; u < nu; u += nb) {
        const int m0 = (u / (D / 128)) * 128, n0 = (u % (D / 128)) * 128;
        auto ar = [&](int r) { return (const void*)(Z + (size_t)(m0 + r) * D); };
        auto bc = [&](int c) { return n0 + c; };
        auto ep = [&](int m, int n, f32x4 v) {
            const size_t r = m0 + m; const int c = n0 + n;
            const f32x4 xv = *(const f32x4*)(x + r * D + c);
            *(f32x4*)(PRE1 + r * D + c) = xv * ALPHA + v;
        };
        mgemm_unit<true, false>((char*)sm, D, ar, p.wout, D, bc, ep);
    }
}
__device__ __forceinline__ void ln_rows(float* sm, int bid, int nb, const float* src, float* dst, unsigned short* dstb, const float* gam, const float* bet) {
    const int tid = threadIdx.x, wave = tid >> 6, lane = tid & 63;
    for (int t = bid; t < T; t += nb) {
        const float4 v = *(const float4*)(src + (size_t)t * D + tid * 4);
        float s = (v.x + v.y) + (v.z + v.w);
        s = wave_sum(s);
        __syncthreads();
        if (lane == 0) sm[wave] = s;
        __syncthreads();
        const float mean = (sm[0] + sm[1] + sm[2] + sm[3]) * (1.0f / D);
        const float dx = v.x - mean, dy = v.y - mean, dz = v.z - mean, dw = v.w - mean;
        float q = (dx * dx + dy * dy) + (dz * dz + dw * dw);
        q = wave_sum(q);
        __syncthreads();
        if (lane == 0) sm[wave] = q;
        __syncthreads();
        const float rstd = rsqrtf((sm[0] + sm[1] + sm[2] + sm[3]) * (1.0f / D) + 1e-5f);
        const float4 gq = *(const float4*)(gam + tid * 4), bq = *(const float4*)(bet + tid * 4);
        const float4 o = make_float4(dx * rstd * gq.x + bq.x, dy * rstd * gq.y + bq.y, dz * rstd * gq.z + bq.z, dw * rstd * gq.w + bq.w);
        *(float4*)(dst + (size_t)t * D + tid * 4) = o;
        uint2 w; w.x = cvtpk(o.x, o.y); w.y = cvtpk(o.z, o.w);
        *(uint2*)(dstb + (size_t)t * D + tid * 4) = w;
    }
}
__device__ __forceinline__ void ph_ln1(const Params& p, float* sm, int bid, int nb) { ln_rows(sm, bid, nb, p.PRE1, p.X1, p.X1b, p.ln1g, p.ln1b); }

__device__ __forceinline__ void ph_router_gemm(const Params& p, float* sm, int bid, int nb) {
    float* L = p.LOGITS; const bf16_t* X1 = p.X1b;
    const int nu = (T / 128) * 2;
    for (int u = bid; u < nu; u += nb) {
        const int m0 = (u / 2) * 128, n0 = (u % 2) * 128;
        auto ar = [&](int r) { return (const void*)(X1 + (size_t)(m0 + r) * D); };
        auto bc = [&](int c) { return n0 + c; };
        auto ep = [&](int m, int n, f32x4 v) { *(f32x4*)(L + (size_t)(m0 + m) * NE + n0 + n) = v; };
        mgemm_unit<true, false>((char*)sm, D, ar, p.rw, NE, bc, ep);
    }
}
__device__ __forceinline__ void ph_router_sel(const Params& p, float* sm, int bid, int nb) {
    float* chs = sm;
    float* scs = sm + 256;
    float* gs = sm + 512;
    int* gsel = (int*)(sm + 520);
    float* ew = sm + 528;
    int* ei = (int*)(sm + 536);
    const int e = threadIdx.x;
    for (int t = bid; t < T; t += nb) {
        __syncthreads();
        const float sc = sigmoidf_(p.LOGITS[(size_t)t * NE + e]);
        const float ch = sc + p.rbias[e];
        chs[e] = ch; scs[e] = sc;
        __syncthreads();
        if (e < 8) {
            float m1 = -3e38f; int i1 = -1;
            for (int i = 0; i < 32; ++i) { const float v = chs[e * 32 + i]; if (v > m1) { m1 = v; i1 = i; } }
            float m2 = -3e38f;
            for (int i = 0; i < 32; ++i) { const float v = chs[e * 32 + i]; if (i != i1 && v > m2) m2 = v; }
            gs[e] = m1 + m2;
        }
        __syncthreads();
        if (e < 8) {
            const float my = gs[e]; int rank = 0;
            for (int i = 0; i < 8; ++i) { const float o = gs[i]; rank += (o > my || (o == my && i < e)) ? 1 : 0; }
            gsel[e] = (rank < 4) ? 1 : 0;
        }
        __syncthreads();
        const float mch = gsel[e >> 5] ? ch : -1e30f;
        __syncthreads();
        chs[e] = mch;
        __syncthreads();
        {
            int rank = 0;
            for (int i = 0; i < 256; ++i) { const float o = chs[i]; rank += (o > mch || (o == mch && i < e)) ? 1 : 0; }
            if (rank < 8) { ei[rank] = e; ew[rank] = sc; }
        }
        __syncthreads();
        if (e < 8) {
            const float sum = ((ew[0] + ew[1]) + (ew[2] + ew[3])) + ((ew[4] + ew[5]) + (ew[6] + ew[7]));
            p.EIDX[(size_t)t * 8 + e] = ei[e];
            p.EW[(size_t)t * 8 + e] = ew[e] / sum * 2.5f;
        }
    }
}
__device__ __forceinline__ void ph_lists(const Params& p, float* sm, int bid, int nb) {
    int* wcnt = (int*)sm;
    const int tid = threadIdx.x, wave = tid >> 6, lane = tid & 63;
    for (int e = bid; e < NE; e += nb) {
        int base = 0;
        for (int a0 = 0; a0 < T * 8; a0 += NT) {
            const bool f = (p.EIDX[a0 + tid] == e);
            const unsigned long long m = __ballot(f);
            const int before = __popcll(m & ((1ull << lane) - 1ull));
            __syncthreads();
            if (lane == 0) wcnt[wave] = __popcll(m);
            __syncthreads();
            int off = base;
            for (int w = 0; w < wave; ++w) off += wcnt[w];
            if (f && off + before < LISTCAP) p.LIST[(size_t)e * LISTCAP + off + before] = a0 + tid;
            base += wcnt[0] + wcnt[1] + wcnt[2] + wcnt[3];
        }
        if (tid == 0) p.CNT[e] = base < LISTCAP ? base : LISTCAP;
    }
}
__device__ __forceinline__ int glu_col(int j0, int c) { const int wn = c >> 6, ni = (c >> 4) & 3, x = c & 15; return ((ni >> 1) ? 256 : 0) + j0 + wn * 32 + (ni & 1) * 16 + x; }
__device__ __forceinline__ void ph_moe_gu(const Params& p, float* sm, int bid, int nb) {
    const int nu = 128 * NE * 4;
    for (int u = bid; u < nu; u += nb) {
        const int mt = u / (NE * 4), e = (u / 4) % NE, j0 = (u % 4) * 64;
        const int cnt = p.CNT[e];
        if (mt * 128 >= cnt) continue;
        const int* lst = p.LIST + (size_t)e * LISTCAP + mt * 128;
        const int nrow = cnt - mt * 128;
        const bf16_t* X1 = p.X1b; bf16_t* ACT = p.ACT;
        auto ar = [&](int r) { return (const void*)(X1 + (size_t)(lst[r < nrow ? r : 0] >> 3) * D); };
        auto bc = [&](int c) { return glu_col(j0, c); };
        auto ep = [&](int m, int n, f32x4 v) { if (m < nrow) { const int a = lst[m]; uint2 w; w.x = cvtpk(v[0], v[1]); w.y = cvtpk(v[2], v[3]); *(uint2*)(ACT + (size_t)a * 256 + j0 + n) = w; } };
        mgemm_unit<true, true>((char*)sm, D, ar, p.egu + (size_t)e * D * 512, 512, bc, ep);
    }
}
__device__ __forceinline__ void ph_moe_down(const Params& p, float* sm, int bid, int nb) {
    const int nu = 128 * NE * 8;
    for (int u = bid; u < nu; u += nb) {
        const int mt = u / (NE * 8), e = (u / 8) % NE, n0 = (u % 8) * 128;
        const int cnt = p.CNT[e];
        if (mt * 128 >= cnt) continue;
        const int* lst = p.LIST + (size_t)e * LISTCAP + mt * 128;
        const int nrow = cnt - mt * 128;
        const bf16_t* ACT = p.ACT; float* Y = p.Y; const float* EW = p.EW;
        auto ar = [&](int r) { return (const void*)(ACT + (size_t)lst[r < nrow ? r : 0] * 256); };
        auto bc = [&](int c) { return n0 + c; };
        auto ep = [&](int m, int n, f32x4 v) { if (m < nrow) { const int a = lst[m]; const float w = EW[a]; *(f32x4*)(Y + (size_t)a * D + n0 + n) = v * w; } };
        mgemm_unit<true, false>((char*)sm, 256, ar, p.edown + (size_t)e * 256 * D, D, bc, ep);
    }
}
__device__ __forceinline__ void ph_shared_gu(const Params& p, float* sm, int bid, int nb) {
    const bf16_t* X1 = p.X1b; bf16_t* ACTS = p.ACTS;
    const int nu = (T / 128) * 4;
    for (int u = bid; u < nu; u += nb) {
        const int m0 = (u / 4) * 128, j0 = (u % 4) * 64;
        auto ar = [&](int r) { return (const void*)(X1 + (size_t)(m0 + r) * D); };
        auto bc = [&](int c) { return glu_col(j0, c); };
        auto ep = [&](int m, int n, f32x4 v) { uint2 w; w.x = cvtpk(v[0], v[1]); w.y = cvtpk(v[2], v[3]); *(uint2*)(ACTS + (size_t)(m0 + m) * 256 + j0 + n) = w; };
        mgemm_unit<true, true>((char*)sm, D, ar, p.sgu, 512, bc, ep);
    }
}
__device__ __forceinline__ void ph_shared_down(const Params& p, float* sm, int bid, int nb) {
    const bf16_t* ACTS = p.ACTS; float* SH = p.SH;
    const int nu = (T / 128) * 8;
    for (int u = bid; u < nu; u += nb) {
        const int m0 = (u / 8) * 128, n0 = (u % 8) * 128;
        auto ar = [&](int r) { return (const void*)(ACTS + (size_t)(m0 + r) * 256); };
        auto bc = [&](int c) { return n0 + c; };
        auto ep = [&](int m, int n, f32x4 v) { *(f32x4*)(SH + (size_t)(m0 + m) * D + n0 + n) = v; };
        mgemm_unit<true, false>((char*)sm, 256, ar, p.sdown, D, bc, ep);
    }
}
__device__ __forceinline__ void ph_final(const Params& p, float* sm, int bid, int nb) {
    const int tid = threadIdx.x, wave = tid >> 6, lane = tid & 63;
    for (int t = bid; t < T; t += nb) {
        const float4 xv = *(const float4*)(p.X1 + (size_t)t * D + tid * 4);
        float4 v = *(const float4*)(p.SH + (size_t)t * D + tid * 4);
        float4 r = make_float4(0.f, 0.f, 0.f, 0.f);
#pragma unroll
        for (int k = 0; k < 8; ++k) { const float4 y = *(const float4*)(p.Y + ((size_t)t * 8 + k) * D + tid * 4); r.x += y.x; r.y += y.y; r.z += y.z; r.w += y.w; }
        v.x = ALPHA * xv.x + (r.x + v.x); v.y = ALPHA * xv.y + (r.y + v.y); v.z = ALPHA * xv.z + (r.z + v.z); v.w = ALPHA * xv.w + (r.w + v.w);
        float s = (v.x + v.y) + (v.z + v.w);
        s = wave_sum(s);
        __syncthreads();
        if (lane == 0) sm[wave] = s;
        __syncthreads();
        const float mean = (sm[0] + sm[1] + sm[2] + sm[3]) * (1.0f / D);
        const float dx = v.x - mean, dy = v.y - mean, dz = v.z - mean, dw = v.w - mean;
        float q = (dx * dx + dy * dy) + (dz * dz + dw * dw);
        q = wave_sum(q);
        __syncthreads();
        if (lane == 0) sm[wave] = q;
        __syncthreads();
        const float rstd = rsqrtf((sm[0] + sm[1] + sm[2] + sm[3]) * (1.0f / D) + 1e-5f);
        const float4 gq = *(const float4*)(p.ln2g + tid * 4), bq = *(const float4*)(p.ln2b + tid * 4);
        *(float4*)(p.out + (size_t)t * D + tid * 4) = make_float4(dx * rstd * gq.x + bq.x, dy * rstd * gq.y + bq.y, dz * rstd * gq.z + bq.z, dw * rstd * gq.w + bq.w);
    }
}

constexpr int SM_FLOATS = 16384;

#define DEF_KERNEL(name) \
    __global__ void __launch_bounds__(NT) k_##name(Params p) { __shared__ __attribute__((aligned(16))) float sm[SM_FLOATS]; ph_##name(p, sm, (int)blockIdx.x, (int)gridDim.x); }


namespace cg = cooperative_groups;
__global__ void __launch_bounds__(NT, 2) mega(Params p) {
    __shared__ __attribute__((aligned(16))) float sm[SM_FLOATS];
    cg::grid_group grid = cg::this_grid();
    const int bid = (int)blockIdx.x, nb = (int)gridDim.x;
#ifndef PROBE_REP
#define PROBE_REP 0
#endif
#define GROUP(k, ...) { __VA_ARGS__ } if (PROBE_REP == (k)) { __VA_ARGS__ }
    GROUP(1, ph_cvt_x(p, sm, bid, nb); grid.sync(); ph_inproj(p, sm, bid, nb); grid.sync();)
    GROUP(2, ph_rwkv_prep(p, sm, bid, nb); ph_rope(p, sm, bid, nb); ph_cmp1(p, sm, bid, nb); grid.sync();
             ph_cmp2(p, sm, bid, nb); grid.sync();
             ph_cmp_rope(p, sm, bid, nb); grid.sync();)
    GROUP(3, if (bid < 64) ph_scan(p, sm, bid, 64); else ph_nsa_fast(p, sm, bid - 64, nb - 64);
             grid.sync();)
    GROUP(4, ph_rwkv_post(p, sm, bid, nb); grid.sync();
             ph_branch_a(p, sm, bid, nb); ph_branch_b(p, sm, bid, nb); grid.sync();
             ph_outproj(p, sm, bid, nb); grid.sync();
             ph_ln1(p, sm, bid, nb); grid.sync();)
    GROUP(5, ph_router_gemm(p, sm, bid, nb); ph_shared_gu(p, sm, bid, nb); grid.sync();
             ph_router_sel(p, sm, bid, nb); ph_shared_down(p, sm, bid, nb); grid.sync();
             ph_lists(p, sm, bid, nb); grid.sync();)
    GROUP(6, ph_moe_gu(p, sm, bid, nb); grid.sync();
             ph_moe_down(p, sm, bid, nb); grid.sync();)
    ph_final(p, sm, bid, nb);
}
}

extern "C" void kernel_launch(void* const* d_in, const int* in_sizes, int n_in, void* d_out, int out_size, void* d_ws, size_t ws_size, hipStream_t stream) {
    Params p{};
    const float* const* in = (const float* const*)d_in;
    p.x = in[0]; p.w_in = in[1]; p.mu = in[2]; p.w0 = in[3]; p.w2 = in[4]; p.a0 = in[5]; p.a2 = in[6]; p.g2 = in[7]; p.k_k = in[8]; p.k_a = in[9];
    p.r_k = in[10]; p.lnx_w = in[11]; p.lnx_b = in[12]; p.pe_k = in[13]; p.w1_k = in[14]; p.w2_k = in[15]; p.pe_v = in[16]; p.w1_v = in[17]; p.w2_v = in[18];
    p.wba = in[19]; p.wbb = in[20]; p.wout = in[21]; p.ln1g = in[22]; p.ln1b = in[23]; p.rw = in[24]; p.rbias = in[25]; p.egu = in[26]; p.edown = in[27];
    p.sgu = in[28]; p.sdown = in[29]; p.ln2g = in[30]; p.ln2b = in[31];
    p.out = (float*)d_out;
    char* w = (char*)d_ws; size_t off = 0;
    auto carve = [&](size_t bytes) { char* r = w + off; off += (bytes + 255) & ~(size_t)255; return r; };
    p.P = (float*)carve((size_t)T * INW * 4);
    p.R = (float*)carve((size_t)T * 512 * 4); p.DC = (float*)carve((size_t)T * 512 * 4); p.K2 = (float*)carve((size_t)T * 512 * 4); p.V = (float*)carve((size_t)T * 512 * 4);
    p.KK = (float*)carve((size_t)T * 512 * 4); p.BB = (float*)carve((size_t)T * 512 * 4); p.G = (float*)carve((size_t)T * 512 * 4);
    p.O = (float*)carve((size_t)T * 512 * 4); p.YA = (float*)carve((size_t)T * 512 * 4);
    p.QR = (float*)carve((size_t)T * 512 * 4); p.KSR = (float*)carve((size_t)T * 128 * 4); p.KWR = (float*)carve((size_t)T * 128 * 4);
    p.KCraw = (float*)carve((size_t)NCROWS * 64 * 4); p.KCR = (float*)carve((size_t)NCROWS * 64 * 4); p.VC = (float*)carve((size_t)NCROWS * 64 * 4);
    p.H1K = (float*)carve((size_t)NCROWS * 256 * 4); p.H1V = (float*)carve((size_t)NCROWS * 256 * 4);
    p.YB = (float*)carve((size_t)T * 512 * 4);
    p.Z = (float*)carve((size_t)T * D * 4); p.PRE1 = (float*)carve((size_t)T * D * 4); p.X1 = (float*)carve((size_t)T * D * 4);
    p.LOGITS = (float*)carve((size_t)T * NE * 4); p.EW = (float*)carve((size_t)T * 8 * 4); p.EIDX = (int*)carve((size_t)T * 8 * 4);
    p.LIST = (int*)carve((size_t)NE * LISTCAP * 4); p.CNT = (int*)carve(1024);
    p.Xb = (unsigned short*)carve((size_t)T * D * 2); p.YAb = (unsigned short*)carve((size_t)T * 512 * 2); p.YBb = (unsigned short*)carve((size_t)T * 512 * 2);
    p.Zb = (unsigned short*)carve((size_t)T * D * 2); p.X1b = (unsigned short*)carve((size_t)T * D * 2);
    p.Qb = (unsigned short*)carve((size_t)T * 512 * 2); p.KSb = (unsigned short*)carve((size_t)T * 128 * 2); p.VSb = (unsigned short*)carve((size_t)T * 128 * 2);
    p.KWb = (unsigned short*)carve((size_t)T * 128 * 2); p.VWb = (unsigned short*)carve((size_t)T * 128 * 2);
    p.KCb = (unsigned short*)carve((size_t)4 * 512 * 64 * 2); p.VCb = (unsigned short*)carve((size_t)4 * 512 * 64 * 2);
    p.GT = (float*)carve((size_t)T * 24 * 4);
    p.OC = (float*)carve((size_t)T * 512 * 4); p.OS = (float*)carve((size_t)T * 512 * 4); p.OW = (float*)carve((size_t)T * 512 * 4);
    p.OCf = (float*)carve((size_t)T * 512 * 4); p.OSf = (float*)carve((size_t)T * 512 * 4); p.OWf = (float*)carve((size_t)T * 512 * 4);
    p.SELM = (unsigned*)carve((size_t)T * 2 * 4 * 4); p.SELMf = (unsigned*)carve((size_t)T * 2 * 4 * 4);
    p.ACTS = (unsigned short*)carve((size_t)T * 256 * 2); p.SH = (float*)carve((size_t)T * D * 4);
    p.ACT = (unsigned short*)carve((size_t)T * 8 * 256 * 2);
    p.Y = (float*)carve((size_t)T * 8 * D * 4);
    if (off > ws_size) { fprintf(stderr, "kernel_launch: workspace too small: need %zu have %zu\n", off, ws_size); return; }
    static int grid_blocks = 0;
    if (!grid_blocks) {
        int dev = 0, cus = 0, per_cu = 0;
        hipGetDevice(&dev);
        hipDeviceGetAttribute(&cus, hipDeviceAttributeMultiprocessorCount, dev);
        hipOccupancyMaxActiveBlocksPerMultiprocessor(&per_cu, mega, NT, 0);
        if (per_cu > 2) per_cu = 2;
        if (per_cu < 1) per_cu = 1;
        grid_blocks = cus * per_cu;
    }
    void* args[] = {&p};
    hipError_t e = hipLaunchCooperativeKernel((void*)mega, dim3(grid_blocks), dim3(NT), args, 0, stream);
    if (e != hipSuccess) fprintf(stderr, "cooperative launch failed: %s (grid %d)\n", hipGetErrorString(e), grid_blocks);
}
```

```cpp
#include <hip/hip_runtime.h>
#include <hip/hip_cooperative_groups.h>
#include <cstdio>
#include <cstdint>
#include <cmath>

namespace {

constexpr int NB = 2, S = 8192, T = NB * S, D = 1024, INW = 5144;
constexpr int C_R = 0, C_K = 512, C_V = 1024, C_WL = 1536, C_AL = 1600, C_GL = 1664, RW_IN = 1792;
constexpr int C_Q = 1792, C_KC = 2304, C_VC = 2432, C_KS = 2560, C_VS = 2688, C_KW = 2816, C_VW = 2944, C_GT = 3072;
constexpr int C_GA = 3096, C_GB = 4120;
constexpr int NCMP = 511, NCROWS = NB * NCMP * 2;
constexpr int NE = 256, TOPK = 8, LISTCAP = 16384;
constexpr float ALPHA = 1.189207115002721f;
constexpr float QSCALE = 0.125f * 1.4426950408889634f;
constexpr int NT = 256;

struct Params {
    const float *x, *w_in, *mu, *w0, *w2, *a0, *a2, *g2, *k_k, *k_a, *r_k, *lnx_w, *lnx_b;
    const float *pe_k, *w1_k, *w2_k, *pe_v, *w1_v, *w2_v, *wba, *wbb, *wout, *ln1g, *ln1b;
    const float *rw, *rbias, *egu, *edown, *sgu, *sdown, *ln2g, *ln2b;
    float* out;
    unsigned short* P;
    float *R, *DC, *K2, *V, *KK, *BB, *G, *O, *YA, *QR, *KSR, *KWR, *KCraw, *KCR, *VC, *H1K, *H1V, *YB, *Z, *PRE1, *X1;
    float *LOGITS, *EW, *SH;
    unsigned short* Y;
    unsigned short *ACT, *ACTS, *Xb, *YAb, *YBb, *Zb, *X1b;
    unsigned short *Qb, *KSb, *VSb, *KWb, *VWb, *KCb, *VCb;
    float *GT, *OC, *OS, *OW, *OCf, *OSf, *OWf;
    unsigned *SELM, *SELMf;
    unsigned short *WINb, *WBAb, *WBBb, *WOUTb, *RWb, *SGUb, *SDOWNb, *W1Kb, *W1Vb, *W2Kb, *W2Vb, *LW2b, *LA2b, *LG2b;
    unsigned short *LORA, *KCin, *VCin, *H1Kb, *H1Vb;
    float *TABC, *TABS, *CB, *KSH;
    int *EIDX, *LIST, *CNT;
    unsigned* BAR;
    int pad_[2];
};

__device__ __forceinline__ float wave_sum(float v) {
#pragma unroll
    for (int o = 1; o < 64; o <<= 1) v += __shfl_xor(v, o);
    return v;
}
__device__ __forceinline__ float wave_max(float v) {
#pragma unroll
    for (int o = 1; o < 64; o <<= 1) v = fmaxf(v, __shfl_xor(v, o));
    return v;
}
__device__ __forceinline__ float sigmoidf_(float x) { return 1.0f / (1.0f + expf(-x)); }
__device__ __forceinline__ float gelu_tanh(float x) { return 0.5f * x * (1.0f + tanhf(0.7978845608028654f * (x + 0.044715f * x * x * x))); }

template <class AL, class BL, class EP>
__device__ __forceinline__ void sgemm_unit(float* sm, int K, const AL& aload, const BL& bload, const EP& epi) {
    float (*As)[68] = (float (*)[68])sm;
    float (*Bs)[68] = (float (*)[68])(sm + 16 * 68);
    const int tid = threadIdx.x, ty = tid >> 4, tx = tid & 15;
    const int arow = tid >> 2, ak = (tid & 3) * 4, bk = tid >> 4, bn = (tid & 15) * 4;
    float acc[4][4];
#pragma unroll
    for (int i = 0; i < 4; ++i)
#pragma unroll
        for (int j = 0; j < 4; ++j) acc[i][j] = 0.f;
    for (int k0 = 0; k0 < K; k0 += 16) {
        const float4 av = aload(arow, k0 + ak);
        const float4 bv = bload(k0 + bk, bn);
        __syncthreads();
        As[ak + 0][arow] = av.x; As[ak + 1][arow] = av.y; As[ak + 2][arow] = av.z; As[ak + 3][arow] = av.w;
        *(float4*)&Bs[bk][bn] = bv;
        __syncthreads();
#pragma unroll
        for (int k = 0; k < 16; ++k) {
            const float4 a = *(const float4*)&As[k][ty * 4];
            const float4 b = *(const float4*)&Bs[k][tx * 4];
            acc[0][0] += a.x * b.x; acc[0][1] += a.x * b.y; acc[0][2] += a.x * b.z; acc[0][3] += a.x * b.w;
            acc[1][0] += a.y * b.x; acc[1][1] += a.y * b.y; acc[1][2] += a.y * b.z; acc[1][3] += a.y * b.w;
            acc[2][0] += a.z * b.x; acc[2][1] += a.z * b.y; acc[2][2] += a.z * b.z; acc[2][3] += a.z * b.w;
            acc[3][0] += a.w * b.x; acc[3][1] += a.w * b.y; acc[3][2] += a.w * b.z; acc[3][3] += a.w * b.w;
        }
    }
#pragma unroll
    for (int i = 0; i < 4; ++i) epi(ty * 4 + i, tx * 4, make_float4(acc[i][0], acc[i][1], acc[i][2], acc[i][3]));
}

template <class EP>
__device__ __forceinline__ void dense_gemm_phase(float* sm, int bid, int nb, const float* A, int lda, const float* B, int ldb, int M, int N, int K, const EP& epi) {
    const int ntn = (N + 63) / 64, nu = (M / 64) * ntn;
    for (int u = bid; u < nu; u += nb) {
        const int m0 = (u / ntn) * 64, n0 = (u % ntn) * 64;
        auto al = [&](int m, int k) { return *(const float4*)(A + (size_t)(m0 + m) * lda + k); };
        auto bl = [&](int k, int n) { return (n0 + n < N) ? *(const float4*)(B + (size_t)k * ldb + n0 + n) : make_float4(0.f, 0.f, 0.f, 0.f); };
        auto ep = [&](int m, int n, float4 v) { if (n0 + n < N) epi(m0 + m, n0 + n, v); };
        sgemm_unit(sm, K, al, bl, ep);
    }
}

typedef short s16x8 __attribute__((ext_vector_type(8)));
typedef short s16x4 __attribute__((ext_vector_type(4)));
typedef float f32x4 __attribute__((ext_vector_type(4)));
typedef float f32x2 __attribute__((ext_vector_type(2)));
typedef __bf16 bf16x2_t __attribute__((ext_vector_type(2)));
typedef unsigned short bf16_t;
#define LAS __attribute__((address_space(3)))
__device__ __forceinline__ unsigned cvtpk(float lo, float hi) { f32x2 v = {lo, hi}; bf16x2_t b = __builtin_convertvector(v, bf16x2_t); return __builtin_bit_cast(unsigned, b); }
__device__ __forceinline__ float bf2f(unsigned short h) { return __uint_as_float(((unsigned)h) << 16); }
__device__ __forceinline__ int bimg_off(int k, int ch) { return 256 * k + 16 * (ch ^ (((k & 3) << 2) | ((k >> 2) & 3))); }

template <bool B_F32, bool GLU, class AR, class BC, class EP>
__device__ __forceinline__ void mgemm_unit(char* lds, int K, const AR& arow, const void* Bp, int ldb, const BC& bcol, const EP& epi) {
    const int tid = threadIdx.x, lane = tid & 63, wid = tid >> 6, wm = wid >> 1, wn = wid & 1, fr = lane & 15, fq = lane >> 4;
    const int ac = tid & 7;
    const char* ap[4];
#pragma unroll
    for (int i = 0; i < 4; ++i) ap[i] = (const char*)arow((tid >> 3) + 32 * i);
    const int ao0 = (tid >> 3) * 128 + ((ac ^ ((tid >> 4) & 7)) << 4);
    const char* bp; int bo_e, bo_o;
    if constexpr (B_F32) {
        const int n4 = tid & 31, kb = tid >> 5; const int col = bcol(n4 * 4);
        bp = (const char*)((const float*)Bp + col) + (size_t)kb * ldb * 4;
        bo_e = 16384 + bimg_off(kb, n4 >> 1) + 8 * (n4 & 1); bo_o = 16384 + bimg_off(kb + 8, n4 >> 1) + 8 * (n4 & 1);
    } else {
        const int ch = tid & 15, kb = tid >> 4; const int col = bcol(ch * 8);
        bp = (const char*)((const bf16_t*)Bp + col) + (size_t)kb * ldb * 2;
        bo_e = 16384 + bimg_off(kb, ch); bo_o = 0;
    }
    const int a_base = (wm * 64 + fr) * 128, a_sw = (fr >> 1) & 7;
    const int li = lane & 15, wq = li >> 2, wp = li & 3;
    uint4 ra0, ra1, ra2, ra3; float4 rf0, rf1, rf2, rf3, rf4, rf5, rf6, rf7; uint4 rb0, rb1, rb2, rb3;
#define MG_LOAD_TILES(kt_) do { \
        const size_t ka_ = (size_t)((kt_) * 64 + ac * 8) * 2; \
        ra0 = *(const uint4*)(ap[0] + ka_); ra1 = *(const uint4*)(ap[1] + ka_); ra2 = *(const uint4*)(ap[2] + ka_); ra3 = *(const uint4*)(ap[3] + ka_); \
        if constexpr (B_F32) { const char* b_ = bp + (size_t)((kt_) * 64) * ldb * 4; const size_t st_ = (size_t)8 * ldb * 4; \
            rf0 = *(const float4*)(b_); rf1 = *(const float4*)(b_ + st_); rf2 = *(const float4*)(b_ + 2 * st_); rf3 = *(const float4*)(b_ + 3 * st_); \
            rf4 = *(const float4*)(b_ + 4 * st_); rf5 = *(const float4*)(b_ + 5 * st_); rf6 = *(const float4*)(b_ + 6 * st_); rf7 = *(const float4*)(b_ + 7 * st_); } \
        else { const char* b_ = bp + (size_t)((kt_) * 64) * ldb * 2; const size_t st_ = (size_t)16 * ldb * 2; \
            rb0 = *(const uint4*)(b_); rb1 = *(const uint4*)(b_ + st_); rb2 = *(const uint4*)(b_ + 2 * st_); rb3 = *(const uint4*)(b_ + 3 * st_); } \
    } while (0)
#define MG_CVT8(buf_, off_, v_) do { uint2 w_; w_.x = cvtpk((v_).x, (v_).y); w_.y = cvtpk((v_).z, (v_).w); *(uint2*)((buf_) + (off_)) = w_; } while (0)
#define MG_STORE_TILES(buf_) do { \
        *(uint4*)((buf_) + ao0) = ra0; *(uint4*)((buf_) + ao0 + 4096) = ra1; *(uint4*)((buf_) + ao0 + 8192) = ra2; *(uint4*)((buf_) + ao0 + 12288) = ra3; \
        if constexpr (B_F32) { \
            MG_CVT8(buf_, bo_e, rf0); MG_CVT8(buf_, bo_o, rf1); MG_CVT8(buf_, bo_e + 4096, rf2); MG_CVT8(buf_, bo_o + 4096, rf3); \
            MG_CVT8(buf_, bo_e + 8192, rf4); MG_CVT8(buf_, bo_o + 8192, rf5); MG_CVT8(buf_, bo_e + 12288, rf6); MG_CVT8(buf_, bo_o + 12288, rf7); } \
        else { *(uint4*)((buf_) + bo_e) = rb0; *(uint4*)((buf_) + bo_e + 4096) = rb1; *(uint4*)((buf_) + bo_e + 8192) = rb2; *(uint4*)((buf_) + bo_e + 12288) = rb3; } \
    } while (0)
    f32x4 acc[4][4];
#pragma unroll
    for (int i = 0; i < 4; ++i)
#pragma unroll
        for (int j = 0; j < 4; ++j) acc[i][j] = (f32x4){0.f, 0.f, 0.f, 0.f};
    const int nk = K / 64;
    __syncthreads();
    MG_LOAD_TILES(0);
    MG_STORE_TILES(lds);
    __syncthreads();
    for (int kt = 0; kt < nk; ++kt) {
        char* cur = lds + (kt & 1) * 32768;
        if (kt + 1 < nk) MG_LOAD_TILES(kt + 1);
        __builtin_amdgcn_sched_barrier(0);
#pragma unroll
        for (int ks = 0; ks < 2; ++ks) {
            s16x8 af[4], wf[4];
            const int axor = ((ks * 4 + fq) ^ a_sw) << 4;
#pragma unroll
            for (int mi = 0; mi < 4; ++mi) af[mi] = *(const s16x8*)(cur + a_base + mi * 2048 + axor);
            const int r1 = ks * 32 + 8 * fq + wq, r2 = r1 + 4;
#pragma unroll
            for (int ni = 0; ni < 4; ++ni) {
                const int chunk = wn * 8 + ni * 2 + (wp >> 1);
                const LAS char* p1 = (const LAS char*)(cur + 16384 + bimg_off(r1, chunk) + 8 * (wp & 1));
                const LAS char* p2 = (const LAS char*)(cur + 16384 + bimg_off(r2, chunk) + 8 * (wp & 1));
                const s16x4 t1 = __builtin_bit_cast(s16x4, __builtin_amdgcn_ds_read_tr16_b64_v4i16((LAS s16x4*)p1));
                const s16x4 t2 = __builtin_bit_cast(s16x4, __builtin_amdgcn_ds_read_tr16_b64_v4i16((LAS s16x4*)p2));
                wf[ni] = (s16x8){t1[0], t1[1], t1[2], t1[3], t2[0], t2[1], t2[2], t2[3]};
            }
#pragma unroll
            for (int mi = 0; mi < 4; ++mi)
#pragma unroll
                for (int ni = 0; ni < 4; ++ni) acc[mi][ni] = __builtin_amdgcn_mfma_f32_16x16x32_bf16(wf[ni], af[mi], acc[mi][ni], 0, 0, 0);
            if (ks == 0) __builtin_amdgcn_sched_barrier(0);
        }
        __builtin_amdgcn_sched_barrier(0);
        if (kt + 1 < nk) MG_STORE_TILES(lds + ((kt + 1) & 1) * 32768);
        __syncthreads();
    }
    {
        constexpr int NCH = GLU ? 16 : 32;
#pragma unroll
        for (int mi = 0; mi < 4; ++mi) {
            const int m = wm * 64 + mi * 16 + fr;
            if constexpr (GLU) {
#pragma unroll
                for (int ni = 0; ni < 2; ++ni) {
                    const f32x4 g = acc[mi][ni], u = acc[mi][ni + 2];
                    f32x4 r;
#pragma unroll
                    for (int j = 0; j < 4; ++j) r[j] = g[j] / (1.0f + expf(-g[j])) * u[j];
                    const int ch = wn * 8 + ni * 4 + fq;
                    *(f32x4*)(lds + m * 256 + ((ch ^ (m & 7)) << 4)) = r;
                }
            } else {
#pragma unroll
                for (int ni = 0; ni < 4; ++ni) { const int ch = wn * 16 + ni * 4 + fq; *(f32x4*)(lds + m * 512 + ((ch ^ (m & 7)) << 4)) = acc[mi][ni]; }
            }
        }
        __syncthreads();
#pragma unroll 4
        for (int i = 0; i < NCH / 2; ++i) {
            const int idx = i * 256 + tid, m = idx / NCH, ch = idx % NCH;
            const f32x4 v = *(const f32x4*)(lds + m * (NCH * 16) + ((ch ^ (m & 7)) << 4));
            epi(m, ch * 4, v);
        }
    }
}

__device__ __forceinline__ unsigned short f2bf(float v) { return (unsigned short)(cvtpk(v, 0.f) & 0xffffu); }
__device__ __forceinline__ void cvt_seg(const float* src, unsigned short* dst, size_t n, int bid, int nb) {
    const size_t n8 = n / 8;
    for (size_t i = (size_t)bid * NT + threadIdx.x; i < n8; i += (size_t)nb * NT) {
        const float4 a = *(const float4*)(src + i * 8), b = *(const float4*)(src + i * 8 + 4);
        uint4 v; v.x = cvtpk(a.x, a.y); v.y = cvtpk(a.z, a.w); v.z = cvtpk(b.x, b.y); v.w = cvtpk(b.z, b.w);
        *(uint4*)(dst + i * 8) = v;
    }
}
__device__ __forceinline__ void ph_cvt_x(const Params& p, float* sm, int bid, int nb) {
    cvt_seg(p.x, p.Xb, (size_t)T * D, bid, nb);
    cvt_seg(p.w_in, p.WINb, (size_t)D * INW, bid, nb);
    cvt_seg(p.wba, p.WBAb, (size_t)512 * D, bid, nb); cvt_seg(p.wbb, p.WBBb, (size_t)512 * D, bid, nb); cvt_seg(p.wout, p.WOUTb, (size_t)D * D, bid, nb);
    cvt_seg(p.rw, p.RWb, (size_t)D * NE, bid, nb); cvt_seg(p.sgu, p.SGUb, (size_t)D * 512, bid, nb); cvt_seg(p.sdown, p.SDOWNb, (size_t)256 * D, bid, nb);
    cvt_seg(p.w1_k, p.W1Kb, (size_t)2048 * 256, bid, nb); cvt_seg(p.w1_v, p.W1Vb, (size_t)2048 * 256, bid, nb);
    cvt_seg(p.w2_k, p.W2Kb, (size_t)256 * 64, bid, nb); cvt_seg(p.w2_v, p.W2Vb, (size_t)256 * 64, bid, nb);
    cvt_seg(p.w2, p.LW2b, (size_t)64 * 512, bid, nb); cvt_seg(p.a2, p.LA2b, (size_t)64 * 512, bid, nb); cvt_seg(p.g2, p.LG2b, (size_t)128 * 512, bid, nb);
    for (int i = bid * NT + threadIdx.x; i < S * 32; i += nb * NT) {
        const int pos = i >> 5, d = i & 31;
        const float inv = (float)pow(10000.0, -(double)d / 32.0);
        float sn, cs; sincosf((float)pos * inv, &sn, &cs);
        p.TABC[i] = cs; p.TABS[i] = sn;
    }
    if (bid < 2) {
        const float* pe = bid ? p.pe_v : p.pe_k; const float* w1 = bid ? p.w1_v : p.w1_k;
        float acc = 0.f;
        for (int k = 0; k < 2048; ++k) acc += pe[k] * w1[(size_t)k * 256 + threadIdx.x];
        p.CB[bid * 256 + threadIdx.x] = acc;
    }
}
__device__ __forceinline__ int xcd_tile(int ul, int nM, int nN, int x) {
    const int q = nN >> 3, r = nN & 7, nmain = nM * q;
    if (ul < nmain) return ((ul / q) << 16) | (x + 8 * (ul % q));
    const int v = ul - nmain, per = nM >> 3;
    if (v < per * r) return (((v % per) * 8 + x) << 16) | (8 * q + v / per);
    return -1;
}
#define XCD_TILE_LOOP(nM_, nN_) for (int ul_ = bid >> 3, tc_ = xcd_tile(ul_, (nM_), (nN_), bid & 7); tc_ >= 0; ul_ += nb >> 3, tc_ = xcd_tile(ul_, (nM_), (nN_), bid & 7))
#define tm_ (tc_ >> 16)
#define tn_ (tc_ & 0xffff)
__device__ __forceinline__ void ph_inproj(const Params& p, float* sm, int bid, int nb) {
    bf16_t* P = p.P; const bf16_t* x = p.Xb;
    XCD_TILE_LOOP(T / 128, (INW + 127) / 128) {
        const int m0 = tm_ * 128, n0 = tn_ * 128;
        auto ar = [&](int r) { return (const void*)(x + (size_t)(m0 + r) * D); };
        auto bc = [&](int c) { return (n0 + c < INW) ? n0 + c : INW - 8; };
        auto ep = [&](int m, int n, f32x4 v) { if (n0 + n < INW) { uint2 w; w.x = cvtpk(v[0], v[1]); w.y = cvtpk(v[2], v[3]); *(uint2*)(P + (size_t)(m0 + m) * INW + n0 + n) = w; } };
        mgemm_unit<false, false>((char*)sm, D, ar, p.WINb, INW, bc, ep);
    }
}

__device__ __forceinline__ void ph_prep(const Params& p, float* sm, int bid, int nb) {
    float* xs = sm;
    const int tid = threadIdx.x;
    for (int t = bid; t < T; t += nb) {
        const int s = t & (S - 1), b = t >> 13;
        const bf16_t* Pt = p.P + (size_t)t * INW;
        __syncthreads();
        for (int c = tid; c < RW_IN; c += NT) {
            const float cur = bf2f(Pt[c]);
            const float prev = (s > 0) ? bf2f(Pt[c - INW]) : 0.f;
            xs[c] = cur + (prev - cur) * p.mu[c];
        }
        __syncthreads();
#pragma unroll
        for (int slot = 0; slot < 2; ++slot) {
            const int c = tid + slot * 256;
            const float kraw = xs[C_K + c];
            const float kkv = kraw * p.k_k[c];
            const float ss = wave_sum(kkv * kkv);
            const float nrm = fmaxf(sqrtf(ss), 1e-12f);
            const size_t o = (size_t)t * 512 + c;
            p.R[o] = xs[C_R + c]; p.V[o] = xs[C_V + c]; p.KSH[o] = kraw; p.KK[o] = kkv / nrm;
        }
        {
            float v;
            if (tid < 64) v = tanhf(xs[C_WL + tid]); else if (tid < 128) v = xs[C_AL + tid - 64]; else v = sigmoidf_(xs[C_GL + tid - 128]);
            p.LORA[(size_t)t * 256 + tid] = f2bf(v);
        }
        for (int pi = tid; pi < 12 * 32; pi += NT) {
            const int hs = pi >> 5, i = pi & 31;
            const float cs = p.TABC[s * 32 + i], sn = p.TABS[s * 32 + i];
            const bf16_t* src = (hs < 8) ? Pt + C_Q + hs * 64 : (hs < 10) ? Pt + C_KS + (hs - 8) * 64 : Pt + C_KW + (hs - 10) * 64;
            const float x1 = bf2f(src[i]), x2 = bf2f(src[i + 32]);
            const float y1 = x1 * cs - x2 * sn, y2 = x2 * cs + x1 * sn;
            if (hs < 8) { p.Qb[(size_t)t * 512 + hs * 64 + i] = f2bf(y1 * QSCALE); p.Qb[(size_t)t * 512 + hs * 64 + i + 32] = f2bf(y2 * QSCALE); }
            else if (hs < 10) { p.KSb[(size_t)t * 128 + (hs - 8) * 64 + i] = f2bf(y1); p.KSb[(size_t)t * 128 + (hs - 8) * 64 + i + 32] = f2bf(y2); }
            else { p.KWb[(size_t)t * 128 + (hs - 10) * 64 + i] = f2bf(y1); p.KWb[(size_t)t * 128 + (hs - 10) * 64 + i + 32] = f2bf(y2); }
        }
        if (tid < 128) {
            p.VSb[(size_t)t * 128 + tid] = Pt[C_VS + tid]; p.VWb[(size_t)t * 128 + tid] = Pt[C_VW + tid];
            const int g = tid >> 6, d = tid & 63;
            p.KCin[((size_t)(b * 2 + g) * S + s) * 64 + d] = Pt[C_KC + tid];
            p.VCin[((size_t)(b * 2 + g) * S + s) * 64 + d] = Pt[C_VC + tid];
        }
        if (tid < 24) p.GT[(size_t)t * 24 + tid] = sigmoidf_(bf2f(Pt[C_GT + tid]));
    }
}
__device__ __forceinline__ void ph_prep_gemm(const Params& p, float* sm, int bid, int nb) {
    const int n_lora = (T / 128) * 4 * 3, n_cmp = 16 * 2 * 2;
    for (int u = bid; u < n_lora + n_cmp; u += nb) {
        if (u < n_lora) {
            const int part = u % 3, n0 = ((u / 3) % 4) * 128, m0 = (u / 12) * 128;
            const bf16_t* A = p.LORA + (part == 0 ? 0 : part == 1 ? 64 : 128);
            const bf16_t* Bw = (part == 0) ? p.LW2b : (part == 1) ? p.LA2b : p.LG2b;
            auto ar = [&](int r) { return (const void*)(A + (size_t)(m0 + r) * 256); };
            auto bc = [&](int c) { return n0 + c; };
            if (part == 0) {
                float* DC = p.DC; const float* w0 = p.w0;
                auto ep = [&](int m, int n, f32x4 v) {
                    const int c = n0 + n; const f32x4 w0v = *(const f32x4*)(w0 + c); f32x4 o;
#pragma unroll
                    for (int j = 0; j < 4; ++j) { const float nx = -(w0v[j] + v[j]); const float sp = (nx > 20.f) ? nx : log1pf(expf(nx)); o[j] = expf(-expf(-sp - 0.5f)); }
                    *(f32x4*)(DC + (size_t)(m0 + m) * 512 + c) = o;
                };
                mgemm_unit<false, false>((char*)sm, 64, ar, Bw, 512, bc, ep);
            } else if (part == 1) {
                float* K2 = p.K2; float* BB = p.BB; const float* KSH = p.KSH; const float* KK = p.KK; const float* a0 = p.a0; const float* k_a = p.k_a;
                auto ep = [&](int m, int n, f32x4 v) {
                    const int c = n0 + n; const size_t o = (size_t)(m0 + m) * 512 + c;
                    const f32x4 a0v = *(const f32x4*)(a0 + c), kav = *(const f32x4*)(k_a + c), kv = *(const f32x4*)(KSH + o), kkv = *(const f32x4*)(KK + o);
                    f32x4 k2, bb;
#pragma unroll
                    for (int j = 0; j < 4; ++j) { const float a = sigmoidf_(a0v[j] + v[j]); k2[j] = kv[j] * (1.0f + (a - 1.0f) * kav[j]); bb[j] = kkv[j] * a; }
                    *(f32x4*)(K2 + o) = k2; *(f32x4*)(BB + o) = bb;
                };
                mgemm_unit<false, false>((char*)sm, 64, ar, Bw, 512, bc, ep);
            } else {
                float* G = p.G;
                auto ep = [&](int m, int n, f32x4 v) { *(f32x4*)(G + (size_t)(m0 + m) * 512 + n0 + n) = v; };
                mgemm_unit<false, false>((char*)sm, 128, ar, Bw, 512, bc, ep);
            }
        } else {
            const int v = u - n_lora, kv = v & 1, n0 = ((v >> 1) & 1) * 128, m0 = (v >> 2) * 128;
            const bf16_t* IN = kv ? p.VCin : p.KCin; const bf16_t* Bw = kv ? p.W1Vb : p.W1Kb; bf16_t* H1 = kv ? p.H1Vb : p.H1Kb; const float* cb = p.CB + kv * 256;
            auto ar = [&](int r) { int rr = m0 + r; if (rr >= NCROWS) rr = NCROWS - 1; const int g = rr & 1, bc_ = rr >> 1, b = bc_ / NCMP, c = bc_ % NCMP; return (const void*)(IN + ((size_t)(b * 2 + g) * S + 16 * c) * 64); };
            auto bc = [&](int c) { return n0 + c; };
            auto ep = [&](int m, int n, f32x4 v4) {
                const int rr = m0 + m; if (rr >= NCROWS) return;
                const f32x4 bv = *(const f32x4*)(cb + n0 + n);
                uint2 w; w.x = cvtpk(gelu_tanh(v4[0] + bv[0]), gelu_tanh(v4[1] + bv[1])); w.y = cvtpk(gelu_tanh(v4[2] + bv[2]), gelu_tanh(v4[3] + bv[3]));
                *(uint2*)(H1 + (size_t)rr * 256 + n0 + n) = w;
            };
            mgemm_unit<false, false>((char*)sm, 2048, ar, Bw, 256, bc, ep);
        }
    }
}

constexpr int SCH = 16;
constexpr int SCH_FLOATS = SCH * (5 * 64 + 16);
template <int CTRL> __device__ __forceinline__ float dpp_mov(float v) { return __builtin_bit_cast(float, __builtin_amdgcn_update_dpp(0, __builtin_bit_cast(int, v), CTRL, 0xf, 0xf, false)); }
__device__ __forceinline__ float row16_sum(float x) {
    x += dpp_mov<0xB1>(x);
    x += dpp_mov<0x4E>(x);
    x += dpp_mov<0x141>(x);
    x += dpp_mov<0x140>(x);
    return x;
}
__device__ __forceinline__ void ph_scan(const Params& p, float* sm, int bid, int nb) {
    const int tid = threadIdx.x, row = tid >> 4, q = tid & 15;
    for (int item = bid; item < 64; item += nb) {
        const int b = item >> 5, h = (item >> 2) & 7, qu = item & 3;
        const int st_ = tid >> 4, part = tid & 15;
        const size_t gbase = ((size_t)(b * S + st_)) * 512 + h * 64 + part * 4;
        const size_t vbase = ((size_t)(b * S + st_)) * 512 + h * 64 + qu * 16 + part;
        float4 pr, pd, pk, pkk, pb; float pv;
        auto gload = [&](int t0) {
            const size_t o = gbase + (size_t)t0 * 512;
            pr = *(const float4*)(p.R + o); pd = *(const float4*)(p.DC + o); pk = *(const float4*)(p.K2 + o); pkk = *(const float4*)(p.KK + o); pb = *(const float4*)(p.BB + o);
            pv = p.V[vbase + (size_t)t0 * 512];
        };
        auto lstore = [&](float* buf) {
            float* d = buf + st_ * 320 + part * 4;
            *(float4*)(d) = pr; *(float4*)(d + 64) = pd; *(float4*)(d + 128) = pk; *(float4*)(d + 192) = pkk; *(float4*)(d + 256) = pb;
            buf[SCH * 320 + st_ * 16 + part] = pv;
        };
        float s0 = 0.f, s1 = 0.f, s2 = 0.f, s3 = 0.f;
        __syncthreads();
        gload(0); lstore(sm);
        __syncthreads();
        for (int t0 = 0; t0 < S; t0 += SCH) {
            const float* cur = sm + ((t0 / SCH) & 1) * SCH_FLOATS;
            if (t0 + SCH < S) gload(t0 + SCH);
            __builtin_amdgcn_sched_barrier(0);
            const float* d0 = cur + q * 4;
            const float* v0 = cur + SCH * 320 + row;
            float4 rr = *(const float4*)(d0), dd = *(const float4*)(d0 + 64), kv = *(const float4*)(d0 + 128), kk = *(const float4*)(d0 + 192), bb = *(const float4*)(d0 + 256);
            float vv = v0[0];
            float oreg = 0.f;
#pragma unroll
            for (int st = 0; st < SCH; ++st) {
                float4 rr2 = rr, dd2 = dd, kv2 = kv, kk2 = kk, bb2 = bb; float vv2 = vv;
                if (st + 1 < SCH) {
                    const float* d = d0 + (st + 1) * 320;
                    rr2 = *(const float4*)(d); dd2 = *(const float4*)(d + 64); kv2 = *(const float4*)(d + 128); kk2 = *(const float4*)(d + 192); bb2 = *(const float4*)(d + 256);
                    vv2 = v0[(st + 1) * 16];
                }
                float sa = (s0 * kk.x + s1 * kk.y) + (s2 * kk.z + s3 * kk.w);
                sa = -row16_sum(sa);
                s0 = (s0 * dd.x + vv * kv.x) + sa * bb.x;
                s1 = (s1 * dd.y + vv * kv.y) + sa * bb.y;
                s2 = (s2 * dd.z + vv * kv.z) + sa * bb.z;
                s3 = (s3 * dd.w + vv * kv.w) + sa * bb.w;
                float o = (s0 * rr.x + s1 * rr.y) + (s2 * rr.z + s3 * rr.w);
                o = row16_sum(o);
                oreg = (q == st) ? o : oreg;
                rr = rr2; dd = dd2; kv = kv2; kk = kk2; bb = bb2; vv = vv2;
            }
            if (t0 + SCH < S) lstore(sm + (((t0 / SCH) + 1) & 1) * SCH_FLOATS);
            p.O[((size_t)(b * S + t0 + q)) * 512 + h * 64 + qu * 16 + row] = oreg;
            __syncthreads();
        }
    }
}

__device__ __forceinline__ void ph_rwkv_post(const Params& p, float* sm, int bid, int nb) {
    const int tid = threadIdx.x;
    for (int t = bid; t < T; t += nb) {
#pragma unroll
        for (int slot = 0; slot < 2; ++slot) {
            const int c = tid + slot * 256;
            const size_t o = (size_t)t * 512 + c;
            const float ov = p.O[o];
            const float m = wave_sum(ov) * (1.0f / 64.0f);
            const float dl = ov - m;
            const float var = wave_sum(dl * dl) * (1.0f / 64.0f);
            const float on = dl * rsqrtf(var + 64e-5f) * p.lnx_w[c] + p.lnx_b[c];
            const float bon = wave_sum(p.R[o] * p.K2[o] * p.r_k[c]) * p.V[o];
            p.YAb[o] = f2bf((on + bon) * p.G[o]);
        }
    }
}

__device__ __forceinline__ void ph_cmp2(const Params& p, float* sm, int bid, int nb) {
    for (int u = bid; u < 32; u += nb) {
        const int kv = u & 1, m0 = (u >> 1) * 128;
        const bf16_t* H1 = kv ? p.H1Vb : p.H1Kb; const bf16_t* Bw = kv ? p.W2Vb : p.W2Kb; float* OUT = kv ? p.VC : p.KCraw;
        auto ar = [&](int r) { int rr = m0 + r; if (rr >= NCROWS) rr = NCROWS - 1; return (const void*)(H1 + (size_t)rr * 256); };
        auto bc = [&](int c) { return (c < 64) ? c : 0; };
        auto ep = [&](int m, int n, f32x4 v) { const int rr = m0 + m; if (rr < NCROWS && n < 64) *(f32x4*)(OUT + (size_t)rr * 64 + n) = v; };
        mgemm_unit<false, false>((char*)sm, 256, ar, Bw, 64, bc, ep);
    }
}
__device__ __forceinline__ void ph_cmp_rope(const Params& p, float* sm, int bid, int nb) {
    const int tid = threadIdx.x;
    for (int i = bid * NT + tid; i < NCROWS * 32; i += nb * NT) {
        const int r = i >> 5, d = i & 31;
        const int c = (r >> 1) % NCMP;
        const int pos = 16 * c + 31;
        const float cs = p.TABC[pos * 32 + d], sn = p.TABS[pos * 32 + d];
        const float x1 = p.KCraw[(size_t)r * 64 + d], x2 = p.KCraw[(size_t)r * 64 + d + 32];
        const float y1 = x1 * cs - x2 * sn, y2 = x2 * cs + x1 * sn;
        const int g = r & 1, b = (r >> 1) / NCMP;
        const size_t ob = ((size_t)((b * 2 + g) * 512 + c)) * 64;
        p.KCb[ob + d] = f2bf(y1); p.KCb[ob + d + 32] = f2bf(y2);
        p.VCb[ob + d] = f2bf(p.VC[(size_t)r * 64 + d]); p.VCb[ob + d + 32] = f2bf(p.VC[(size_t)r * 64 + d + 32]);
    }
    for (int i = bid * NT + tid; i < 4 * 64; i += nb * NT) { const size_t ob = ((size_t)((i >> 6) * 512 + 511)) * 64 + (i & 63); p.KCb[ob] = 0; p.VCb[ob] = 0; }
}

__device__ __forceinline__ int kimg_off(int key, int c) { return key * 128 + ((c ^ ((key >> 1) & 7)) << 4); }
__device__ __forceinline__ int vimg_off(int key, int c) { return key * 128 + ((c ^ (((key >> 1) & 3) << 1)) << 4); }
__device__ __forceinline__ float fast_exp2(float x) { return __builtin_amdgcn_exp2f(x); }

struct NsaCtx {
    char* lds; int tid, lane, wave, fr, fq, li;
    s16x8 qf[2][2];
    int tq[2];
};

__device__ __forceinline__ void nsa_qk(const NsaCtx& c, const char* cur, f32x4 (&s)[2][4]) {
#pragma unroll
    for (int kt = 0; kt < 4; ++kt) {
#pragma unroll
        for (int ks = 0; ks < 2; ++ks) {
            const s16x8 kf = *(const s16x8*)(cur + kimg_off(kt * 16 + c.fr, ks * 4 + c.fq));
#pragma unroll
            for (int qt = 0; qt < 2; ++qt) {
                if (ks == 0) s[qt][kt] = __builtin_amdgcn_mfma_f32_16x16x32_bf16(kf, c.qf[qt][0], (f32x4){0.f, 0.f, 0.f, 0.f}, 0, 0, 0);
                else s[qt][kt] = __builtin_amdgcn_mfma_f32_16x16x32_bf16(kf, c.qf[qt][1], s[qt][kt], 0, 0, 0);
            }
        }
    }
}
__device__ __forceinline__ void nsa_pv(const NsaCtx& c, const char* cur, const f32x4 (&pr)[2][4], f32x4 (&O)[2][4]) {
    s16x8 pb[2][2];
#pragma unroll
    for (int qt = 0; qt < 2; ++qt)
#pragma unroll
        for (int k2 = 0; k2 < 2; ++k2) {
            const f32x4 a = pr[qt][2 * k2], b = pr[qt][2 * k2 + 1];
            const unsigned w0 = cvtpk(a[0], a[1]), w1 = cvtpk(a[2], a[3]), w2 = cvtpk(b[0], b[1]), w3 = cvtpk(b[2], b[3]);
            pb[qt][k2] = __builtin_bit_cast(s16x8, make_uint4(w0, w1, w2, w3));
        }
    const int q_ = c.li >> 2, p_ = c.li & 3;
#pragma unroll
    for (int dt = 0; dt < 4; ++dt)
#pragma unroll
        for (int k2 = 0; k2 < 2; ++k2) {
            const int key1 = k2 * 32 + 4 * c.fq + q_, key2 = key1 + 16;
            const int chunk = dt * 2 + (p_ >> 1);
            const LAS char* a1 = (const LAS char*)(cur + 8192 + vimg_off(key1, chunk) + 8 * (p_ & 1));
            const LAS char* a2 = (const LAS char*)(cur + 8192 + vimg_off(key2, chunk) + 8 * (p_ & 1));
            const s16x4 t1 = __builtin_bit_cast(s16x4, __builtin_amdgcn_ds_read_tr16_b64_v4i16((LAS s16x4*)a1));
            const s16x4 t2 = __builtin_bit_cast(s16x4, __builtin_amdgcn_ds_read_tr16_b64_v4i16((LAS s16x4*)a2));
            const s16x8 vf = (s16x8){t1[0], t1[1], t1[2], t1[3], t2[0], t2[1], t2[2], t2[3]};
#pragma unroll
            for (int qt = 0; qt < 2; ++qt) O[qt][dt] = __builtin_amdgcn_mfma_f32_16x16x32_bf16(vf, pb[qt][k2], O[qt][dt], 0, 0, 0);
        }
}
#define KVREGS uint4 rk0, rk1, rv0, rv1
#define KVARGS rk0, rk1, rv0, rv1
__device__ __forceinline__ void nsa_gload(const NsaCtx& c, uint4& rk0, uint4& rk1, uint4& rv0, uint4& rv1, const bf16_t* Kg, const bf16_t* Vg, int stride, int tile) {
    { const int idx = c.tid, key = idx >> 3, ch = idx & 7; const size_t off = (size_t)(tile * 64 + key) * stride + ch * 8; rk0 = *(const uint4*)(Kg + off); rv0 = *(const uint4*)(Vg + off); }
    { const int idx = 256 + c.tid, key = idx >> 3, ch = idx & 7; const size_t off = (size_t)(tile * 64 + key) * stride + ch * 8; rk1 = *(const uint4*)(Kg + off); rv1 = *(const uint4*)(Vg + off); }
}
__device__ __forceinline__ void nsa_lstore(const NsaCtx& c, const uint4& rk0, const uint4& rk1, const uint4& rv0, const uint4& rv1, char* buf) {
    { const int idx = c.tid, key = idx >> 3, ch = idx & 7; *(uint4*)(buf + kimg_off(key, ch)) = rk0; *(uint4*)(buf + 8192 + vimg_off(key, ch)) = rv0; }
    { const int idx = 256 + c.tid, key = idx >> 3, ch = idx & 7; *(uint4*)(buf + kimg_off(key, ch)) = rk1; *(uint4*)(buf + 8192 + vimg_off(key, ch)) = rv1; }
}
__device__ __forceinline__ bool selbit4(const unsigned (&w)[4], int tile) {
    const int wi = tile >> 5; const unsigned x = (wi == 0) ? w[0] : (wi == 1) ? w[1] : (wi == 2) ? w[2] : w[3];
    return ((x >> (tile & 31)) & 1u) != 0u;
}
__device__ __forceinline__ float xmax16_32(float v) { v = fmaxf(v, __shfl_xor(v, 16)); v = fmaxf(v, __shfl_xor(v, 32)); return v; }
__device__ __forceinline__ float xsum16_32(float v) { v += __shfl_xor(v, 16); v += __shfl_xor(v, 32); return v; }

template <int BR>
__device__ __forceinline__ void nsa_flash(const NsaCtx& c, const bf16_t* Kg, const bf16_t* Vg, int stride, int tile_lo, int tile_hi, const unsigned (&selw)[2][4],
                                          float (&m)[2], float (&l)[2], f32x4 (&O)[2][4]) {
    if (tile_lo > tile_hi) return;
    KVREGS;
    __syncthreads();
    nsa_gload(c, KVARGS, Kg, Vg, stride, tile_lo);
    nsa_lstore(c, KVARGS, c.lds);
    __syncthreads();
    for (int tile = tile_lo; tile <= tile_hi; ++tile) {
        char* cur = c.lds + ((tile - tile_lo) & 1) * 16384;
        if (tile < tile_hi) nsa_gload(c, KVARGS, Kg, Vg, stride, tile + 1);
        __builtin_amdgcn_sched_barrier(0);
        bool need = true;
        if (BR == 1) {
            const bool mine = selbit4(selw[0], tile) || selbit4(selw[1], tile);
            need = __ballot(mine) != 0ull;
        }
        if (need) {
            f32x4 s[2][4];
            nsa_qk(c, cur, s);
#pragma unroll
            for (int qt = 0; qt < 2; ++qt) {
                const int t = c.tq[qt];
                bool rowok = true;
                if (BR == 1) rowok = selbit4(selw[qt], tile);
                float tmax = -1e30f;
#pragma unroll
                for (int kt = 0; kt < 4; ++kt)
#pragma unroll
                    for (int r = 0; r < 4; ++r) {
                        const int kap = tile * 64 + kt * 16 + 4 * c.fq + r;
                        bool ok = rowok && (kap <= t);
                        if (BR == 2) ok = ok && (kap + 511 >= t);
                        const float v = ok ? s[qt][kt][r] : -1e30f;
                        s[qt][kt][r] = v; tmax = fmaxf(tmax, v);
                    }
                tmax = xmax16_32(tmax);
                const float mn = fmaxf(m[qt], tmax);
                const float alpha = fast_exp2(m[qt] - mn);
                m[qt] = mn;
                float rs = 0.f;
#pragma unroll
                for (int kt = 0; kt < 4; ++kt)
#pragma unroll
                    for (int r = 0; r < 4; ++r) { const float v = s[qt][kt][r]; const float pv = (v > -1e29f) ? fast_exp2(v - mn) : 0.f; s[qt][kt][r] = pv; rs += pv; }
                l[qt] = l[qt] * alpha + rs;
#pragma unroll
                for (int dt = 0; dt < 4; ++dt) O[qt][dt] *= alpha;
            }
            nsa_pv(c, cur, s, O);
        }
        if (tile < tile_hi) nsa_lstore(c, KVARGS, c.lds + ((tile - tile_lo + 1) & 1) * 16384);
        __syncthreads();
    }
}
template <bool NORM, int MODE>
__device__ __forceinline__ void nsa_accum(const NsaCtx& c, const float (&gate)[2], const float (&l)[2], const f32x4 (&O)[2][4], bf16_t* const (&yrow)[2]) {
#pragma unroll
    for (int qt = 0; qt < 2; ++qt) {
        float inv = 1.0f;
        if (NORM) { const float lt = xsum16_32(l[qt]); inv = (lt > 0.f) ? 1.0f / lt : 0.f; }
        inv *= gate[qt];
        float* acc = (float*)(c.lds + 32768) + (c.wave * 32 + qt * 16 + c.li) * 64 + 4 * c.fq;
#pragma unroll
        for (int dt = 0; dt < 4; ++dt) {
            f32x4 v = O[qt][dt] * inv;
            if (MODE >= 1) v += *(const f32x4*)(acc + dt * 16);
            if (MODE <= 1) *(f32x4*)(acc + dt * 16) = v;
            else { uint2 w; w.x = cvtpk(v[0], v[1]); w.y = cvtpk(v[2], v[3]); *(uint2*)(yrow[qt] + dt * 16) = w; }
        }
    }
}

__device__ __forceinline__ void ph_nsa_fast(const Params& p, float* sm, int bid, int nb) {
    NsaCtx c;
    c.lds = (char*)sm; c.tid = threadIdx.x; c.lane = c.tid & 63; c.wave = c.tid >> 6; c.fr = c.lane & 15; c.fq = c.lane >> 4; c.li = c.lane & 15;
    float* impA = (float*)(c.lds + 32768); float* impE = (float*)(c.lds + 49152); unsigned* selm = (unsigned*)(c.lds + 49152);
    for (int u = bid; u < 1024; u += nb) {
        const int tt = 255 - (u >> 2), b = (u >> 1) & 1, g = u & 1, t0 = tt * 32;
        const int head = c.li & 3;
#pragma unroll
        for (int qt = 0; qt < 2; ++qt) {
            c.tq[qt] = t0 + c.wave * 8 + qt * 4 + (c.li >> 2);
            const bf16_t* qrow = p.Qb + (size_t)(b * S + c.tq[qt]) * 512 + (g * 4 + head) * 64 + 8 * c.fq;
            c.qf[qt][0] = *(const s16x8*)qrow; c.qf[qt][1] = *(const s16x8*)(qrow + 32);
        }
        unsigned selw[2][4];
        float gt0[2], gt1[2], gt2[2];
        bf16_t* yrow[2];
#pragma unroll
        for (int qt = 0; qt < 2; ++qt) {
#pragma unroll
            for (int w = 0; w < 4; ++w) selw[qt][w] = 0u;
            const float* gp = p.GT + (size_t)(b * S + c.tq[qt]) * 24 + (g * 4 + head) * 3;
            gt0[qt] = gp[0]; gt1[qt] = gp[1]; gt2[qt] = gp[2];
            yrow[qt] = p.YBb + (size_t)(b * S + c.tq[qt]) * 512 + (g * 4 + head) * 64 + 4 * c.fq;
        }
        f32x4 Oc[2][4];
#if 1
        {
            const bf16_t* Kg = p.KCb + (size_t)((b * 2 + g) * 512) * 64; const bf16_t* Vg = p.VCb + (size_t)((b * 2 + g) * 512) * 64;
            const int tl = t0 + 31; const int nvmax = (tl >= 31) ? ((tl - 31) >> 4) + 1 : 0; const int ntile = (nvmax + 63) >> 6;
            float m[2] = {-1e30f, -1e30f}, l[2] = {0.f, 0.f};
#pragma unroll
            for (int qt = 0; qt < 2; ++qt)
#pragma unroll
                for (int dt = 0; dt < 4; ++dt) Oc[qt][dt] = (f32x4){0.f, 0.f, 0.f, 0.f};
            __syncthreads();
            for (int i = c.tid; i < 32 * 128; i += NT) { impA[i] = 0.f; impE[i] = 0.f; }
            KVREGS;
            for (int pass = 0; pass < 2; ++pass) {
                float linv[2] = {0.f, 0.f};
                if (pass == 1) {
#pragma unroll
                    for (int qt = 0; qt < 2; ++qt) { const float lt = xsum16_32(l[qt]); linv[qt] = (lt > 0.f) ? 1.0f / lt : 0.f; }
                }
                if (ntile > 0) {
                    __syncthreads();
                    nsa_gload(c, KVARGS, Kg, Vg, 64, 0); nsa_lstore(c, KVARGS, c.lds); __syncthreads();
                    for (int tile = 0; tile < ntile; ++tile) {
                        char* cur = c.lds + (tile & 1) * 16384;
                        if (tile + 1 < ntile) nsa_gload(c, KVARGS, Kg, Vg, 64, tile + 1);
                        __builtin_amdgcn_sched_barrier(0);
                        f32x4 s[2][4];
                        nsa_qk(c, cur, s);
#pragma unroll
                        for (int qt = 0; qt < 2; ++qt) {
                            const int t = c.tq[qt];
                            if (pass == 0) {
                                float tmax = -1e30f;
#pragma unroll
                                for (int kt = 0; kt < 4; ++kt)
#pragma unroll
                                    for (int r = 0; r < 4; ++r) { const int cc = tile * 64 + kt * 16 + 4 * c.fq + r; const float v = (16 * cc + 31 <= t) ? s[qt][kt][r] : -1e30f; s[qt][kt][r] = v; tmax = fmaxf(tmax, v); }
                                tmax = xmax16_32(tmax);
                                const float mn = fmaxf(m[qt], tmax); const float alpha = fast_exp2(m[qt] - mn); m[qt] = mn;
                                float rs = 0.f;
#pragma unroll
                                for (int kt = 0; kt < 4; ++kt)
#pragma unroll
                                    for (int r = 0; r < 4; ++r) { const float v = s[qt][kt][r]; rs += (v > -1e29f) ? fast_exp2(v - mn) : 0.f; }
                                l[qt] = l[qt] * alpha + rs;
                            } else {
#pragma unroll
                                for (int kt = 0; kt < 4; ++kt) {
#pragma unroll
                                    for (int r = 0; r < 4; ++r) { const int cc = tile * 64 + kt * 16 + 4 * c.fq + r; s[qt][kt][r] = (16 * cc + 31 <= t) ? fast_exp2(s[qt][kt][r] - m[qt]) * linv[qt] : 0.f; }
                                    float e = s[qt][kt][3];
                                    float a = 2.0f * ((s[qt][kt][0] + s[qt][kt][1]) + (s[qt][kt][2] + e)) - e;
                                    a += __shfl_xor(a, 1); a += __shfl_xor(a, 2); e += __shfl_xor(e, 1); e += __shfl_xor(e, 2);
                                    if (head == 0) { const int j = tile * 16 + kt * 4 + c.fq; const int tokl = c.wave * 8 + qt * 4 + (c.li >> 2); impA[tokl * 128 + j] = a; impE[tokl * 128 + j] = e; }
                                }
                            }
                        }
                        if (pass == 1) nsa_pv(c, cur, s, Oc);
                        if (tile + 1 < ntile) nsa_lstore(c, KVARGS, c.lds + ((tile + 1) & 1) * 16384);
                        __syncthreads();
                    }
                }
            }
        }
#endif
#if 1
        {
            __syncthreads();
            float scv[16];
#pragma unroll
            for (int i = 0; i < 16; ++i) {
                const int e = c.tid + 256 * i, tok = e >> 7, j = e & 127; const int t = t0 + tok, cur = t >> 6;
                const bool valid = (j <= cur), forced = (j == 0) || (j == cur) || (j == cur - 1);
                scv[i] = valid ? (impA[e] + ((j > 0) ? impE[e - 1] : 0.f) + (forced ? 1e4f : 0.f)) : -1.0f;
            }
            __syncthreads();
#pragma unroll
            for (int i = 0; i < 16; ++i) impA[c.tid + 256 * i] = scv[i];
            __syncthreads();
#pragma unroll 1
            for (int i = 0; i < 16; ++i) {
                const int e = c.tid + 256 * i, tok = e >> 7, j = e & 127;
                const float my = impA[e];
                int rank = 0;
                const float* row = impA + tok * 128;
                for (int jj = 0; jj < 128; jj += 4) {
                    const float4 o = *(const float4*)(row + jj);
                    rank += (o.x > my || (o.x == my && jj < j)) ? 1 : 0;
                    rank += (o.y > my || (o.y == my && jj + 1 < j)) ? 1 : 0;
                    rank += (o.z > my || (o.z == my && jj + 2 < j)) ? 1 : 0;
                    rank += (o.w > my || (o.w == my && jj + 3 < j)) ? 1 : 0;
                }
                const unsigned long long mk = __ballot(rank < 16 && my >= 0.f);
                if (c.lane == 0) { selm[tok * 4 + (c.wave & 1) * 2] = (unsigned)mk; selm[tok * 4 + (c.wave & 1) * 2 + 1] = (unsigned)(mk >> 32); }
            }
            __syncthreads();
#pragma unroll
            for (int qt = 0; qt < 2; ++qt) {
                const int tokl = c.wave * 8 + qt * 4 + (c.li >> 2);
#pragma unroll
                for (int w = 0; w < 4; ++w) selw[qt][w] = selm[tokl * 4 + w];
            }
            __syncthreads();
            { const float dummy[2] = {0.f, 0.f}; nsa_accum<false, 0>(c, gt0, dummy, Oc, yrow); }
        }
#endif
#if 1
        {
            float m[2] = {-1e30f, -1e30f}, l[2] = {0.f, 0.f};
            f32x4 O[2][4];
#pragma unroll
            for (int qt = 0; qt < 2; ++qt)
#pragma unroll
                for (int dt = 0; dt < 4; ++dt) O[qt][dt] = (f32x4){0.f, 0.f, 0.f, 0.f};
            nsa_flash<1>(c, p.KSb + (size_t)(b * S) * 128 + g * 64, p.VSb + (size_t)(b * S) * 128 + g * 64, 128, 0, (t0 + 31) >> 6, selw, m, l, O);
            nsa_accum<true, 1>(c, gt1, l, O, yrow);
        }
#endif
#if 1
        {
            float m[2] = {-1e30f, -1e30f}, l[2] = {0.f, 0.f};
            f32x4 O[2][4];
#pragma unroll
            for (int qt = 0; qt < 2; ++qt)
#pragma unroll
                for (int dt = 0; dt < 4; ++dt) O[qt][dt] = (f32x4){0.f, 0.f, 0.f, 0.f};
            const int lo = (t0 >= 511) ? ((t0 - 511) >> 6) : 0;
            nsa_flash<2>(c, p.KWb + (size_t)(b * S) * 128 + g * 64, p.VWb + (size_t)(b * S) * 128 + g * 64, 128, lo, (t0 + 31) >> 6, selw, m, l, O);
            nsa_accum<true, 2>(c, gt2, l, O, yrow);
        }
#endif
    }
}
__device__ __forceinline__ void ph_branch_a(const Params& p, float* sm, int bid, int nb) {
    const bf16_t* P = p.P; float* Z = p.Z; const bf16_t* YA = p.YAb;
    XCD_TILE_LOOP(T / 128, D / 128) {
        const int m0 = tm_ * 128, n0 = tn_ * 128;
        auto ar = [&](int r) { return (const void*)(YA + (size_t)(m0 + r) * 512); };
        auto bc = [&](int c) { return n0 + c; };
        auto ep = [&](int m, int n, f32x4 v) {
            const size_t r = m0 + m; const int c = n0 + n;
            const uint2 gw = *(const uint2*)(P + r * INW + C_GA + c); const f32x4 gq = {bf2f(gw.x & 0xffff), bf2f(gw.x >> 16), bf2f(gw.y & 0xffff), bf2f(gw.y >> 16)};
            f32x4 o;
#pragma unroll
            for (int j = 0; j < 4; ++j) o[j] = sigmoidf_(gq[j]) * v[j];
            *(f32x4*)(Z + r * D + c) = o;
        };
        mgemm_unit<false, false>((char*)sm, 512, ar, p.WBAb, D, bc, ep);
    }
}
__device__ __forceinline__ void ph_branch_b(const Params& p, float* sm, int bid, int nb) {
    const bf16_t* P = p.P; float* Z = p.Z; const bf16_t* YB = p.YBb; bf16_t* Zb = p.Zb;
    XCD_TILE_LOOP(T / 128, D / 128) {
        const int m0 = tm_ * 128, n0 = tn_ * 128;
        auto ar = [&](int r) { return (const void*)(YB + (size_t)(m0 + r) * 512); };
        auto bc = [&](int c) { return n0 + c; };
        auto ep = [&](int m, int n, f32x4 v) {
            const size_t r = m0 + m; const int c = n0 + n;
            const uint2 gw = *(const uint2*)(P + r * INW + C_GB + c); const f32x4 gq = {bf2f(gw.x & 0xffff), bf2f(gw.x >> 16), bf2f(gw.y & 0xffff), bf2f(gw.y >> 16)};
            f32x4 o = *(const f32x4*)(Z + r * D + c);
#pragma unroll
            for (int j = 0; j < 4; ++j) o[j] += sigmoidf_(gq[j]) * v[j];
            uint2 w; w.x = cvtpk(o[0], o[1]); w.y = cvtpk(o[2], o[3]);
            *(uint2*)(Zb + r * D + c) = w;
        };
        mgemm_unit<false, false>((char*)sm, 512, ar, p.WBBb, D, bc, ep);
    }
}
__device__ __forceinline__ void ph_outproj(const Params& p, float* sm, int bid, int nb) {
    const float* x = p.x; float* PRE1 = p.PRE1; const bf16_t* Z = p.Zb;
    XCD_TILE_LOOP(T / 128, D / 128) {
        const int m0 = tm_ * 128, n0 = tn_ * 128;
        auto ar = [&](int r) { return (const void*)(Z + (size_t)(m0 + r) * D); };
        auto bc = [&](int c) { return n0 + c; };
        auto ep = [&](int m, int n, f32x4 v) {
            const size_t r = m0 + m; const int c = n0 + n;
            const f32x4 xv = *(const f32x4*)(x + r * D + c);
            *(f32x4*)(PRE1 + r * D + c) = xv * ALPHA + v;
        };
        mgemm_unit<false, false>((char*)sm, D, ar, p.WOUTb, D, bc, ep);
    }
}
__device__ __forceinline__ void ln_rows(float* sm, int bid, int nb, const float* src, float* dst, unsigned short* dstb, const float* gam, const float* bet) {
    const int tid = threadIdx.x, wave = tid >> 6, lane = tid & 63;
    for (int t = bid; t < T; t += nb) {
        const float4 v = *(const float4*)(src + (size_t)t * D + tid * 4);
        float s = (v.x + v.y) + (v.z + v.w);
        s = wave_sum(s);
        __syncthreads();
        if (lane == 0) sm[wave] = s;
        __syncthreads();
        const float mean = (sm[0] + sm[1] + sm[2] + sm[3]) * (1.0f / D);
        const float dx = v.x - mean, dy = v.y - mean, dz = v.z - mean, dw = v.w - mean;
        float q = (dx * dx + dy * dy) + (dz * dz + dw * dw);
        q = wave_sum(q);
        __syncthreads();
        if (lane == 0) sm[wave] = q;
        __syncthreads();
        const float rstd = rsqrtf((sm[0] + sm[1] + sm[2] + sm[3]) * (1.0f / D) + 1e-5f);
        const float4 gq = *(const float4*)(gam + tid * 4), bq = *(const float4*)(bet + tid * 4);
        const float4 o = make_float4(dx * rstd * gq.x + bq.x, dy * rstd * gq.y + bq.y, dz * rstd * gq.z + bq.z, dw * rstd * gq.w + bq.w);
        *(float4*)(dst + (size_t)t * D + tid * 4) = o;
        uint2 w; w.x = cvtpk(o.x, o.y); w.y = cvtpk(o.z, o.w);
        *(uint2*)(dstb + (size_t)t * D + tid * 4) = w;
    }
}
__device__ __forceinline__ void ph_ln1(const Params& p, float* sm, int bid, int nb) { ln_rows(sm, bid, nb, p.PRE1, p.X1, p.X1b, p.ln1g, p.ln1b); }

__device__ __forceinline__ void ph_router_gemm(const Params& p, float* sm, int bid, int nb) {
    float* L = p.LOGITS; const bf16_t* X1 = p.X1b;
    XCD_TILE_LOOP(T / 128, 2) {
        const int m0 = tm_ * 128, n0 = tn_ * 128;
        auto ar = [&](int r) { return (const void*)(X1 + (size_t)(m0 + r) * D); };
        auto bc = [&](int c) { return n0 + c; };
        auto ep = [&](int m, int n, f32x4 v) { *(f32x4*)(L + (size_t)(m0 + m) * NE + n0 + n) = v; };
        mgemm_unit<false, false>((char*)sm, D, ar, p.RWb, NE, bc, ep);
    }
}
__device__ __forceinline__ void ph_router_sel(const Params& p, float* sm, int bid, int nb) {
    float* chs = sm;
    float* scs = sm + 256;
    float* gs = sm + 512;
    int* gsel = (int*)(sm + 520);
    float* ew = sm + 528;
    int* ei = (int*)(sm + 536);
    const int e = threadIdx.x;
    for (int t = bid; t < T; t += nb) {
        __syncthreads();
        const float sc = sigmoidf_(p.LOGITS[(size_t)t * NE + e]);
        const float ch = sc + p.rbias[e];
        chs[e] = ch; scs[e] = sc;
        __syncthreads();
        if (e < 8) {
            float m1 = -3e38f; int i1 = -1;
            for (int i = 0; i < 32; ++i) { const float v = chs[e * 32 + i]; if (v > m1) { m1 = v; i1 = i; } }
            float m2 = -3e38f;
            for (int i = 0; i < 32; ++i) { const float v = chs[e * 32 + i]; if (i != i1 && v > m2) m2 = v; }
            gs[e] = m1 + m2;
        }
        __syncthreads();
        if (e < 8) {
            const float my = gs[e]; int rank = 0;
            for (int i = 0; i < 8; ++i) { const float o = gs[i]; rank += (o > my || (o == my && i < e)) ? 1 : 0; }
            gsel[e] = (rank < 4) ? 1 : 0;
        }
        __syncthreads();
        const float mch = gsel[e >> 5] ? ch : -1e30f;
        __syncthreads();
        chs[e] = mch;
        __syncthreads();
        {
            int rank = 0;
            for (int i = 0; i < 256; ++i) { const float o = chs[i]; rank += (o > mch || (o == mch && i < e)) ? 1 : 0; }
            if (rank < 8) { ei[rank] = e; ew[rank] = sc; }
        }
        __syncthreads();
        if (e < 8) {
            const float sum = ((ew[0] + ew[1]) + (ew[2] + ew[3])) + ((ew[4] + ew[5]) + (ew[6] + ew[7]));
            p.EIDX[(size_t)t * 8 + e] = ei[e];
            p.EW[(size_t)t * 8 + e] = ew[e] / sum * 2.5f;
        }
    }
}
__device__ __forceinline__ void ph_lists(const Params& p, float* sm, int bid, int nb) {
    int* wcnt = (int*)sm;
    const int tid = threadIdx.x, wave = tid >> 6, lane = tid & 63;
    for (int e = bid; e < NE; e += nb) {
        int base = 0;
        for (int a0 = 0; a0 < T * 8; a0 += NT) {
            const bool f = (p.EIDX[a0 + tid] == e);
            const unsigned long long m = __ballot(f);
            const int before = __popcll(m & ((1ull << lane) - 1ull));
            __syncthreads();
            if (lane == 0) wcnt[wave] = __popcll(m);
            __syncthreads();
            int off = base;
            for (int w = 0; w < wave; ++w) off += wcnt[w];
            if (f && off + before < LISTCAP) p.LIST[(size_t)e * LISTCAP + off + before] = a0 + tid;
            base += wcnt[0] + wcnt[1] + wcnt[2] + wcnt[3];
        }
        if (tid == 0) p.CNT[e] = base < LISTCAP ? base : LISTCAP;
    }
}
__device__ __forceinline__ int glu_col(int j0, int c) { const int wn = c >> 6, ni = (c >> 4) & 3, x = c & 15; return ((ni >> 1) ? 256 : 0) + j0 + wn * 32 + (ni & 1) * 16 + x; }
__device__ __forceinline__ void ph_moe_gu(const Params& p, float* sm, int bid, int nb) {
    const int nu = 128 * NE * 4;
    for (int u = bid; u < nu; u += nb) {
        const int mt = u / (NE * 4), e = (u / 4) % NE, j0 = (u % 4) * 64;
        const int cnt = p.CNT[e];
        if (mt * 128 >= cnt) continue;
        const int* lst = p.LIST + (size_t)e * LISTCAP + mt * 128;
        const int nrow = cnt - mt * 128;
        const bf16_t* X1 = p.X1b; bf16_t* ACT = p.ACT;
        auto ar = [&](int r) { return (const void*)(X1 + (size_t)(lst[r < nrow ? r : 0] >> 3) * D); };
        auto bc = [&](int c) { return glu_col(j0, c); };
        auto ep = [&](int m, int n, f32x4 v) { if (m < nrow) { const int a = lst[m]; uint2 w; w.x = cvtpk(v[0], v[1]); w.y = cvtpk(v[2], v[3]); *(uint2*)(ACT + (size_t)a * 256 + j0 + n) = w; } };
        mgemm_unit<true, true>((char*)sm, D, ar, p.egu + (size_t)e * D * 512, 512, bc, ep);
    }
}
__device__ __forceinline__ void ph_moe_down(const Params& p, float* sm, int bid, int nb) {
    const int nu = 128 * NE * 8;
    for (int u = bid; u < nu; u += nb) {
        const int mt = u / (NE * 8), e = (u / 8) % NE, n0 = (u % 8) * 128;
        const int cnt = p.CNT[e];
        if (mt * 128 >= cnt) continue;
        const int* lst = p.LIST + (size_t)e * LISTCAP + mt * 128;
        const int nrow = cnt - mt * 128;
        const bf16_t* ACT = p.ACT; bf16_t* Y = p.Y; const float* EW = p.EW;
        auto ar = [&](int r) { return (const void*)(ACT + (size_t)lst[r < nrow ? r : 0] * 256); };
        auto bc = [&](int c) { return n0 + c; };
        auto ep = [&](int m, int n, f32x4 v) { if (m < nrow) { const int a = lst[m]; const float w = EW[a]; uint2 o; o.x = cvtpk(v[0] * w, v[1] * w); o.y = cvtpk(v[2] * w, v[3] * w); *(uint2*)(Y + (size_t)a * D + n0 + n) = o; } };
        mgemm_unit<true, false>((char*)sm, 256, ar, p.edown + (size_t)e * 256 * D, D, bc, ep);
    }
}
__device__ __forceinline__ void ph_shared_gu(const Params& p, float* sm, int bid, int nb) {
    const bf16_t* X1 = p.X1b; bf16_t* ACTS = p.ACTS;
    XCD_TILE_LOOP(T / 128, 4) {
        const int m0 = tm_ * 128, j0 = tn_ * 64;
        auto ar = [&](int r) { return (const void*)(X1 + (size_t)(m0 + r) * D); };
        auto bc = [&](int c) { return glu_col(j0, c); };
        auto ep = [&](int m, int n, f32x4 v) { uint2 w; w.x = cvtpk(v[0], v[1]); w.y = cvtpk(v[2], v[3]); *(uint2*)(ACTS + (size_t)(m0 + m) * 256 + j0 + n) = w; };
        mgemm_unit<false, true>((char*)sm, D, ar, p.SGUb, 512, bc, ep);
    }
}
__device__ __forceinline__ void ph_shared_down(const Params& p, float* sm, int bid, int nb) {
    const bf16_t* ACTS = p.ACTS; float* SH = p.SH;
    XCD_TILE_LOOP(T / 128, 8) {
        const int m0 = tm_ * 128, n0 = tn_ * 128;
        auto ar = [&](int r) { return (const void*)(ACTS + (size_t)(m0 + r) * 256); };
        auto bc = [&](int c) { return n0 + c; };
        auto ep = [&](int m, int n, f32x4 v) { *(f32x4*)(SH + (size_t)(m0 + m) * D + n0 + n) = v; };
        mgemm_unit<false, false>((char*)sm, 256, ar, p.SDOWNb, D, bc, ep);
    }
}
__device__ __forceinline__ void ph_final(const Params& p, float* sm, int bid, int nb) {
    const int tid = threadIdx.x, wave = tid >> 6, lane = tid & 63;
    for (int t = bid; t < T; t += nb) {
        const float4 xv = *(const float4*)(p.X1 + (size_t)t * D + tid * 4);
        float4 v = *(const float4*)(p.SH + (size_t)t * D + tid * 4);
        float4 r = make_float4(0.f, 0.f, 0.f, 0.f);
#pragma unroll
        for (int k = 0; k < 8; ++k) { const uint2 y = *(const uint2*)(p.Y + ((size_t)t * 8 + k) * D + tid * 4); r.x += bf2f(y.x & 0xffff); r.y += bf2f(y.x >> 16); r.z += bf2f(y.y & 0xffff); r.w += bf2f(y.y >> 16); }
        v.x = ALPHA * xv.x + (r.x + v.x); v.y = ALPHA * xv.y + (r.y + v.y); v.z = ALPHA * xv.z + (r.z + v.z); v.w = ALPHA * xv.w + (r.w + v.w);
        float s = (v.x + v.y) + (v.z + v.w);
        s = wave_sum(s);
        __syncthreads();
        if (lane == 0) sm[wave] = s;
        __syncthreads();
        const float mean = (sm[0] + sm[1] + sm[2] + sm[3]) * (1.0f / D);
        const float dx = v.x - mean, dy = v.y - mean, dz = v.z - mean, dw = v.w - mean;
        float q = (dx * dx + dy * dy) + (dz * dz + dw * dw);
        q = wave_sum(q);
        __syncthreads();
        if (lane == 0) sm[wave] = q;
        __syncthreads();
        const float rstd = rsqrtf((sm[0] + sm[1] + sm[2] + sm[3]) * (1.0f / D) + 1e-5f);
        const float4 gq = *(const float4*)(p.ln2g + tid * 4), bq = *(const float4*)(p.ln2b + tid * 4);
        *(float4*)(p.out + (size_t)t * D + tid * 4) = make_float4(dx * rstd * gq.x + bq.x, dy * rstd * gq.y + bq.y, dz * rstd * gq.z + bq.z, dw * rstd * gq.w + bq.w);
    }
}

constexpr int SM_FLOATS = 16384;

#define DEF_KERNEL(name) \
    __global__ void __launch_bounds__(NT) k_##name(Params p) { __shared__ __attribute__((aligned(16))) float sm[SM_FLOATS]; ph_##name(p, sm, (int)blockIdx.x, (int)gridDim.x); }


#define XB_TMO      128
#define XB_XCNT(j)  (256  + 64 * (j))
#define XB_XSUB(j)  (1280 + 64 * (j))
#define XB_XGEN(j)  (2304 + 64 * (j))
#define XB_TOP      3328
#define XB_TOPGEN   3392
#define XCD_BAR_WORDS 3456
#define XB_SPIN_CAP (1u << 18)
__device__ __forceinline__ unsigned xb_ld(unsigned* p)              { return __hip_atomic_load(p, __ATOMIC_RELAXED, __HIP_MEMORY_SCOPE_AGENT); }
__device__ __forceinline__ unsigned xb_add(unsigned* p, unsigned v) { return __hip_atomic_fetch_add(p, v, __ATOMIC_RELAXED, __HIP_MEMORY_SCOPE_AGENT); }
__device__ __forceinline__ unsigned xb_xcc_id() { return (unsigned)__builtin_amdgcn_s_getreg((3 << 11) | 20) & 0xFu; }
#define XB_SPIN(cond, bar) do { unsigned _sp = 0; while (cond) { __builtin_amdgcn_s_sleep(1); \
    if ((++_sp & 255u) == 0u) { if (xb_ld(&(bar)[XB_TMO])) break; if (_sp > XB_SPIN_CAP) { atomicAdd(&(bar)[XB_TMO], 1u); break; } } } } while (0)
struct XcdBarrier { unsigned* bar; unsigned x; volatile LAS unsigned* st; };
__device__ __forceinline__ XcdBarrier xcd_barrier_post(unsigned* bar, volatile LAS unsigned* st) {
    XcdBarrier b; b.bar = bar; b.x = xb_xcc_id(); b.st = st;
    if (threadIdx.x == 0) (void)xb_add(&bar[XB_XCNT(b.x)], 1u);
    return b;
}
__device__ __forceinline__ void xcd_barrier_complete(unsigned* bar, unsigned x, unsigned& nloc, unsigned& nx) {
    const unsigned G = gridDim.x * gridDim.y * gridDim.z;
    unsigned sum, cnt, mine, sp = 0u;
    for (;;) {
        sum = 0u; cnt = 0u; mine = 0u;
#pragma unroll
        for (unsigned j = 0; j < 16; ++j) { const unsigned c = xb_ld(&bar[XB_XCNT(j)]); sum += c; cnt += (c > 0u) ? 1u : 0u; mine = (j == x) ? c : mine; }
        if (sum == G) break;
        __builtin_amdgcn_s_sleep(1);
        if ((++sp & 255u) == 0u) { if (xb_ld(&bar[XB_TMO])) break; if (sp > XB_SPIN_CAP) { atomicAdd(&bar[XB_TMO], 1u); break; } }
    }
    nloc = mine > 0u ? mine : 1u; nx = cnt > 0u ? cnt : 1u;
}
__device__ __forceinline__ void xcd_barrier(const XcdBarrier& b) {
    asm volatile("s_waitcnt vmcnt(0)" ::: "memory");
    __syncthreads();
    if (threadIdx.x == 0) {
        unsigned* bar = b.bar;
        __builtin_amdgcn_s_waitcnt(0);
        unsigned nloc = b.st[0], nx = b.st[1];
        if (nloc == 0u) { xcd_barrier_complete(bar, b.x, nloc, nx); b.st[0] = nloc; b.st[1] = nx; }
        const unsigned old = xb_add(&bar[XB_XSUB(b.x)], 1u);
        const unsigned gen = old / nloc;
        if (old + 1u == (gen + 1u) * nloc) {
            __builtin_amdgcn_fence(__ATOMIC_RELEASE, "agent");
            asm volatile("s_waitcnt vmcnt(0)" ::: "memory");
            const unsigned og = xb_add(&bar[XB_TOP], 1u);
            const unsigned tg = og / nx;
            if (og + 1u == (tg + 1u) * nx) xb_add(&bar[XB_TOPGEN], 1u);
            else XB_SPIN(xb_ld(&bar[XB_TOPGEN]) == tg, bar);
            __builtin_amdgcn_fence(__ATOMIC_ACQUIRE, "agent");
            xb_add(&bar[XB_XGEN(b.x)], 1u);
            asm volatile("s_waitcnt vmcnt(0)" ::: "memory");
        } else {
            XB_SPIN(xb_ld(&bar[XB_XGEN(b.x)]) == gen, bar);
            __builtin_amdgcn_fence(__ATOMIC_ACQUIRE, "agent");
            asm volatile("s_waitcnt vmcnt(0)" ::: "memory");
        }
    }
    __syncthreads();
}

namespace cg = cooperative_groups;
__global__ void __launch_bounds__(NT, 2) mega(Params p) {
    __shared__ __attribute__((aligned(16))) float sm[SM_FLOATS];
    __shared__ __attribute__((aligned(16))) unsigned bar_st[4];
    cg::grid_group grid = cg::this_grid();
    if (threadIdx.x < 4) bar_st[threadIdx.x] = 0u;
    __syncthreads();
    const XcdBarrier xbar = xcd_barrier_post(p.BAR, (volatile LAS unsigned*)bar_st);
#define GSYNC() xcd_barrier(xbar)
    const int bid = (int)blockIdx.x, nb = (int)gridDim.x;
#ifndef PROBE_REP
#define PROBE_REP 0
#endif
#define GROUP(k, ...) { __VA_ARGS__ } if (PROBE_REP == (k)) { __VA_ARGS__ }
    GROUP(1, ph_cvt_x(p, sm, bid, nb); grid.sync(); ph_inproj(p, sm, bid, nb); GSYNC();)
    GROUP(2, ph_prep(p, sm, bid, nb); GSYNC();
             ph_prep_gemm(p, sm, bid, nb); GSYNC();
             ph_cmp2(p, sm, bid, nb); GSYNC();
             ph_cmp_rope(p, sm, bid, nb); GSYNC();)
    GROUP(3, if (bid < 64) ph_scan(p, sm, bid, 64); else ph_nsa_fast(p, sm, bid - 64, nb - 64);
             GSYNC();)
    GROUP(4, ph_rwkv_post(p, sm, bid, nb); GSYNC();
             ph_branch_a(p, sm, bid, nb); ph_branch_b(p, sm, bid, nb); GSYNC();
             ph_outproj(p, sm, bid, nb); GSYNC();
             ph_ln1(p, sm, bid, nb); GSYNC();)
    GROUP(5, ph_router_gemm(p, sm, bid, nb); ph_shared_gu(p, sm, bid, nb); GSYNC();
             ph_router_sel(p, sm, bid, nb); ph_shared_down(p, sm, bid, nb); GSYNC();
             ph_lists(p, sm, bid, nb); GSYNC();)
    GROUP(6, ph_moe_gu(p, sm, bid, nb); GSYNC();
             ph_moe_down(p, sm, bid, nb); GSYNC();)
    ph_final(p, sm, bid, nb);
}
}

extern "C" void kernel_launch(void* const* d_in, const int* in_sizes, int n_in, void* d_out, int out_size, void* d_ws, size_t ws_size, hipStream_t stream) {
    Params p{};
    const float* const* in = (const float* const*)d_in;
    p.x = in[0]; p.w_in = in[1]; p.mu = in[2]; p.w0 = in[3]; p.w2 = in[4]; p.a0 = in[5]; p.a2 = in[6]; p.g2 = in[7]; p.k_k = in[8]; p.k_a = in[9];
    p.r_k = in[10]; p.lnx_w = in[11]; p.lnx_b = in[12]; p.pe_k = in[13]; p.w1_k = in[14]; p.w2_k = in[15]; p.pe_v = in[16]; p.w1_v = in[17]; p.w2_v = in[18];
    p.wba = in[19]; p.wbb = in[20]; p.wout = in[21]; p.ln1g = in[22]; p.ln1b = in[23]; p.rw = in[24]; p.rbias = in[25]; p.egu = in[26]; p.edown = in[27];
    p.sgu = in[28]; p.sdown = in[29]; p.ln2g = in[30]; p.ln2b = in[31];
    p.out = (float*)d_out;
    char* w = (char*)d_ws; size_t off = 0;
    auto carve = [&](size_t bytes) { char* r = w + off; off += (bytes + 255) & ~(size_t)255; return r; };
    p.BAR = (unsigned*)carve(16384);
    p.P = (unsigned short*)carve((size_t)T * INW * 2);
    p.R = (float*)carve((size_t)T * 512 * 4); p.DC = (float*)carve((size_t)T * 512 * 4); p.K2 = (float*)carve((size_t)T * 512 * 4); p.V = (float*)carve((size_t)T * 512 * 4);
    p.KK = (float*)carve((size_t)T * 512 * 4); p.BB = (float*)carve((size_t)T * 512 * 4); p.G = (float*)carve((size_t)T * 512 * 4);
    p.O = (float*)carve((size_t)T * 512 * 4); p.YA = (float*)carve((size_t)T * 512 * 4);
    p.KCraw = (float*)carve((size_t)NCROWS * 64 * 4); p.KCR = (float*)carve((size_t)NCROWS * 64 * 4); p.VC = (float*)carve((size_t)NCROWS * 64 * 4);
    p.Z = (float*)carve((size_t)T * D * 4); p.PRE1 = (float*)carve((size_t)T * D * 4); p.X1 = (float*)carve((size_t)T * D * 4);
    p.LOGITS = (float*)carve((size_t)T * NE * 4); p.EW = (float*)carve((size_t)T * 8 * 4); p.EIDX = (int*)carve((size_t)T * 8 * 4);
    p.LIST = (int*)carve((size_t)NE * LISTCAP * 4); p.CNT = (int*)carve(1024);
    p.Xb = (unsigned short*)carve((size_t)T * D * 2); p.YAb = (unsigned short*)carve((size_t)T * 512 * 2); p.YBb = (unsigned short*)carve((size_t)T * 512 * 2);
    p.Zb = (unsigned short*)carve((size_t)T * D * 2); p.X1b = (unsigned short*)carve((size_t)T * D * 2);
    p.Qb = (unsigned short*)carve((size_t)T * 512 * 2); p.KSb = (unsigned short*)carve((size_t)T * 128 * 2); p.VSb = (unsigned short*)carve((size_t)T * 128 * 2);
    p.KWb = (unsigned short*)carve((size_t)T * 128 * 2); p.VWb = (unsigned short*)carve((size_t)T * 128 * 2);
    p.KCb = (unsigned short*)carve((size_t)4 * 512 * 64 * 2); p.VCb = (unsigned short*)carve((size_t)4 * 512 * 64 * 2);
    p.GT = (float*)carve((size_t)T * 24 * 4);
    p.WINb = (unsigned short*)carve((size_t)D * INW * 2); p.WBAb = (unsigned short*)carve((size_t)512 * D * 2); p.WBBb = (unsigned short*)carve((size_t)512 * D * 2);
    p.WOUTb = (unsigned short*)carve((size_t)D * D * 2); p.RWb = (unsigned short*)carve((size_t)D * NE * 2); p.SGUb = (unsigned short*)carve((size_t)D * 512 * 2); p.SDOWNb = (unsigned short*)carve((size_t)256 * D * 2);
    p.W1Kb = (unsigned short*)carve((size_t)2048 * 256 * 2); p.W1Vb = (unsigned short*)carve((size_t)2048 * 256 * 2); p.W2Kb = (unsigned short*)carve((size_t)256 * 64 * 2); p.W2Vb = (unsigned short*)carve((size_t)256 * 64 * 2);
    p.LW2b = (unsigned short*)carve((size_t)64 * 512 * 2); p.LA2b = (unsigned short*)carve((size_t)64 * 512 * 2); p.LG2b = (unsigned short*)carve((size_t)128 * 512 * 2);
    p.LORA = (unsigned short*)carve((size_t)T * 256 * 2); p.KCin = (unsigned short*)carve((size_t)4 * S * 64 * 2 + 4096); p.VCin = (unsigned short*)carve((size_t)4 * S * 64 * 2 + 4096);
    p.H1Kb = (unsigned short*)carve((size_t)NCROWS * 256 * 2); p.H1Vb = (unsigned short*)carve((size_t)NCROWS * 256 * 2);
    p.TABC = (float*)carve((size_t)S * 32 * 4); p.TABS = (float*)carve((size_t)S * 32 * 4); p.CB = (float*)carve(2 * 256 * 4); p.KSH = (float*)carve((size_t)T * 512 * 4);
    p.ACTS = (unsigned short*)carve((size_t)T * 256 * 2); p.SH = (float*)carve((size_t)T * D * 4);
    p.ACT = (unsigned short*)carve((size_t)T * 8 * 256 * 2);
    p.Y = (unsigned short*)carve((size_t)T * 8 * D * 2);
    if (off > ws_size) { fprintf(stderr, "kernel_launch: workspace too small: need %zu have %zu\n", off, ws_size); return; }
    static int grid_blocks = 0;
    if (!grid_blocks) {
        int dev = 0, cus = 0, per_cu = 0;
        hipGetDevice(&dev);
        hipDeviceGetAttribute(&cus, hipDeviceAttributeMultiprocessorCount, dev);
        hipOccupancyMaxActiveBlocksPerMultiprocessor(&per_cu, mega, NT, 0);
        if (per_cu > 2) per_cu = 2;
        if (per_cu < 1) per_cu = 1;
        grid_blocks = cus * per_cu;
    }
    hipMemsetAsync(d_ws, 0, 16384, stream);
    void* args[] = {&p};
    hipError_t e = hipLaunchCooperativeKernel((void*)mega, dim3(grid_blocks), dim3(NT), args, 0, stream);
    if (e != hipSuccess) fprintf(stderr, "cooperative launch failed: %s (grid %d)\n", hipGetErrorString(e), grid_blocks);
}
```

```cpp
#include <hip/hip_runtime.h>
#include <hip/hip_cooperative_groups.h>
#include <cstdio>
#include <cstdint>
#include <cmath>

namespace {

constexpr int NB = 2, S = 8192, T = NB * S, D = 1024, INW = 5144;
constexpr int C_R = 0, C_K = 512, C_V = 1024, C_WL = 1536, C_AL = 1600, C_GL = 1664, RW_IN = 1792;
constexpr int C_Q = 1792, C_KC = 2304, C_VC = 2432, C_KS = 2560, C_VS = 2688, C_KW = 2816, C_VW = 2944, C_GT = 3072;
constexpr int C_GA = 3096, C_GB = 4120;
constexpr int NCMP = 511, NCROWS = NB * NCMP * 2;
constexpr int NE = 256, TOPK = 8, LISTCAP = 16384;
constexpr float ALPHA = 1.189207115002721f;
constexpr float QSCALE = 0.125f * 1.4426950408889634f;
constexpr int NT = 256;

struct Params {
    const float *x, *w_in, *mu, *w0, *w2, *a0, *a2, *g2, *k_k, *k_a, *r_k, *lnx_w, *lnx_b;
    const float *pe_k, *w1_k, *w2_k, *pe_v, *w1_v, *w2_v, *wba, *wbb, *wout, *ln1g, *ln1b;
    const float *rw, *rbias, *egu, *edown, *sgu, *sdown, *ln2g, *ln2b;
    float* out;
    unsigned short* P;
    float *R, *DC, *K2, *V, *KK, *BB, *G, *O, *YA, *QR, *KSR, *KWR, *KCraw, *KCR, *VC, *H1K, *H1V, *YB, *Z, *PRE1, *X1;
    float *LOGITS, *EW, *SH;
    unsigned short* Y;
    unsigned short *ACT, *ACTS, *Xb, *YAb, *YBb, *Zb, *X1b;
    unsigned short *Qb, *KSb, *VSb, *KWb, *VWb, *KCb, *VCb;
    float *GT, *OC, *OS, *OW, *OCf, *OSf, *OWf;
    unsigned *SELM, *SELMf;
    unsigned short *WINb, *WBAb, *WBBb, *WOUTb, *RWb, *SGUb, *SDOWNb, *W1Kb, *W1Vb, *W2Kb, *W2Vb, *LW2b, *LA2b, *LG2b;
    unsigned short *LORA, *KCin, *VCin, *H1Kb, *H1Vb;
    float *TABC, *TABS, *CB, *KSH;
    char* SCANI;
    int *EIDX, *LIST, *CNT;
    unsigned* BAR;
    int pad_[2];
};

__device__ __forceinline__ float wave_sum(float v) {
#pragma unroll
    for (int o = 1; o < 64; o <<= 1) v += __shfl_xor(v, o);
    return v;
}
__device__ __forceinline__ float wave_max(float v) {
#pragma unroll
    for (int o = 1; o < 64; o <<= 1) v = fmaxf(v, __shfl_xor(v, o));
    return v;
}
__device__ __forceinline__ float sigmoidf_(float x) { return 1.0f / (1.0f + expf(-x)); }
__device__ __forceinline__ float gelu_tanh(float x) { return 0.5f * x * (1.0f + tanhf(0.7978845608028654f * (x + 0.044715f * x * x * x))); }

template <class AL, class BL, class EP>
__device__ __forceinline__ void sgemm_unit(float* sm, int K, const AL& aload, const BL& bload, const EP& epi) {
    float (*As)[68] = (float (*)[68])sm;
    float (*Bs)[68] = (float (*)[68])(sm + 16 * 68);
    const int tid = threadIdx.x, ty = tid >> 4, tx = tid & 15;
    const int arow = tid >> 2, ak = (tid & 3) * 4, bk = tid >> 4, bn = (tid & 15) * 4;
    float acc[4][4];
#pragma unroll
    for (int i = 0; i < 4; ++i)
#pragma unroll
        for (int j = 0; j < 4; ++j) acc[i][j] = 0.f;
    for (int k0 = 0; k0 < K; k0 += 16) {
        const float4 av = aload(arow, k0 + ak);
        const float4 bv = bload(k0 + bk, bn);
        __syncthreads();
        As[ak + 0][arow] = av.x; As[ak + 1][arow] = av.y; As[ak + 2][arow] = av.z; As[ak + 3][arow] = av.w;
        *(float4*)&Bs[bk][bn] = bv;
        __syncthreads();
#pragma unroll
        for (int k = 0; k < 16; ++k) {
            const float4 a = *(const float4*)&As[k][ty * 4];
            const float4 b = *(const float4*)&Bs[k][tx * 4];
            acc[0][0] += a.x * b.x; acc[0][1] += a.x * b.y; acc[0][2] += a.x * b.z; acc[0][3] += a.x * b.w;
            acc[1][0] += a.y * b.x; acc[1][1] += a.y * b.y; acc[1][2] += a.y * b.z; acc[1][3] += a.y * b.w;
            acc[2][0] += a.z * b.x; acc[2][1] += a.z * b.y; acc[2][2] += a.z * b.z; acc[2][3] += a.z * b.w;
            acc[3][0] += a.w * b.x; acc[3][1] += a.w * b.y; acc[3][2] += a.w * b.z; acc[3][3] += a.w * b.w;
        }
    }
#pragma unroll
    for (int i = 0; i < 4; ++i) epi(ty * 4 + i, tx * 4, make_float4(acc[i][0], acc[i][1], acc[i][2], acc[i][3]));
}

template <class EP>
__device__ __forceinline__ void dense_gemm_phase(float* sm, int bid, int nb, const float* A, int lda, const float* B, int ldb, int M, int N, int K, const EP& epi) {
    const int ntn = (N + 63) / 64, nu = (M / 64) * ntn;
    for (int u = bid; u < nu; u += nb) {
        const int m0 = (u / ntn) * 64, n0 = (u % ntn) * 64;
        auto al = [&](int m, int k) { return *(const float4*)(A + (size_t)(m0 + m) * lda + k); };
        auto bl = [&](int k, int n) { return (n0 + n < N) ? *(const float4*)(B + (size_t)k * ldb + n0 + n) : make_float4(0.f, 0.f, 0.f, 0.f); };
        auto ep = [&](int m, int n, float4 v) { if (n0 + n < N) epi(m0 + m, n0 + n, v); };
        sgemm_unit(sm, K, al, bl, ep);
    }
}

typedef short s16x8 __attribute__((ext_vector_type(8)));
typedef short s16x4 __attribute__((ext_vector_type(4)));
typedef float f32x4 __attribute__((ext_vector_type(4)));
typedef float f32x2 __attribute__((ext_vector_type(2)));
typedef __bf16 bf16x2_t __attribute__((ext_vector_type(2)));
typedef unsigned short bf16_t;
#define LAS __attribute__((address_space(3)))
__device__ __forceinline__ unsigned cvtpk(float lo, float hi) { f32x2 v = {lo, hi}; bf16x2_t b = __builtin_convertvector(v, bf16x2_t); return __builtin_bit_cast(unsigned, b); }
__device__ __forceinline__ float bf2f(unsigned short h) { return __uint_as_float(((unsigned)h) << 16); }
__device__ __forceinline__ int bimg_off(int k, int ch) { return 256 * k + 16 * (ch ^ (((k & 3) << 2) | ((k >> 2) & 3))); }

template <bool B_F32, bool GLU, class AR, class BC, class EP>
__device__ __forceinline__ void mgemm_unit(char* lds, int K, const AR& arow, const void* Bp, int ldb, const BC& bcol, const EP& epi) {
    const int tid = threadIdx.x, lane = tid & 63, wid = tid >> 6, wm = wid >> 1, wn = wid & 1, fr = lane & 15, fq = lane >> 4;
    const int ac = tid & 7;
    const char* ap[4];
#pragma unroll
    for (int i = 0; i < 4; ++i) ap[i] = (const char*)arow((tid >> 3) + 32 * i);
    const int ao0 = (tid >> 3) * 128 + ((ac ^ ((tid >> 4) & 7)) << 4);
    const char* bp; int bo_e, bo_o;
    if constexpr (B_F32) {
        const int n4 = tid & 31, kb = tid >> 5; const int col = bcol(n4 * 4);
        bp = (const char*)((const float*)Bp + col) + (size_t)kb * ldb * 4;
        bo_e = 16384 + bimg_off(kb, n4 >> 1) + 8 * (n4 & 1); bo_o = 16384 + bimg_off(kb + 8, n4 >> 1) + 8 * (n4 & 1);
    } else {
        const int ch = tid & 15, kb = tid >> 4; const int col = bcol(ch * 8);
        bp = (const char*)((const bf16_t*)Bp + col) + (size_t)kb * ldb * 2;
        bo_e = 16384 + bimg_off(kb, ch); bo_o = 0;
    }
    const int a_base = (wm * 64 + fr) * 128, a_sw = (fr >> 1) & 7;
    const int li = lane & 15, wq = li >> 2, wp = li & 3;
    uint4 ra0, ra1, ra2, ra3; float4 rf0, rf1, rf2, rf3, rf4, rf5, rf6, rf7; uint4 rb0, rb1, rb2, rb3;
#define MG_LOAD_TILES(kt_) do { \
        const size_t ka_ = (size_t)((kt_) * 64 + ac * 8) * 2; \
        ra0 = *(const uint4*)(ap[0] + ka_); ra1 = *(const uint4*)(ap[1] + ka_); ra2 = *(const uint4*)(ap[2] + ka_); ra3 = *(const uint4*)(ap[3] + ka_); \
        if constexpr (B_F32) { const char* b_ = bp + (size_t)((kt_) * 64) * ldb * 4; const size_t st_ = (size_t)8 * ldb * 4; \
            rf0 = *(const float4*)(b_); rf1 = *(const float4*)(b_ + st_); rf2 = *(const float4*)(b_ + 2 * st_); rf3 = *(const float4*)(b_ + 3 * st_); \
            rf4 = *(const float4*)(b_ + 4 * st_); rf5 = *(const float4*)(b_ + 5 * st_); rf6 = *(const float4*)(b_ + 6 * st_); rf7 = *(const float4*)(b_ + 7 * st_); } \
        else { const char* b_ = bp + (size_t)((kt_) * 64) * ldb * 2; const size_t st_ = (size_t)16 * ldb * 2; \
            rb0 = *(const uint4*)(b_); rb1 = *(const uint4*)(b_ + st_); rb2 = *(const uint4*)(b_ + 2 * st_); rb3 = *(const uint4*)(b_ + 3 * st_); } \
    } while (0)
#define MG_CVT8(buf_, off_, v_) do { uint2 w_; w_.x = cvtpk((v_).x, (v_).y); w_.y = cvtpk((v_).z, (v_).w); *(uint2*)((buf_) + (off_)) = w_; } while (0)
#define MG_STORE_TILES(buf_) do { \
        *(uint4*)((buf_) + ao0) = ra0; *(uint4*)((buf_) + ao0 + 4096) = ra1; *(uint4*)((buf_) + ao0 + 8192) = ra2; *(uint4*)((buf_) + ao0 + 12288) = ra3; \
        if constexpr (B_F32) { \
            MG_CVT8(buf_, bo_e, rf0); MG_CVT8(buf_, bo_o, rf1); MG_CVT8(buf_, bo_e + 4096, rf2); MG_CVT8(buf_, bo_o + 4096, rf3); \
            MG_CVT8(buf_, bo_e + 8192, rf4); MG_CVT8(buf_, bo_o + 8192, rf5); MG_CVT8(buf_, bo_e + 12288, rf6); MG_CVT8(buf_, bo_o + 12288, rf7); } \
        else { *(uint4*)((buf_) + bo_e) = rb0; *(uint4*)((buf_) + bo_e + 4096) = rb1; *(uint4*)((buf_) + bo_e + 8192) = rb2; *(uint4*)((buf_) + bo_e + 12288) = rb3; } \
    } while (0)
    f32x4 acc[4][4];
#pragma unroll
    for (int i = 0; i < 4; ++i)
#pragma unroll
        for (int j = 0; j < 4; ++j) acc[i][j] = (f32x4){0.f, 0.f, 0.f, 0.f};
    const int nk = K / 64;
    __syncthreads();
    MG_LOAD_TILES(0);
    MG_STORE_TILES(lds);
    __syncthreads();
    for (int kt = 0; kt < nk; ++kt) {
        char* cur = lds + (kt & 1) * 32768;
        if (kt + 1 < nk) MG_LOAD_TILES(kt + 1);
        __builtin_amdgcn_sched_barrier(0);
#pragma unroll
        for (int ks = 0; ks < 2; ++ks) {
            s16x8 af[4], wf[4];
            const int axor = ((ks * 4 + fq) ^ a_sw) << 4;
#pragma unroll
            for (int mi = 0; mi < 4; ++mi) af[mi] = *(const s16x8*)(cur + a_base + mi * 2048 + axor);
            const int r1 = ks * 32 + 8 * fq + wq, r2 = r1 + 4;
#pragma unroll
            for (int ni = 0; ni < 4; ++ni) {
                const int chunk = wn * 8 + ni * 2 + (wp >> 1);
                const LAS char* p1 = (const LAS char*)(cur + 16384 + bimg_off(r1, chunk) + 8 * (wp & 1));
                const LAS char* p2 = (const LAS char*)(cur + 16384 + bimg_off(r2, chunk) + 8 * (wp & 1));
                const s16x4 t1 = __builtin_bit_cast(s16x4, __builtin_amdgcn_ds_read_tr16_b64_v4i16((LAS s16x4*)p1));
                const s16x4 t2 = __builtin_bit_cast(s16x4, __builtin_amdgcn_ds_read_tr16_b64_v4i16((LAS s16x4*)p2));
                wf[ni] = (s16x8){t1[0], t1[1], t1[2], t1[3], t2[0], t2[1], t2[2], t2[3]};
            }
#pragma unroll
            for (int mi = 0; mi < 4; ++mi)
#pragma unroll
                for (int ni = 0; ni < 4; ++ni) acc[mi][ni] = __builtin_amdgcn_mfma_f32_16x16x32_bf16(wf[ni], af[mi], acc[mi][ni], 0, 0, 0);
            if (ks == 0) __builtin_amdgcn_sched_barrier(0);
        }
        __builtin_amdgcn_sched_barrier(0);
        if (kt + 1 < nk) MG_STORE_TILES(lds + ((kt + 1) & 1) * 32768);
        __syncthreads();
    }
    {
        constexpr int NCH = GLU ? 16 : 32;
#pragma unroll
        for (int mi = 0; mi < 4; ++mi) {
            const int m = wm * 64 + mi * 16 + fr;
            if constexpr (GLU) {
#pragma unroll
                for (int ni = 0; ni < 2; ++ni) {
                    const f32x4 g = acc[mi][ni], u = acc[mi][ni + 2];
                    f32x4 r;
#pragma unroll
                    for (int j = 0; j < 4; ++j) r[j] = g[j] / (1.0f + expf(-g[j])) * u[j];
                    const int ch = wn * 8 + ni * 4 + fq;
                    *(f32x4*)(lds + m * 256 + ((ch ^ (m & 7)) << 4)) = r;
                }
            } else {
#pragma unroll
                for (int ni = 0; ni < 4; ++ni) { const int ch = wn * 16 + ni * 4 + fq; *(f32x4*)(lds + m * 512 + ((ch ^ (m & 7)) << 4)) = acc[mi][ni]; }
            }
        }
        __syncthreads();
#pragma unroll 4
        for (int i = 0; i < NCH / 2; ++i) {
            const int idx = i * 256 + tid, m = idx / NCH, ch = idx % NCH;
            const f32x4 v = *(const f32x4*)(lds + m * (NCH * 16) + ((ch ^ (m & 7)) << 4));
            epi(m, ch * 4, v);
        }
    }
}

__device__ __forceinline__ unsigned short f2bf(float v) { return (unsigned short)(cvtpk(v, 0.f) & 0xffffu); }
__device__ __forceinline__ void cvt_seg(const float* src, unsigned short* dst, size_t n, int bid, int nb) {
    const size_t n8 = n / 8;
    for (size_t i = (size_t)bid * NT + threadIdx.x; i < n8; i += (size_t)nb * NT) {
        const float4 a = *(const float4*)(src + i * 8), b = *(const float4*)(src + i * 8 + 4);
        uint4 v; v.x = cvtpk(a.x, a.y); v.y = cvtpk(a.z, a.w); v.z = cvtpk(b.x, b.y); v.w = cvtpk(b.z, b.w);
        *(uint4*)(dst + i * 8) = v;
    }
}
__device__ __forceinline__ void ph_cvt_x(const Params& p, float* sm, int bid, int nb) {
    cvt_seg(p.x, p.Xb, (size_t)T * D, bid, nb);
    cvt_seg(p.w_in, p.WINb, (size_t)D * INW, bid, nb);
    cvt_seg(p.wba, p.WBAb, (size_t)512 * D, bid, nb); cvt_seg(p.wbb, p.WBBb, (size_t)512 * D, bid, nb); cvt_seg(p.wout, p.WOUTb, (size_t)D * D, bid, nb);
    cvt_seg(p.rw, p.RWb, (size_t)D * NE, bid, nb); cvt_seg(p.sgu, p.SGUb, (size_t)D * 512, bid, nb); cvt_seg(p.sdown, p.SDOWNb, (size_t)256 * D, bid, nb);
    cvt_seg(p.w1_k, p.W1Kb, (size_t)2048 * 256, bid, nb); cvt_seg(p.w1_v, p.W1Vb, (size_t)2048 * 256, bid, nb);
    cvt_seg(p.w2_k, p.W2Kb, (size_t)256 * 64, bid, nb); cvt_seg(p.w2_v, p.W2Vb, (size_t)256 * 64, bid, nb);
    cvt_seg(p.w2, p.LW2b, (size_t)64 * 512, bid, nb); cvt_seg(p.a2, p.LA2b, (size_t)64 * 512, bid, nb); cvt_seg(p.g2, p.LG2b, (size_t)128 * 512, bid, nb);
    for (int i = bid * NT + threadIdx.x; i < S * 32; i += nb * NT) {
        const int pos = i >> 5, d = i & 31;
        const float inv = (float)pow(10000.0, -(double)d / 32.0);
        float sn, cs; sincosf((float)pos * inv, &sn, &cs);
        p.TABC[i] = cs; p.TABS[i] = sn;
    }
    if (bid < 2) {
        const float* pe = bid ? p.pe_v : p.pe_k; const float* w1 = bid ? p.w1_v : p.w1_k;
        float acc = 0.f;
        for (int k = 0; k < 2048; ++k) acc += pe[k] * w1[(size_t)k * 256 + threadIdx.x];
        p.CB[bid * 256 + threadIdx.x] = acc;
    }
}
__device__ __forceinline__ int xcd_tile(int ul, int nM, int nN, int x) {
    const int q = nN >> 3, r = nN & 7, nmain = nM * q;
    if (ul < nmain) return ((ul / q) << 16) | (x + 8 * (ul % q));
    const int v = ul - nmain, per = nM >> 3;
    if (v < per * r) return (((v % per) * 8 + x) << 16) | (8 * q + v / per);
    return -1;
}
#define XCD_TILE_LOOP(nM_, nN_) for (int ul_ = bid >> 3, tc_ = xcd_tile(ul_, (nM_), (nN_), bid & 7); tc_ >= 0; ul_ += nb >> 3, tc_ = xcd_tile(ul_, (nM_), (nN_), bid & 7))
#define tm_ (tc_ >> 16)
#define tn_ (tc_ & 0xffff)
__device__ __forceinline__ void ph_inproj(const Params& p, float* sm, int bid, int nb) {
    bf16_t* P = p.P; const bf16_t* x = p.Xb;
    XCD_TILE_LOOP(T / 128, (INW + 127) / 128) {
        const int m0 = tm_ * 128, n0 = tn_ * 128;
        auto ar = [&](int r) { return (const void*)(x + (size_t)(m0 + r) * D); };
        auto bc = [&](int c) { return (n0 + c < INW) ? n0 + c : INW - 8; };
        auto ep = [&](int m, int n, f32x4 v) { if (n0 + n < INW) { uint2 w; w.x = cvtpk(v[0], v[1]); w.y = cvtpk(v[2], v[3]); *(uint2*)(P + (size_t)(m0 + m) * INW + n0 + n) = w; } };
        mgemm_unit<false, false>((char*)sm, D, ar, p.WINb, INW, bc, ep);
    }
}

__device__ __forceinline__ void unpack8(const uint4 v, float (&f)[8]) {
    f[0] = bf2f(v.x & 0xffff); f[1] = bf2f(v.x >> 16); f[2] = bf2f(v.y & 0xffff); f[3] = bf2f(v.y >> 16);
    f[4] = bf2f(v.z & 0xffff); f[5] = bf2f(v.z >> 16); f[6] = bf2f(v.w & 0xffff); f[7] = bf2f(v.w >> 16);
}
__device__ __forceinline__ uint4 pack8(const float (&f)[8]) { uint4 v; v.x = cvtpk(f[0], f[1]); v.y = cvtpk(f[2], f[3]); v.z = cvtpk(f[4], f[5]); v.w = cvtpk(f[6], f[7]); return v; }
__device__ __forceinline__ void ph_prep(const Params& p, float* sm, int bid, int nb) {
    const int tid = threadIdx.x;
    for (int t = bid; t < T; t += nb) {
        const int s = t & (S - 1), b = t >> 13;
        const bf16_t* Pt = p.P + (size_t)t * INW;
        if (tid < 224) {
            const int c0 = tid * 8;
            float cur[8], prv[8], x[8];
            unpack8(*(const uint4*)(Pt + c0), cur);
            if (s > 0) unpack8(*(const uint4*)(Pt + c0 - INW), prv); else { for (int j = 0; j < 8; ++j) prv[j] = 0.f; }
            const float4 mu0 = *(const float4*)(p.mu + c0), mu1 = *(const float4*)(p.mu + c0 + 4);
            const float muv[8] = {mu0.x, mu0.y, mu0.z, mu0.w, mu1.x, mu1.y, mu1.z, mu1.w};
#pragma unroll
            for (int j = 0; j < 8; ++j) x[j] = cur[j] + (prv[j] - cur[j]) * muv[j];
            if (tid < 192) {
                const int region = tid >> 6, c = (tid & 63) * 8;
                const size_t o = (size_t)t * 512 + c;
                if (region == 1) {
                    const float4 k0 = *(const float4*)(p.k_k + c), k1 = *(const float4*)(p.k_k + c + 4);
                    const float kkv[8] = {x[0] * k0.x, x[1] * k0.y, x[2] * k0.z, x[3] * k0.w, x[4] * k1.x, x[5] * k1.y, x[6] * k1.z, x[7] * k1.w};
                    float ss = 0.f;
#pragma unroll
                    for (int j = 0; j < 8; ++j) ss += kkv[j] * kkv[j];
                    ss += __shfl_xor(ss, 1); ss += __shfl_xor(ss, 2); ss += __shfl_xor(ss, 4);
                    const float inv = 1.0f / fmaxf(sqrtf(ss), 1e-12f);
                    *(float4*)(p.KSH + o) = make_float4(x[0], x[1], x[2], x[3]); *(float4*)(p.KSH + o + 4) = make_float4(x[4], x[5], x[6], x[7]);
                    *(float4*)(p.KK + o) = make_float4(kkv[0] * inv, kkv[1] * inv, kkv[2] * inv, kkv[3] * inv); *(float4*)(p.KK + o + 4) = make_float4(kkv[4] * inv, kkv[5] * inv, kkv[6] * inv, kkv[7] * inv);
                } else {
                    float* dst = (region == 0) ? p.R : p.V;
                    *(float4*)(dst + o) = make_float4(x[0], x[1], x[2], x[3]); *(float4*)(dst + o + 4) = make_float4(x[4], x[5], x[6], x[7]);
                }
            } else {
                const int c = (tid - 192) * 8;
                float y[8];
#pragma unroll
                for (int j = 0; j < 8; ++j) y[j] = (c < 64) ? tanhf(x[j]) : (c < 128) ? x[j] : sigmoidf_(x[j]);
                *(uint4*)(p.LORA + (size_t)t * 256 + c) = pack8(y);
            }
        } else if (tid < 248) {
            const int i = tid - 224;
            p.GT[(size_t)t * 24 + i] = sigmoidf_(bf2f(Pt[C_GT + i]));
        }
        if (tid < 48) {
            const int hs = tid >> 2, i0 = (tid & 3) * 8;
            const bf16_t* src = (hs < 8) ? Pt + C_Q + hs * 64 : (hs < 10) ? Pt + C_KS + (hs - 8) * 64 : Pt + C_KW + (hs - 10) * 64;
            bf16_t* dst = (hs < 8) ? p.Qb + (size_t)t * 512 + hs * 64 : (hs < 10) ? p.KSb + (size_t)t * 128 + (hs - 8) * 64 : p.KWb + (size_t)t * 128 + (hs - 10) * 64;
            const float scl = (hs < 8) ? QSCALE : 1.0f;
            float x1[8], x2[8], y1[8], y2[8];
            unpack8(*(const uint4*)(src + i0), x1); unpack8(*(const uint4*)(src + i0 + 32), x2);
            const float4 c0 = *(const float4*)(p.TABC + s * 32 + i0), c1 = *(const float4*)(p.TABC + s * 32 + i0 + 4), s0 = *(const float4*)(p.TABS + s * 32 + i0), s1 = *(const float4*)(p.TABS + s * 32 + i0 + 4);
            const float cs[8] = {c0.x, c0.y, c0.z, c0.w, c1.x, c1.y, c1.z, c1.w}, sn[8] = {s0.x, s0.y, s0.z, s0.w, s1.x, s1.y, s1.z, s1.w};
#pragma unroll
            for (int j = 0; j < 8; ++j) { y1[j] = (x1[j] * cs[j] - x2[j] * sn[j]) * scl; y2[j] = (x2[j] * cs[j] + x1[j] * sn[j]) * scl; }
            *(uint4*)(dst + i0) = pack8(y1); *(uint4*)(dst + i0 + 32) = pack8(y2);
        } else if (tid >= 64 && tid < 128) {
            const int i = tid - 64, which = i >> 4, c = (i & 15) * 8;
            const int scol = (which == 0) ? C_VS : (which == 1) ? C_VW : (which == 2) ? C_KC : C_VC;
            const uint4 v = *(const uint4*)(Pt + scol + c);
            if (which == 0) *(uint4*)(p.VSb + (size_t)t * 128 + c) = v;
            else if (which == 1) *(uint4*)(p.VWb + (size_t)t * 128 + c) = v;
            else { bf16_t* base = (which == 2) ? p.KCin : p.VCin; *(uint4*)(base + ((size_t)(b * 2 + (c >> 6)) * S + s) * 64 + (c & 63)) = v; }
        }
    }
}
__device__ __forceinline__ void ph_prep_gemm(const Params& p, float* sm, int bid, int nb) {
    const int n_lora = (T / 128) * 4 * 3, n_cmp = 16 * 2 * 2;
    for (int u = bid; u < n_lora + n_cmp; u += nb) {
        if (u < n_lora) {
            const int part = u % 3, n0 = ((u / 3) % 4) * 128, m0 = (u / 12) * 128;
            const bf16_t* A = p.LORA + (part == 0 ? 0 : part == 1 ? 64 : 128);
            const bf16_t* Bw = (part == 0) ? p.LW2b : (part == 1) ? p.LA2b : p.LG2b;
            auto ar = [&](int r) { return (const void*)(A + (size_t)(m0 + r) * 256); };
            auto bc = [&](int c) { return n0 + c; };
            if (part == 0) {
                float* DC = p.DC; const float* w0 = p.w0;
                auto ep = [&](int m, int n, f32x4 v) {
                    const int c = n0 + n; const f32x4 w0v = *(const f32x4*)(w0 + c); f32x4 o;
#pragma unroll
                    for (int j = 0; j < 4; ++j) { const float nx = -(w0v[j] + v[j]); const float sp = (nx > 20.f) ? nx : log1pf(expf(nx)); o[j] = expf(-expf(-sp - 0.5f)); }
                    *(f32x4*)(DC + (size_t)(m0 + m) * 512 + c) = o;
                };
                mgemm_unit<false, false>((char*)sm, 64, ar, Bw, 512, bc, ep);
            } else if (part == 1) {
                float* K2 = p.K2; float* BB = p.BB; const float* KSH = p.KSH; const float* KK = p.KK; const float* a0 = p.a0; const float* k_a = p.k_a;
                auto ep = [&](int m, int n, f32x4 v) {
                    const int c = n0 + n; const size_t o = (size_t)(m0 + m) * 512 + c;
                    const f32x4 a0v = *(const f32x4*)(a0 + c), kav = *(const f32x4*)(k_a + c), kv = *(const f32x4*)(KSH + o), kkv = *(const f32x4*)(KK + o);
                    f32x4 k2, bb;
#pragma unroll
                    for (int j = 0; j < 4; ++j) { const float a = sigmoidf_(a0v[j] + v[j]); k2[j] = kv[j] * (1.0f + (a - 1.0f) * kav[j]); bb[j] = kkv[j] * a; }
                    *(f32x4*)(K2 + o) = k2; *(f32x4*)(BB + o) = bb;
                };
                mgemm_unit<false, false>((char*)sm, 64, ar, Bw, 512, bc, ep);
            } else {
                float* G = p.G;
                auto ep = [&](int m, int n, f32x4 v) { *(f32x4*)(G + (size_t)(m0 + m) * 512 + n0 + n) = v; };
                mgemm_unit<false, false>((char*)sm, 128, ar, Bw, 512, bc, ep);
            }
        } else {
            const int v = u - n_lora, kv = v & 1, n0 = ((v >> 1) & 1) * 128, m0 = (v >> 2) * 128;
            const bf16_t* IN = kv ? p.VCin : p.KCin; const bf16_t* Bw = kv ? p.W1Vb : p.W1Kb; bf16_t* H1 = kv ? p.H1Vb : p.H1Kb; const float* cb = p.CB + kv * 256;
            auto ar = [&](int r) { int rr = m0 + r; if (rr >= NCROWS) rr = NCROWS - 1; const int g = rr & 1, bc_ = rr >> 1, b = bc_ / NCMP, c = bc_ % NCMP; return (const void*)(IN + ((size_t)(b * 2 + g) * S + 16 * c) * 64); };
            auto bc = [&](int c) { return n0 + c; };
            auto ep = [&](int m, int n, f32x4 v4) {
                const int rr = m0 + m; if (rr >= NCROWS) return;
                const f32x4 bv = *(const f32x4*)(cb + n0 + n);
                uint2 w; w.x = cvtpk(gelu_tanh(v4[0] + bv[0]), gelu_tanh(v4[1] + bv[1])); w.y = cvtpk(gelu_tanh(v4[2] + bv[2]), gelu_tanh(v4[3] + bv[3]));
                *(uint2*)(H1 + (size_t)rr * 256 + n0 + n) = w;
            };
            mgemm_unit<false, false>((char*)sm, 2048, ar, Bw, 256, bc, ep);
        }
    }
}

constexpr int SCH = 16;
constexpr int SCH_FLOATS = SCH * (5 * 64 + 16);
template <int CTRL> __device__ __forceinline__ float dpp_mov(float v) { return __builtin_bit_cast(float, __builtin_amdgcn_update_dpp(0, __builtin_bit_cast(int, v), CTRL, 0xf, 0xf, false)); }
__device__ __forceinline__ float row16_sum(float x) {
    x += dpp_mov<0xB1>(x);
    x += dpp_mov<0x4E>(x);
    x += dpp_mov<0x141>(x);
    x += dpp_mov<0x140>(x);
    return x;
}
__device__ __forceinline__ void ph_scan(const Params& p, float* sm, int bid, int nb) {
    const int tid = threadIdx.x, row = tid >> 4, q = tid & 15;
    for (int item = bid; item < 64; item += nb) {
        const int b = item >> 5, h = (item >> 2) & 7, qu = item & 3;
        const int st_ = tid >> 4, part = tid & 15;
        const size_t gbase = ((size_t)(b * S + st_)) * 512 + h * 64 + part * 4;
        const size_t vbase = ((size_t)(b * S + st_)) * 512 + h * 64 + qu * 16 + part;
        float4 pr, pd, pk, pkk, pb; float pv;
        auto gload = [&](int t0) {
            const size_t o = gbase + (size_t)t0 * 512;
            pr = *(const float4*)(p.R + o); pd = *(const float4*)(p.DC + o); pk = *(const float4*)(p.K2 + o); pkk = *(const float4*)(p.KK + o); pb = *(const float4*)(p.BB + o);
            pv = p.V[vbase + (size_t)t0 * 512];
        };
        auto lstore = [&](float* buf) {
            float* d = buf + st_ * 320 + part * 4;
            *(float4*)(d) = pr; *(float4*)(d + 64) = pd; *(float4*)(d + 128) = pk; *(float4*)(d + 192) = pkk; *(float4*)(d + 256) = pb;
            buf[SCH * 320 + st_ * 16 + part] = pv;
        };
        float s0 = 0.f, s1 = 0.f, s2 = 0.f, s3 = 0.f;
        __syncthreads();
        gload(0); lstore(sm);
        __syncthreads();
        for (int t0 = 0; t0 < S; t0 += SCH) {
            const float* cur = sm + ((t0 / SCH) & 1) * SCH_FLOATS;
            if (t0 + SCH < S) gload(t0 + SCH);
            __builtin_amdgcn_sched_barrier(0);
            const float* d0 = cur + q * 4;
            const float* v0 = cur + SCH * 320 + row;
            float4 rr = *(const float4*)(d0), dd = *(const float4*)(d0 + 64), kv = *(const float4*)(d0 + 128), kk = *(const float4*)(d0 + 192), bb = *(const float4*)(d0 + 256);
            float vv = v0[0];
            float oreg = 0.f;
#pragma unroll
            for (int st = 0; st < SCH; ++st) {
                float4 rr2 = rr, dd2 = dd, kv2 = kv, kk2 = kk, bb2 = bb; float vv2 = vv;
                if (st + 1 < SCH) {
                    const float* d = d0 + (st + 1) * 320;
                    rr2 = *(const float4*)(d); dd2 = *(const float4*)(d + 64); kv2 = *(const float4*)(d + 128); kk2 = *(const float4*)(d + 192); bb2 = *(const float4*)(d + 256);
                    vv2 = v0[(st + 1) * 16];
                }
                float sa = (s0 * kk.x + s1 * kk.y) + (s2 * kk.z + s3 * kk.w);
                sa = -row16_sum(sa);
                s0 = (s0 * dd.x + vv * kv.x) + sa * bb.x;
                s1 = (s1 * dd.y + vv * kv.y) + sa * bb.y;
                s2 = (s2 * dd.z + vv * kv.z) + sa * bb.z;
                s3 = (s3 * dd.w + vv * kv.w) + sa * bb.w;
                float o = (s0 * rr.x + s1 * rr.y) + (s2 * rr.z + s3 * rr.w);
                o = row16_sum(o);
                oreg = (q == st) ? o : oreg;
                rr = rr2; dd = dd2; kv = kv2; kk = kk2; bb = bb2; vv = vv2;
            }
            if (t0 + SCH < S) lstore(sm + (((t0 / SCH) + 1) & 1) * SCH_FLOATS);
            p.O[((size_t)(b * S + t0 + q)) * 512 + h * 64 + qu * 16 + row] = oreg;
            __syncthreads();
        }
    }
}

constexpr int SCI_AP = 0, SCI_RP = 2048, SCI_BQ = 4096, SCI_KQ = 6144, SCI_LAK = 8192, SCI_TT = 8704, SCI_MRB = 9216, SCI_MRK = 9728, SCI_GC = 10240, SCI_BYTES = 10496;
__device__ __forceinline__ f32x4 mfma16(s16x4 a, s16x4 b, f32x4 c) { const s16x8 a8 = {a[0], a[1], a[2], a[3], 0, 0, 0, 0}, b8 = {b[0], b[1], b[2], b[3], 0, 0, 0, 0}; return __builtin_amdgcn_mfma_f32_16x16x32_bf16(a8, b8, c, 0, 0, 0); }
__device__ __forceinline__ f32x4 mfma32(s16x8 a, s16x8 b, f32x4 c) { return __builtin_amdgcn_mfma_f32_16x16x32_bf16(a, b, c, 0, 0, 0); }
__device__ __forceinline__ s16x4 packf4(f32x4 v) { uint2 w; w.x = cvtpk(v[0], v[1]); w.y = cvtpk(v[2], v[3]); return __builtin_bit_cast(s16x4, w); }
__device__ __forceinline__ s16x8 packf8(f32x4 a, f32x4 b) { uint4 w; w.x = cvtpk(a[0], a[1]); w.y = cvtpk(a[2], a[3]); w.z = cvtpk(b[0], b[1]); w.w = cvtpk(b[2], b[3]); return __builtin_bit_cast(s16x8, w); }
#define WAVE_LDS_SYNC() asm volatile("s_waitcnt lgkmcnt(0)" ::: "memory")
__device__ __forceinline__ void ph_scan_pre(const Params& p, float* sm, int bid, int nb) {
    const int tid = threadIdx.x, lane = tid & 63, wave = tid >> 6, li = lane & 15, fq = lane >> 4;
    char* wl = (char*)sm + wave * 10240;
    bf16_t* A_l = (bf16_t*)wl; bf16_t* R_l = A_l + 1024; bf16_t* B_l = A_l + 2048; bf16_t* K_l = A_l + 3072;
    float* Lf = (float*)(wl + 8192); float* Tf = (float*)(wl + 9216);
    __syncthreads();
    for (int item = bid * 4 + wave; item < 8192; item += nb * 4) {
        const int ch = item & 511, bh = item >> 9, b = bh >> 3, h = bh & 7;
        const size_t base = ((size_t)(b * S + ch * 16)) * 512 + h * 64 + lane;
        char* out = p.SCANI + (size_t)item * SCI_BYTES;
        float G = 1.0f;
        float bt[16], kt[16];
        WAVE_LDS_SYNC();
#pragma unroll
        for (int t = 0; t < 16; ++t) {
            const size_t o = base + (size_t)t * 512;
            const float d = p.DC[o], kk = p.KK[o], bb = p.BB[o], k2 = p.K2[o], r = p.R[o];
            const float Gp = G; G *= d; const float ig = 1.0f / G;
            bt[t] = bb * ig; kt[t] = k2 * ig;
            A_l[t * 64 + lane] = f2bf(-kk * Gp); R_l[t * 64 + lane] = f2bf(r * G); B_l[t * 64 + lane] = f2bf(bt[t]); K_l[t * 64 + lane] = f2bf(kt[t]);
        }
        *(float*)(out + SCI_GC + lane * 4) = G;
        {
            uint4 w0, w1;
            w0.x = cvtpk(bt[0], bt[1]); w0.y = cvtpk(bt[2], bt[3]); w0.z = cvtpk(bt[4], bt[5]); w0.w = cvtpk(bt[6], bt[7]);
            w1.x = cvtpk(bt[8], bt[9]); w1.y = cvtpk(bt[10], bt[11]); w1.z = cvtpk(bt[12], bt[13]); w1.w = cvtpk(bt[14], bt[15]);
            *(uint4*)(out + SCI_BQ + lane * 32) = w0; *(uint4*)(out + SCI_BQ + lane * 32 + 16) = w1;
            w0.x = cvtpk(kt[0], kt[1]); w0.y = cvtpk(kt[2], kt[3]); w0.z = cvtpk(kt[4], kt[5]); w0.w = cvtpk(kt[6], kt[7]);
            w1.x = cvtpk(kt[8], kt[9]); w1.y = cvtpk(kt[10], kt[11]); w1.z = cvtpk(kt[12], kt[13]); w1.w = cvtpk(kt[14], kt[15]);
            *(uint4*)(out + SCI_KQ + lane * 32) = w0; *(uint4*)(out + SCI_KQ + lane * 32 + 16) = w1;
        }
        WAVE_LDS_SYNC();
        f32x4 Lab = {0.f, 0.f, 0.f, 0.f}, Lak = Lab, Mrb = Lab, Mrk = Lab;
#pragma unroll
        for (int s2 = 0; s2 < 2; ++s2) {
            const int o = li * 64 + s2 * 32 + fq * 8;
            const s16x8 bf = *(const s16x8*)(B_l + o), kf = *(const s16x8*)(K_l + o), af = *(const s16x8*)(A_l + o), rf = *(const s16x8*)(R_l + o);
            Lab = mfma32(bf, af, Lab); Lak = mfma32(kf, af, Lak); Mrb = mfma32(bf, rf, Mrb); Mrk = mfma32(kf, rf, Mrk);
        }
#pragma unroll
        for (int r = 0; r < 4; ++r) {
            const int i = 4 * fq + r;
            if (!(i < li)) { Lab[r] = 0.f; Lak[r] = 0.f; }
            if (!(i <= li)) { Mrb[r] = 0.f; Mrk[r] = 0.f; }
            Lf[i * 16 + li] = Lab[r];
        }
        *(uint2*)(out + SCI_LAK + (li * 16 + 4 * fq) * 2) = __builtin_bit_cast(uint2, packf4(Lak));
        *(uint2*)(out + SCI_MRB + (li * 16 + 4 * fq) * 2) = __builtin_bit_cast(uint2, packf4(Mrb));
        *(uint2*)(out + SCI_MRK + (li * 16 + 4 * fq) * 2) = __builtin_bit_cast(uint2, packf4(Mrk));
        WAVE_LDS_SYNC();
        float Tr[16];
#pragma unroll
        for (int t = 0; t < 16; ++t) {
            float acc = (t == li) ? 1.0f : 0.0f;
#pragma unroll
            for (int j = 0; j < t; ++j) acc += Tr[j] * Lf[j * 16 + t];
            Tr[t] = acc;
        }
        if (fq == 0) {
#pragma unroll
            for (int t = 0; t < 16; t += 4) *(float4*)(Tf + li * 16 + t) = make_float4(Tr[t], Tr[t + 1], Tr[t + 2], Tr[t + 3]);
        }
        WAVE_LDS_SYNC();
        {
            const f32x4 tv = {Tf[(4 * fq + 0) * 16 + li], Tf[(4 * fq + 1) * 16 + li], Tf[(4 * fq + 2) * 16 + li], Tf[(4 * fq + 3) * 16 + li]};
            *(uint2*)(out + SCI_TT + (li * 16 + 4 * fq) * 2) = __builtin_bit_cast(uint2, packf4(tv));
        }
#pragma unroll
        for (int c2 = 0; c2 < 2; ++c2) {
            const int q = lane + 64 * c2, s2 = q >> 6, t = (q >> 2) & 15, f = q & 3;
            const int e0 = t * 64 + 32 * s2 + 4 * f;
            uint4 w; const uint2 a0 = *(const uint2*)(A_l + e0), a1 = *(const uint2*)(A_l + e0 + 16);
            w.x = a0.x; w.y = a0.y; w.z = a1.x; w.w = a1.y; *(uint4*)(out + SCI_AP + q * 16) = w;
            const uint2 r0 = *(const uint2*)(R_l + e0), r1 = *(const uint2*)(R_l + e0 + 16);
            w.x = r0.x; w.y = r0.y; w.z = r1.x; w.w = r1.y; *(uint4*)(out + SCI_RP + q * 16) = w;
        }
    }
}
constexpr int SC_SLOT = 16384, SC_VOFF = SCI_BYTES;
__device__ __forceinline__ void ph_scan_seq(const Params& p, float* sm, int bid, int nb) {
    const int tid = threadIdx.x, lane = tid & 63, vs = tid >> 6, li = lane & 15, fq = lane >> 4;
    char* lds = (char*)sm;
    for (int bh = bid; bh < 16; bh += nb) {
        const int b = bh >> 3, h = bh & 7;
        const char* item = p.SCANI + (size_t)(bh * 512) * SCI_BYTES;
        const size_t vcol = (size_t)h * 64 + vs * 16 + li;
        const char* src2; size_t st2; const char* src3; size_t st3;
        {
            const int q2 = tid + 512, q3 = tid + 768;
            if (q2 < 656) { src2 = item + (size_t)q2 * 16; st2 = SCI_BYTES; } else { const int vq = q2 - 656; src2 = (const char*)(p.V + ((size_t)(b * S + (vq >> 4))) * 512 + h * 64 + (vq & 15) * 4); st2 = (size_t)16 * 512 * 4; }
            if (q3 < 912) { const int vq = q3 - 656; src3 = (const char*)(p.V + ((size_t)(b * S + (vq >> 4))) * 512 + h * 64 + (vq & 15) * 4); st3 = (size_t)16 * 512 * 4; } else { src3 = item; st3 = SCI_BYTES; }
        }
        const char* src0 = item + (size_t)tid * 16; const char* src1 = item + (size_t)(tid + 256) * 16;
        const int d2 = (tid + 512 < 656) ? (tid + 512) * 16 : SC_VOFF + (tid + 512 - 656) * 16;
        const int d3 = (tid + 768 < 912) ? SC_VOFF + (tid + 768 - 656) * 16 : 15360 + (tid & 63) * 16;
        f32x4 S0 = {0.f, 0.f, 0.f, 0.f}, S1 = S0, S2 = S0, S3 = S0;
        uint4 rA0, rA1, rA2, rA3, rB0, rB1, rB2, rB3, rC0, rC1, rC2, rC3, rD0, rD1, rD2, rD3;
#define SC_GLOAD(R, chn_) do { const int cc_ = ((chn_) < 512) ? (chn_) : 511; \
        R##0 = *(const uint4*)(src0 + (size_t)cc_ * SCI_BYTES); R##1 = *(const uint4*)(src1 + (size_t)cc_ * SCI_BYTES); \
        R##2 = *(const uint4*)(src2 + (size_t)cc_ * st2); R##3 = *(const uint4*)(src3 + (size_t)cc_ * st3); } while (0)
#define SC_LSTORE(R, slot_) do { char* sl_ = lds + (slot_) * SC_SLOT; \
        *(uint4*)(sl_ + tid * 16) = R##0; *(uint4*)(sl_ + (tid + 256) * 16) = R##1; *(uint4*)(sl_ + d2) = R##2; *(uint4*)(sl_ + d3) = R##3; } while (0)
#define SC_COMPUTE(chn_, slot_) do { const char* it_ = lds + (slot_) * SC_SLOT; \
        const s16x8 ap0 = *(const s16x8*)(it_ + SCI_AP + ((0 * 16 + li) * 4 + fq) * 16), ap1 = *(const s16x8*)(it_ + SCI_AP + ((1 * 16 + li) * 4 + fq) * 16); \
        const s16x8 rp0 = *(const s16x8*)(it_ + SCI_RP + ((0 * 16 + li) * 4 + fq) * 16), rp1 = *(const s16x8*)(it_ + SCI_RP + ((1 * 16 + li) * 4 + fq) * 16); \
        const s16x4 bq0 = *(const s16x4*)(it_ + SCI_BQ + ((0 * 16 + li) * 16 + 4 * fq) * 2), bq1 = *(const s16x4*)(it_ + SCI_BQ + ((1 * 16 + li) * 16 + 4 * fq) * 2); \
        const s16x4 bq2 = *(const s16x4*)(it_ + SCI_BQ + ((2 * 16 + li) * 16 + 4 * fq) * 2), bq3 = *(const s16x4*)(it_ + SCI_BQ + ((3 * 16 + li) * 16 + 4 * fq) * 2); \
        const s16x4 kq0 = *(const s16x4*)(it_ + SCI_KQ + ((0 * 16 + li) * 16 + 4 * fq) * 2), kq1 = *(const s16x4*)(it_ + SCI_KQ + ((1 * 16 + li) * 16 + 4 * fq) * 2); \
        const s16x4 kq2 = *(const s16x4*)(it_ + SCI_KQ + ((2 * 16 + li) * 16 + 4 * fq) * 2), kq3 = *(const s16x4*)(it_ + SCI_KQ + ((3 * 16 + li) * 16 + 4 * fq) * 2); \
        const s16x4 lak = *(const s16x4*)(it_ + SCI_LAK + (li * 16 + 4 * fq) * 2), ttm = *(const s16x4*)(it_ + SCI_TT + (li * 16 + 4 * fq) * 2); \
        const s16x4 mrb = *(const s16x4*)(it_ + SCI_MRB + (li * 16 + 4 * fq) * 2), mrk = *(const s16x4*)(it_ + SCI_MRK + (li * 16 + 4 * fq) * 2); \
        const f32x4 g0 = *(const f32x4*)(it_ + SCI_GC + (0 * 16 + 4 * fq) * 4), g1 = *(const f32x4*)(it_ + SCI_GC + (1 * 16 + 4 * fq) * 4); \
        const f32x4 g2 = *(const f32x4*)(it_ + SCI_GC + (2 * 16 + 4 * fq) * 4), g3 = *(const f32x4*)(it_ + SCI_GC + (3 * 16 + 4 * fq) * 4); \
        const float* vl_ = (const float*)(it_ + SC_VOFF) + (4 * fq) * 64 + vs * 16 + li; \
        const s16x4 vb = packf4((f32x4){vl_[0], vl_[64], vl_[128], vl_[192]}); \
        const s16x8 sb0 = packf8(S0, S1), sb1 = packf8(S2, S3); \
        const f32x4 z_ = {0.f, 0.f, 0.f, 0.f}; \
        f32x4 W = mfma32(ap0, sb0, z_); W = mfma32(ap1, sb1, W); W = mfma16(lak, vb, W); \
        const f32x4 U = mfma16(ttm, packf4(W), z_); \
        const s16x4 ub = packf4(U); \
        f32x4 O = mfma32(rp0, sb0, z_); O = mfma32(rp1, sb1, O); O = mfma16(mrk, vb, O); O = mfma16(mrb, ub, O); \
        S0 = mfma16(kq0, vb, S0); S0 = mfma16(bq0, ub, S0); S1 = mfma16(kq1, vb, S1); S1 = mfma16(bq1, ub, S1); \
        S2 = mfma16(kq2, vb, S2); S2 = mfma16(bq2, ub, S2); S3 = mfma16(kq3, vb, S3); S3 = mfma16(bq3, ub, S3); \
        S0 *= g0; S1 *= g1; S2 *= g2; S3 *= g3; \
        float* op_ = p.O + ((size_t)(b * S + (chn_) * 16 + 4 * fq)) * 512 + vcol; \
        op_[0] = O[0]; op_[512] = O[1]; op_[1024] = O[2]; op_[1536] = O[3]; } while (0)
        SC_GLOAD(rA, 0); SC_GLOAD(rB, 1); SC_GLOAD(rC, 2); SC_GLOAD(rD, 3);
        for (int ch = 0; ch < 512; ch += 4) {
            __syncthreads();
            asm volatile("s_waitcnt vmcnt(0)" ::: "memory");
            SC_LSTORE(rA, 0); SC_LSTORE(rB, 1); SC_LSTORE(rC, 2); SC_LSTORE(rD, 3);
            __syncthreads();
            SC_GLOAD(rA, ch + 4); SC_GLOAD(rB, ch + 5); SC_GLOAD(rC, ch + 6); SC_GLOAD(rD, ch + 7);
            __builtin_amdgcn_sched_barrier(0);
            SC_COMPUTE(ch, 0); SC_COMPUTE(ch + 1, 1); SC_COMPUTE(ch + 2, 2); SC_COMPUTE(ch + 3, 3);
        }
#undef SC_COMPUTE
#undef SC_LSTORE
#undef SC_GLOAD
    }
}

__device__ __forceinline__ void ph_rwkv_post(const Params& p, float* sm, int bid, int nb) {
    const int tid = threadIdx.x;
    for (int t = bid; t < T; t += nb) {
#pragma unroll
        for (int slot = 0; slot < 2; ++slot) {
            const int c = tid + slot * 256;
            const size_t o = (size_t)t * 512 + c;
            const float ov = p.O[o];
            const float m = wave_sum(ov) * (1.0f / 64.0f);
            const float dl = ov - m;
            const float var = wave_sum(dl * dl) * (1.0f / 64.0f);
            const float on = dl * rsqrtf(var + 64e-5f) * p.lnx_w[c] + p.lnx_b[c];
            const float bon = wave_sum(p.R[o] * p.K2[o] * p.r_k[c]) * p.V[o];
            p.YAb[o] = f2bf((on + bon) * p.G[o]);
        }
    }
}

__device__ __forceinline__ void ph_cmp2(const Params& p, float* sm, int bid, int nb) {
    for (int u = bid; u < 32; u += nb) {
        const int kv = u & 1, m0 = (u >> 1) * 128;
        const bf16_t* H1 = kv ? p.H1Vb : p.H1Kb; const bf16_t* Bw = kv ? p.W2Vb : p.W2Kb; float* OUT = kv ? p.VC : p.KCraw;
        auto ar = [&](int r) { int rr = m0 + r; if (rr >= NCROWS) rr = NCROWS - 1; return (const void*)(H1 + (size_t)rr * 256); };
        auto bc = [&](int c) { return (c < 64) ? c : 0; };
        auto ep = [&](int m, int n, f32x4 v) { const int rr = m0 + m; if (rr < NCROWS && n < 64) *(f32x4*)(OUT + (size_t)rr * 64 + n) = v; };
        mgemm_unit<false, false>((char*)sm, 256, ar, Bw, 64, bc, ep);
    }
}
__device__ __forceinline__ void ph_cmp_rope(const Params& p, float* sm, int bid, int nb) {
    const int tid = threadIdx.x;
    for (int i = bid * NT + tid; i < NCROWS * 32; i += nb * NT) {
        const int r = i >> 5, d = i & 31;
        const int c = (r >> 1) % NCMP;
        const int pos = 16 * c + 31;
        const float cs = p.TABC[pos * 32 + d], sn = p.TABS[pos * 32 + d];
        const float x1 = p.KCraw[(size_t)r * 64 + d], x2 = p.KCraw[(size_t)r * 64 + d + 32];
        const float y1 = x1 * cs - x2 * sn, y2 = x2 * cs + x1 * sn;
        const int g = r & 1, b = (r >> 1) / NCMP;
        const size_t ob = ((size_t)((b * 2 + g) * 512 + c)) * 64;
        p.KCb[ob + d] = f2bf(y1); p.KCb[ob + d + 32] = f2bf(y2);
        p.VCb[ob + d] = f2bf(p.VC[(size_t)r * 64 + d]); p.VCb[ob + d + 32] = f2bf(p.VC[(size_t)r * 64 + d + 32]);
    }
    for (int i = bid * NT + tid; i < 4 * 64; i += nb * NT) { const size_t ob = ((size_t)((i >> 6) * 512 + 511)) * 64 + (i & 63); p.KCb[ob] = 0; p.VCb[ob] = 0; }
}

__device__ __forceinline__ int kimg_off(int key, int c) { return key * 128 + ((c ^ ((key >> 1) & 7)) << 4); }
__device__ __forceinline__ int vimg_off(int key, int c) { return key * 128 + ((c ^ (((key >> 1) & 3) << 1)) << 4); }
__device__ __forceinline__ float fast_exp2(float x) { return __builtin_amdgcn_exp2f(x); }

struct NsaCtx {
    char* lds; int tid, lane, wave, fr, fq, li;
    s16x8 qf[2][2];
    int tq[2];
};

__device__ __forceinline__ void nsa_qk(const NsaCtx& c, const char* cur, f32x4 (&s)[2][4]) {
#pragma unroll
    for (int kt = 0; kt < 4; ++kt) {
#pragma unroll
        for (int ks = 0; ks < 2; ++ks) {
            const s16x8 kf = *(const s16x8*)(cur + kimg_off(kt * 16 + c.fr, ks * 4 + c.fq));
#pragma unroll
            for (int qt = 0; qt < 2; ++qt) {
                if (ks == 0) s[qt][kt] = __builtin_amdgcn_mfma_f32_16x16x32_bf16(kf, c.qf[qt][0], (f32x4){0.f, 0.f, 0.f, 0.f}, 0, 0, 0);
                else s[qt][kt] = __builtin_amdgcn_mfma_f32_16x16x32_bf16(kf, c.qf[qt][1], s[qt][kt], 0, 0, 0);
            }
        }
    }
}
__device__ __forceinline__ void nsa_pv(const NsaCtx& c, const char* cur, const f32x4 (&pr)[2][4], f32x4 (&O)[2][4]) {
    s16x8 pb[2][2];
#pragma unroll
    for (int qt = 0; qt < 2; ++qt)
#pragma unroll
        for (int k2 = 0; k2 < 2; ++k2) {
            const f32x4 a = pr[qt][2 * k2], b = pr[qt][2 * k2 + 1];
            const unsigned w0 = cvtpk(a[0], a[1]), w1 = cvtpk(a[2], a[3]), w2 = cvtpk(b[0], b[1]), w3 = cvtpk(b[2], b[3]);
            pb[qt][k2] = __builtin_bit_cast(s16x8, make_uint4(w0, w1, w2, w3));
        }
    const int q_ = c.li >> 2, p_ = c.li & 3;
#pragma unroll
    for (int dt = 0; dt < 4; ++dt)
#pragma unroll
        for (int k2 = 0; k2 < 2; ++k2) {
            const int key1 = k2 * 32 + 4 * c.fq + q_, key2 = key1 + 16;
            const int chunk = dt * 2 + (p_ >> 1);
            const LAS char* a1 = (const LAS char*)(cur + 8192 + vimg_off(key1, chunk) + 8 * (p_ & 1));
            const LAS char* a2 = (const LAS char*)(cur + 8192 + vimg_off(key2, chunk) + 8 * (p_ & 1));
            const s16x4 t1 = __builtin_bit_cast(s16x4, __builtin_amdgcn_ds_read_tr16_b64_v4i16((LAS s16x4*)a1));
            const s16x4 t2 = __builtin_bit_cast(s16x4, __builtin_amdgcn_ds_read_tr16_b64_v4i16((LAS s16x4*)a2));
            const s16x8 vf = (s16x8){t1[0], t1[1], t1[2], t1[3], t2[0], t2[1], t2[2], t2[3]};
#pragma unroll
            for (int qt = 0; qt < 2; ++qt) O[qt][dt] = __builtin_amdgcn_mfma_f32_16x16x32_bf16(vf, pb[qt][k2], O[qt][dt], 0, 0, 0);
        }
}
#define KVREGS uint4 rk0, rk1, rv0, rv1
#define KVARGS rk0, rk1, rv0, rv1
__device__ __forceinline__ void nsa_gload(const NsaCtx& c, uint4& rk0, uint4& rk1, uint4& rv0, uint4& rv1, const bf16_t* Kg, const bf16_t* Vg, int stride, int tile) {
    { const int idx = c.tid, key = idx >> 3, ch = idx & 7; const size_t off = (size_t)(tile * 64 + key) * stride + ch * 8; rk0 = *(const uint4*)(Kg + off); rv0 = *(const uint4*)(Vg + off); }
    { const int idx = 256 + c.tid, key = idx >> 3, ch = idx & 7; const size_t off = (size_t)(tile * 64 + key) * stride + ch * 8; rk1 = *(const uint4*)(Kg + off); rv1 = *(const uint4*)(Vg + off); }
}
__device__ __forceinline__ void nsa_lstore(const NsaCtx& c, const uint4& rk0, const uint4& rk1, const uint4& rv0, const uint4& rv1, char* buf) {
    { const int idx = c.tid, key = idx >> 3, ch = idx & 7; *(uint4*)(buf + kimg_off(key, ch)) = rk0; *(uint4*)(buf + 8192 + vimg_off(key, ch)) = rv0; }
    { const int idx = 256 + c.tid, key = idx >> 3, ch = idx & 7; *(uint4*)(buf + kimg_off(key, ch)) = rk1; *(uint4*)(buf + 8192 + vimg_off(key, ch)) = rv1; }
}
__device__ __forceinline__ bool selbit4(const unsigned (&w)[4], int tile) {
    const int wi = tile >> 5; const unsigned x = (wi == 0) ? w[0] : (wi == 1) ? w[1] : (wi == 2) ? w[2] : w[3];
    return ((x >> (tile & 31)) & 1u) != 0u;
}
__device__ __forceinline__ float xmax16_32(float v) { v = fmaxf(v, __shfl_xor(v, 16)); v = fmaxf(v, __shfl_xor(v, 32)); return v; }
__device__ __forceinline__ float xsum16_32(float v) { v += __shfl_xor(v, 16); v += __shfl_xor(v, 32); return v; }

template <int BR>
__device__ __forceinline__ void nsa_flash(const NsaCtx& c, const bf16_t* Kg, const bf16_t* Vg, int stride, int tile_lo, int tile_hi, const unsigned (&selw)[2][4],
                                          float (&m)[2], float (&l)[2], f32x4 (&O)[2][4]) {
    if (tile_lo > tile_hi) return;
    KVREGS;
    __syncthreads();
    nsa_gload(c, KVARGS, Kg, Vg, stride, tile_lo);
    nsa_lstore(c, KVARGS, c.lds);
    __syncthreads();
    for (int tile = tile_lo; tile <= tile_hi; ++tile) {
        char* cur = c.lds + ((tile - tile_lo) & 1) * 16384;
        if (tile < tile_hi) nsa_gload(c, KVARGS, Kg, Vg, stride, tile + 1);
        __builtin_amdgcn_sched_barrier(0);
        bool need = true;
        if (BR == 1) {
            const bool mine = selbit4(selw[0], tile) || selbit4(selw[1], tile);
            need = __ballot(mine) != 0ull;
        }
        if (need) {
            f32x4 s[2][4];
            nsa_qk(c, cur, s);
#pragma unroll
            for (int qt = 0; qt < 2; ++qt) {
                const int t = c.tq[qt];
                bool rowok = true;
                if (BR == 1) rowok = selbit4(selw[qt], tile);
                float tmax = -1e30f;
#pragma unroll
                for (int kt = 0; kt < 4; ++kt)
#pragma unroll
                    for (int r = 0; r < 4; ++r) {
                        const int kap = tile * 64 + kt * 16 + 4 * c.fq + r;
                        bool ok = rowok && (kap <= t);
                        if (BR == 2) ok = ok && (kap + 511 >= t);
                        const float v = ok ? s[qt][kt][r] : -1e30f;
                        s[qt][kt][r] = v; tmax = fmaxf(tmax, v);
                    }
                tmax = xmax16_32(tmax);
                const float mn = fmaxf(m[qt], tmax);
                const float alpha = fast_exp2(m[qt] - mn);
                m[qt] = mn;
                float rs = 0.f;
#pragma unroll
                for (int kt = 0; kt < 4; ++kt)
#pragma unroll
                    for (int r = 0; r < 4; ++r) { const float v = s[qt][kt][r]; const float pv = (v > -1e29f) ? fast_exp2(v - mn) : 0.f; s[qt][kt][r] = pv; rs += pv; }
                l[qt] = l[qt] * alpha + rs;
#pragma unroll
                for (int dt = 0; dt < 4; ++dt) O[qt][dt] *= alpha;
            }
            nsa_pv(c, cur, s, O);
        }
        if (tile < tile_hi) nsa_lstore(c, KVARGS, c.lds + ((tile - tile_lo + 1) & 1) * 16384);
        __syncthreads();
    }
}
template <bool NORM, int MODE>
__device__ __forceinline__ void nsa_accum(const NsaCtx& c, const float (&gate)[2], const float (&l)[2], const f32x4 (&O)[2][4], bf16_t* const (&yrow)[2]) {
#pragma unroll
    for (int qt = 0; qt < 2; ++qt) {
        float inv = 1.0f;
        if (NORM) { const float lt = xsum16_32(l[qt]); inv = (lt > 0.f) ? 1.0f / lt : 0.f; }
        inv *= gate[qt];
        float* acc = (float*)(c.lds + 32768) + (c.wave * 32 + qt * 16 + c.li) * 64 + 4 * c.fq;
#pragma unroll
        for (int dt = 0; dt < 4; ++dt) {
            f32x4 v = O[qt][dt] * inv;
            if (MODE >= 1) v += *(const f32x4*)(acc + dt * 16);
            if (MODE <= 1) *(f32x4*)(acc + dt * 16) = v;
            else { uint2 w; w.x = cvtpk(v[0], v[1]); w.y = cvtpk(v[2], v[3]); *(uint2*)(yrow[qt] + dt * 16) = w; }
        }
    }
}

__device__ __forceinline__ void ph_nsa_fast(const Params& p, float* sm, int bid, int nb) {
    NsaCtx c;
    c.lds = (char*)sm; c.tid = threadIdx.x; c.lane = c.tid & 63; c.wave = c.tid >> 6; c.fr = c.lane & 15; c.fq = c.lane >> 4; c.li = c.lane & 15;
    float* impA = (float*)(c.lds + 32768); float* impE = (float*)(c.lds + 49152); unsigned* selm = (unsigned*)(c.lds + 49152);
    int* wq = (int*)sm + 16384 + 300;
    for (;;) {
        __syncthreads();
        if (c.tid == 0) *wq = atomicAdd(p.CNT + 256, 1);
        __syncthreads();
        const int u = *wq;
        if (u >= 1024) break;
        const int tt = 255 - (u >> 2), b = (u >> 1) & 1, g = u & 1, t0 = tt * 32;
        const int head = c.li & 3;
#pragma unroll
        for (int qt = 0; qt < 2; ++qt) {
            c.tq[qt] = t0 + c.wave * 8 + qt * 4 + (c.li >> 2);
            const bf16_t* qrow = p.Qb + (size_t)(b * S + c.tq[qt]) * 512 + (g * 4 + head) * 64 + 8 * c.fq;
            c.qf[qt][0] = *(const s16x8*)qrow; c.qf[qt][1] = *(const s16x8*)(qrow + 32);
        }
        unsigned selw[2][4];
        float gt0[2], gt1[2], gt2[2];
        bf16_t* yrow[2];
#pragma unroll
        for (int qt = 0; qt < 2; ++qt) {
#pragma unroll
            for (int w = 0; w < 4; ++w) selw[qt][w] = 0u;
            const float* gp = p.GT + (size_t)(b * S + c.tq[qt]) * 24 + (g * 4 + head) * 3;
            gt0[qt] = gp[0]; gt1[qt] = gp[1]; gt2[qt] = gp[2];
            yrow[qt] = p.YBb + (size_t)(b * S + c.tq[qt]) * 512 + (g * 4 + head) * 64 + 4 * c.fq;
        }
        f32x4 Oc[2][4];
#if 1
        {
            const bf16_t* Kg = p.KCb + (size_t)((b * 2 + g) * 512) * 64; const bf16_t* Vg = p.VCb + (size_t)((b * 2 + g) * 512) * 64;
            const int tl = t0 + 31; const int nvmax = (tl >= 31) ? ((tl - 31) >> 4) + 1 : 0; const int ntile = (nvmax + 63) >> 6;
            float m[2] = {-1e30f, -1e30f}, l[2] = {0.f, 0.f};
#pragma unroll
            for (int qt = 0; qt < 2; ++qt)
#pragma unroll
                for (int dt = 0; dt < 4; ++dt) Oc[qt][dt] = (f32x4){0.f, 0.f, 0.f, 0.f};
            __syncthreads();
            for (int i = c.tid; i < 32 * 128; i += NT) { impA[i] = 0.f; impE[i] = 0.f; }
            KVREGS;
            for (int pass = 0; pass < 2; ++pass) {
                float linv[2] = {0.f, 0.f};
                if (pass == 1) {
#pragma unroll
                    for (int qt = 0; qt < 2; ++qt) { const float lt = xsum16_32(l[qt]); linv[qt] = (lt > 0.f) ? 1.0f / lt : 0.f; }
                }
                if (ntile > 0) {
                    __syncthreads();
                    nsa_gload(c, KVARGS, Kg, Vg, 64, 0); nsa_lstore(c, KVARGS, c.lds); __syncthreads();
                    for (int tile = 0; tile < ntile; ++tile) {
                        char* cur = c.lds + (tile & 1) * 16384;
                        if (tile + 1 < ntile) nsa_gload(c, KVARGS, Kg, Vg, 64, tile + 1);
                        __builtin_amdgcn_sched_barrier(0);
                        f32x4 s[2][4];
                        nsa_qk(c, cur, s);
#pragma unroll
                        for (int qt = 0; qt < 2; ++qt) {
                            const int t = c.tq[qt];
                            if (pass == 0) {
                                float tmax = -1e30f;
#pragma unroll
                                for (int kt = 0; kt < 4; ++kt)
#pragma unroll
                                    for (int r = 0; r < 4; ++r) { const int cc = tile * 64 + kt * 16 + 4 * c.fq + r; const float v = (16 * cc + 31 <= t) ? s[qt][kt][r] : -1e30f; s[qt][kt][r] = v; tmax = fmaxf(tmax, v); }
                                tmax = xmax16_32(tmax);
                                const float mn = fmaxf(m[qt], tmax); const float alpha = fast_exp2(m[qt] - mn); m[qt] = mn;
                                float rs = 0.f;
#pragma unroll
                                for (int kt = 0; kt < 4; ++kt)
#pragma unroll
                                    for (int r = 0; r < 4; ++r) { const float v = s[qt][kt][r]; rs += (v > -1e29f) ? fast_exp2(v - mn) : 0.f; }
                                l[qt] = l[qt] * alpha + rs;
                            } else {
#pragma unroll
                                for (int kt = 0; kt < 4; ++kt) {
#pragma unroll
                                    for (int r = 0; r < 4; ++r) { const int cc = tile * 64 + kt * 16 + 4 * c.fq + r; s[qt][kt][r] = (16 * cc + 31 <= t) ? fast_exp2(s[qt][kt][r] - m[qt]) * linv[qt] : 0.f; }
                                    float e = s[qt][kt][3];
                                    float a = 2.0f * ((s[qt][kt][0] + s[qt][kt][1]) + (s[qt][kt][2] + e)) - e;
                                    a += __shfl_xor(a, 1); a += __shfl_xor(a, 2); e += __shfl_xor(e, 1); e += __shfl_xor(e, 2);
                                    if (head == 0) { const int j = tile * 16 + kt * 4 + c.fq; const int tokl = c.wave * 8 + qt * 4 + (c.li >> 2); impA[tokl * 128 + j] = a; impE[tokl * 128 + j] = e; }
                                }
                            }
                        }
                        if (pass == 1) nsa_pv(c, cur, s, Oc);
                        if (tile + 1 < ntile) nsa_lstore(c, KVARGS, c.lds + ((tile + 1) & 1) * 16384);
                        __syncthreads();
                    }
                }
            }
        }
#endif
#if 1
        {
            __syncthreads();
            float scv[16];
#pragma unroll
            for (int i = 0; i < 16; ++i) {
                const int e = c.tid + 256 * i, tok = e >> 7, j = e & 127; const int t = t0 + tok, cur = t >> 6;
                const bool valid = (j <= cur), forced = (j == 0) || (j == cur) || (j == cur - 1);
                scv[i] = valid ? (impA[e] + ((j > 0) ? impE[e - 1] : 0.f) + (forced ? 1e4f : 0.f)) : -1.0f;
            }
            __syncthreads();
#pragma unroll
            for (int i = 0; i < 16; ++i) impA[c.tid + 256 * i] = scv[i];
            __syncthreads();
#pragma unroll 1
            for (int i = 0; i < 16; ++i) {
                const int e = c.tid + 256 * i, tok = e >> 7, j = e & 127;
                const float my = impA[e];
                int rank = 0;
                const float* row = impA + tok * 128;
                for (int jj = 0; jj < 128; jj += 4) {
                    const float4 o = *(const float4*)(row + jj);
                    rank += (o.x > my || (o.x == my && jj < j)) ? 1 : 0;
                    rank += (o.y > my || (o.y == my && jj + 1 < j)) ? 1 : 0;
                    rank += (o.z > my || (o.z == my && jj + 2 < j)) ? 1 : 0;
                    rank += (o.w > my || (o.w == my && jj + 3 < j)) ? 1 : 0;
                }
                const unsigned long long mk = __ballot(rank < 16 && my >= 0.f);
                if (c.lane == 0) { selm[tok * 4 + (c.wave & 1) * 2] = (unsigned)mk; selm[tok * 4 + (c.wave & 1) * 2 + 1] = (unsigned)(mk >> 32); }
            }
            __syncthreads();
#pragma unroll
            for (int qt = 0; qt < 2; ++qt) {
                const int tokl = c.wave * 8 + qt * 4 + (c.li >> 2);
#pragma unroll
                for (int w = 0; w < 4; ++w) selw[qt][w] = selm[tokl * 4 + w];
            }
            __syncthreads();
            { const float dummy[2] = {0.f, 0.f}; nsa_accum<false, 0>(c, gt0, dummy, Oc, yrow); }
        }
#endif
#if 1
        {
            float m[2] = {-1e30f, -1e30f}, l[2] = {0.f, 0.f};
            f32x4 O[2][4];
#pragma unroll
            for (int qt = 0; qt < 2; ++qt)
#pragma unroll
                for (int dt = 0; dt < 4; ++dt) O[qt][dt] = (f32x4){0.f, 0.f, 0.f, 0.f};
            nsa_flash<1>(c, p.KSb + (size_t)(b * S) * 128 + g * 64, p.VSb + (size_t)(b * S) * 128 + g * 64, 128, 0, (t0 + 31) >> 6, selw, m, l, O);
            nsa_accum<true, 1>(c, gt1, l, O, yrow);
        }
#endif
#if 1
        {
            float m[2] = {-1e30f, -1e30f}, l[2] = {0.f, 0.f};
            f32x4 O[2][4];
#pragma unroll
            for (int qt = 0; qt < 2; ++qt)
#pragma unroll
                for (int dt = 0; dt < 4; ++dt) O[qt][dt] = (f32x4){0.f, 0.f, 0.f, 0.f};
            const int lo = (t0 >= 511) ? ((t0 - 511) >> 6) : 0;
            nsa_flash<2>(c, p.KWb + (size_t)(b * S) * 128 + g * 64, p.VWb + (size_t)(b * S) * 128 + g * 64, 128, lo, (t0 + 31) >> 6, selw, m, l, O);
            nsa_accum<true, 2>(c, gt2, l, O, yrow);
        }
#endif
    }
}
__device__ __forceinline__ void ph_branch_a(const Params& p, float* sm, int bid, int nb) {
    const bf16_t* P = p.P; float* Z = p.Z; const bf16_t* YA = p.YAb;
    XCD_TILE_LOOP(T / 128, D / 128) {
        const int m0 = tm_ * 128, n0 = tn_ * 128;
        auto ar = [&](int r) { return (const void*)(YA + (size_t)(m0 + r) * 512); };
        auto bc = [&](int c) { return n0 + c; };
        auto ep = [&](int m, int n, f32x4 v) {
            const size_t r = m0 + m; const int c = n0 + n;
            const uint2 gw = *(const uint2*)(P + r * INW + C_GA + c); const f32x4 gq = {bf2f(gw.x & 0xffff), bf2f(gw.x >> 16), bf2f(gw.y & 0xffff), bf2f(gw.y >> 16)};
            f32x4 o;
#pragma unroll
            for (int j = 0; j < 4; ++j) o[j] = sigmoidf_(gq[j]) * v[j];
            *(f32x4*)(Z + r * D + c) = o;
        };
        mgemm_unit<false, false>((char*)sm, 512, ar, p.WBAb, D, bc, ep);
    }
}
__device__ __forceinline__ void ph_branch_b(const Params& p, float* sm, int bid, int nb) {
    const bf16_t* P = p.P; float* Z = p.Z; const bf16_t* YB = p.YBb; bf16_t* Zb = p.Zb;
    XCD_TILE_LOOP(T / 128, D / 128) {
        const int m0 = tm_ * 128, n0 = tn_ * 128;
        auto ar = [&](int r) { return (const void*)(YB + (size_t)(m0 + r) * 512); };
        auto bc = [&](int c) { return n0 + c; };
        auto ep = [&](int m, int n, f32x4 v) {
            const size_t r = m0 + m; const int c = n0 + n;
            const uint2 gw = *(const uint2*)(P + r * INW + C_GB + c); const f32x4 gq = {bf2f(gw.x & 0xffff), bf2f(gw.x >> 16), bf2f(gw.y & 0xffff), bf2f(gw.y >> 16)};
            f32x4 o = *(const f32x4*)(Z + r * D + c);
#pragma unroll
            for (int j = 0; j < 4; ++j) o[j] += sigmoidf_(gq[j]) * v[j];
            uint2 w; w.x = cvtpk(o[0], o[1]); w.y = cvtpk(o[2], o[3]);
            *(uint2*)(Zb + r * D + c) = w;
        };
        mgemm_unit<false, false>((char*)sm, 512, ar, p.WBBb, D, bc, ep);
    }
}
__device__ __forceinline__ void ph_outproj(const Params& p, float* sm, int bid, int nb) {
    const float* x = p.x; float* PRE1 = p.PRE1; const bf16_t* Z = p.Zb;
    XCD_TILE_LOOP(T / 128, D / 128) {
        const int m0 = tm_ * 128, n0 = tn_ * 128;
        auto ar = [&](int r) { return (const void*)(Z + (size_t)(m0 + r) * D); };
        auto bc = [&](int c) { return n0 + c; };
        auto ep = [&](int m, int n, f32x4 v) {
            const size_t r = m0 + m; const int c = n0 + n;
            const f32x4 xv = *(const f32x4*)(x + r * D + c);
            *(f32x4*)(PRE1 + r * D + c) = xv * ALPHA + v;
        };
        mgemm_unit<false, false>((char*)sm, D, ar, p.WOUTb, D, bc, ep);
    }
}
__device__ __forceinline__ void ln_rows(float* sm, int bid, int nb, const float* src, float* dst, unsigned short* dstb, const float* gam, const float* bet) {
    const int tid = threadIdx.x, wave = tid >> 6, lane = tid & 63;
    for (int t = bid; t < T; t += nb) {
        const float4 v = *(const float4*)(src + (size_t)t * D + tid * 4);
        float s = (v.x + v.y) + (v.z + v.w);
        s = wave_sum(s);
        __syncthreads();
        if (lane == 0) sm[wave] = s;
        __syncthreads();
        const float mean = (sm[0] + sm[1] + sm[2] + sm[3]) * (1.0f / D);
        const float dx = v.x - mean, dy = v.y - mean, dz = v.z - mean, dw = v.w - mean;
        float q = (dx * dx + dy * dy) + (dz * dz + dw * dw);
        q = wave_sum(q);
        __syncthreads();
        if (lane == 0) sm[wave] = q;
        __syncthreads();
        const float rstd = rsqrtf((sm[0] + sm[1] + sm[2] + sm[3]) * (1.0f / D) + 1e-5f);
        const float4 gq = *(const float4*)(gam + tid * 4), bq = *(const float4*)(bet + tid * 4);
        const float4 o = make_float4(dx * rstd * gq.x + bq.x, dy * rstd * gq.y + bq.y, dz * rstd * gq.z + bq.z, dw * rstd * gq.w + bq.w);
        *(float4*)(dst + (size_t)t * D + tid * 4) = o;
        uint2 w; w.x = cvtpk(o.x, o.y); w.y = cvtpk(o.z, o.w);
        *(uint2*)(dstb + (size_t)t * D + tid * 4) = w;
    }
}
__device__ __forceinline__ void ph_ln1(const Params& p, float* sm, int bid, int nb) { ln_rows(sm, bid, nb, p.PRE1, p.X1, p.X1b, p.ln1g, p.ln1b); }

__device__ __forceinline__ void ph_router_gemm(const Params& p, float* sm, int bid, int nb) {
    float* L = p.LOGITS; const bf16_t* X1 = p.X1b;
    XCD_TILE_LOOP(T / 128, 2) {
        const int m0 = tm_ * 128, n0 = tn_ * 128;
        auto ar = [&](int r) { return (const void*)(X1 + (size_t)(m0 + r) * D); };
        auto bc = [&](int c) { return n0 + c; };
        auto ep = [&](int m, int n, f32x4 v) { *(f32x4*)(L + (size_t)(m0 + m) * NE + n0 + n) = v; };
        mgemm_unit<false, false>((char*)sm, D, ar, p.RWb, NE, bc, ep);
    }
}
__device__ __forceinline__ void ph_router_sel(const Params& p, float* sm, int bid, int nb) {
    const int tid = threadIdx.x, lane = tid & 63, wave = tid >> 6;
    const float4 bias4 = *(const float4*)(p.rbias + lane * 4);
    for (int t = bid * 4 + wave; t < T; t += nb * 4) {
        const float4 lg = *(const float4*)(p.LOGITS + (size_t)t * NE + lane * 4);
        float sc[4] = {sigmoidf_(lg.x), sigmoidf_(lg.y), sigmoidf_(lg.z), sigmoidf_(lg.w)};
        float ch[4] = {sc[0] + bias4.x, sc[1] + bias4.y, sc[2] + bias4.z, sc[3] + bias4.w};
        float m1 = fmaxf(fmaxf(ch[0], ch[1]), fmaxf(ch[2], ch[3]));
        float m2;
        {
            const float a = fmaxf(ch[0], ch[1]), b = fminf(ch[0], ch[1]), c = fmaxf(ch[2], ch[3]), d = fminf(ch[2], ch[3]);
            m2 = fmaxf(fminf(a, c), fmaxf(b, d));
        }
#pragma unroll
        for (int o = 1; o < 8; o <<= 1) {
            const float o1 = __shfl_xor(m1, o), o2 = __shfl_xor(m2, o);
            const float n1 = fmaxf(m1, o1), n2 = fmaxf(fminf(m1, o1), fmaxf(m2, o2));
            m1 = n1; m2 = n2;
        }
        const float gs = m1 + m2;
        const int grp = lane >> 3;
        int grank = 0;
#pragma unroll
        for (int g = 0; g < 8; ++g) { const float og = __shfl(gs, g * 8); grank += (og > gs || (og == gs && g < grp)) ? 1 : 0; }
        const bool gsel = grank < 4;
        float mc[4];
#pragma unroll
        for (int j = 0; j < 4; ++j) mc[j] = gsel ? ch[j] : -1e30f;
        int myk = -1; float mysc = 0.f, wsum = 0.f;
#pragma unroll 1
        for (int k = 0; k < 8; ++k) {
            float bv = mc[0]; int bi = lane * 4;
#pragma unroll
            for (int j = 1; j < 4; ++j) if (mc[j] > bv) { bv = mc[j]; bi = lane * 4 + j; }
#pragma unroll
            for (int o = 1; o < 64; o <<= 1) {
                const float ov = __shfl_xor(bv, o); const int oi = __shfl_xor(bi, o);
                if (ov > bv || (ov == bv && oi < bi)) { bv = ov; bi = oi; }
            }
            const int own = bi >> 2, jj = bi & 3;
            const float wsc = __shfl((jj == 0) ? sc[0] : (jj == 1) ? sc[1] : (jj == 2) ? sc[2] : sc[3], own);
            if (lane == own) { if (jj == 0) mc[0] = -3e38f; else if (jj == 1) mc[1] = -3e38f; else if (jj == 2) mc[2] = -3e38f; else mc[3] = -3e38f; }
            if (lane == k) { myk = bi; mysc = wsc; }
            wsum += wsc;
        }
        if (lane < 8) {
            const int a = t * 8 + lane;
            p.EIDX[a] = myk;
            p.EW[a] = mysc / wsum * 2.5f;
            const int pos = atomicAdd(p.CNT + myk, 1);
            if (pos < LISTCAP) p.LIST[(size_t)myk * LISTCAP + pos] = a;
        }
    }
}
__device__ __forceinline__ int moe_tile_prefix(const Params& p, int* pre) {
    const int tid = threadIdx.x;
    __syncthreads();
    int c = __hip_atomic_load(p.CNT + tid, __ATOMIC_RELAXED, __HIP_MEMORY_SCOPE_AGENT); if (c > LISTCAP) c = LISTCAP;
    pre[tid + 1] = (c + 127) >> 7;
    if (tid == 0) pre[0] = 0;
    __syncthreads();
    if (tid == 0) { int a = 0; for (int i = 1; i <= 256; ++i) { a += pre[i]; pre[i] = a; } }
    __syncthreads();
    return pre[256];
}
__device__ __forceinline__ int moe_find_expert(const int* pre, int tile) {
    int lo = 0, hi = 255;
    while (lo < hi) { const int mid = (lo + hi + 1) >> 1; if (pre[mid] <= tile) lo = mid; else hi = mid - 1; }
    return lo;
}
__device__ __forceinline__ int glu_col(int j0, int c) { const int wn = c >> 6, ni = (c >> 4) & 3, x = c & 15; return ((ni >> 1) ? 256 : 0) + j0 + wn * 32 + (ni & 1) * 16 + x; }
__device__ __forceinline__ void ph_moe_gu(const Params& p, float* sm, int bid, int nb) {
    int* pre = (int*)sm + 16384;
    const int ntile = moe_tile_prefix(p, pre);
    for (int u = bid; u < ntile * 4; u += nb) {
        const int tile = u >> 2, j0 = (u & 3) * 64;
        const int e = moe_find_expert(pre, tile), mt = tile - pre[e];
        int cnt = __hip_atomic_load(p.CNT + e, __ATOMIC_RELAXED, __HIP_MEMORY_SCOPE_AGENT); if (cnt > LISTCAP) cnt = LISTCAP;
        const int* lst = p.LIST + (size_t)e * LISTCAP + mt * 128;
        const int nrow = cnt - mt * 128;
        const bf16_t* X1 = p.X1b; bf16_t* ACT = p.ACT;
        auto ar = [&](int r) { return (const void*)(X1 + (size_t)(lst[r < nrow ? r : 0] >> 3) * D); };
        auto bc = [&](int c) { return glu_col(j0, c); };
        auto ep = [&](int m, int n, f32x4 v) { if (m < nrow) { const int a = lst[m]; uint2 w; w.x = cvtpk(v[0], v[1]); w.y = cvtpk(v[2], v[3]); *(uint2*)(ACT + (size_t)a * 256 + j0 + n) = w; } };
        mgemm_unit<true, true>((char*)sm, D, ar, p.egu + (size_t)e * D * 512, 512, bc, ep);
    }
}
__device__ __forceinline__ void ph_moe_down(const Params& p, float* sm, int bid, int nb) {
    int* pre = (int*)sm + 16384;
    const int ntile = moe_tile_prefix(p, pre);
    for (int u = bid; u < ntile * 8; u += nb) {
        const int tile = u >> 3, n0 = (u & 7) * 128;
        const int e = moe_find_expert(pre, tile), mt = tile - pre[e];
        int cnt = __hip_atomic_load(p.CNT + e, __ATOMIC_RELAXED, __HIP_MEMORY_SCOPE_AGENT); if (cnt > LISTCAP) cnt = LISTCAP;
        const int* lst = p.LIST + (size_t)e * LISTCAP + mt * 128;
        const int nrow = cnt - mt * 128;
        const bf16_t* ACT = p.ACT; bf16_t* Y = p.Y; const float* EW = p.EW;
        auto ar = [&](int r) { return (const void*)(ACT + (size_t)lst[r < nrow ? r : 0] * 256); };
        auto bc = [&](int c) { return n0 + c; };
        auto ep = [&](int m, int n, f32x4 v) { if (m < nrow) { const int a = lst[m]; const float w = EW[a]; uint2 o; o.x = cvtpk(v[0] * w, v[1] * w); o.y = cvtpk(v[2] * w, v[3] * w); *(uint2*)(Y + (size_t)a * D + n0 + n) = o; } };
        mgemm_unit<true, false>((char*)sm, 256, ar, p.edown + (size_t)e * 256 * D, D, bc, ep);
    }
}
__device__ __forceinline__ void ph_shared_gu(const Params& p, float* sm, int bid, int nb) {
    const bf16_t* X1 = p.X1b; bf16_t* ACTS = p.ACTS;
    XCD_TILE_LOOP(T / 128, 4) {
        const int m0 = tm_ * 128, j0 = tn_ * 64;
        auto ar = [&](int r) { return (const void*)(X1 + (size_t)(m0 + r) * D); };
        auto bc = [&](int c) { return glu_col(j0, c); };
        auto ep = [&](int m, int n, f32x4 v) { uint2 w; w.x = cvtpk(v[0], v[1]); w.y = cvtpk(v[2], v[3]); *(uint2*)(ACTS + (size_t)(m0 + m) * 256 + j0 + n) = w; };
        mgemm_unit<false, true>((char*)sm, D, ar, p.SGUb, 512, bc, ep);
    }
}
__device__ __forceinline__ void ph_shared_down(const Params& p, float* sm, int bid, int nb) {
    const bf16_t* ACTS = p.ACTS; float* SH = p.SH;
    XCD_TILE_LOOP(T / 128, 8) {
        const int m0 = tm_ * 128, n0 = tn_ * 128;
        auto ar = [&](int r) { return (const void*)(ACTS + (size_t)(m0 + r) * 256); };
        auto bc = [&](int c) { return n0 + c; };
        auto ep = [&](int m, int n, f32x4 v) { *(f32x4*)(SH + (size_t)(m0 + m) * D + n0 + n) = v; };
        mgemm_unit<false, false>((char*)sm, 256, ar, p.SDOWNb, D, bc, ep);
    }
}
__device__ __forceinline__ void ph_final(const Params& p, float* sm, int bid, int nb) {
    const int tid = threadIdx.x, wave = tid >> 6, lane = tid & 63;
    for (int t = bid; t < T; t += nb) {
        const float4 xv = *(const float4*)(p.X1 + (size_t)t * D + tid * 4);
        float4 v = *(const float4*)(p.SH + (size_t)t * D + tid * 4);
        float4 r = make_float4(0.f, 0.f, 0.f, 0.f);
#pragma unroll
        for (int k = 0; k < 8; ++k) { const uint2 y = *(const uint2*)(p.Y + ((size_t)t * 8 + k) * D + tid * 4); r.x += bf2f(y.x & 0xffff); r.y += bf2f(y.x >> 16); r.z += bf2f(y.y & 0xffff); r.w += bf2f(y.y >> 16); }
        v.x = ALPHA * xv.x + (r.x + v.x); v.y = ALPHA * xv.y + (r.y + v.y); v.z = ALPHA * xv.z + (r.z + v.z); v.w = ALPHA * xv.w + (r.w + v.w);
        float s = (v.x + v.y) + (v.z + v.w);
        s = wave_sum(s);
        __syncthreads();
        if (lane == 0) sm[wave] = s;
        __syncthreads();
        const float mean = (sm[0] + sm[1] + sm[2] + sm[3]) * (1.0f / D);
        const float dx = v.x - mean, dy = v.y - mean, dz = v.z - mean, dw = v.w - mean;
        float q = (dx * dx + dy * dy) + (dz * dz + dw * dw);
        q = wave_sum(q);
        __syncthreads();
        if (lane == 0) sm[wave] = q;
        __syncthreads();
        const float rstd = rsqrtf((sm[0] + sm[1] + sm[2] + sm[3]) * (1.0f / D) + 1e-5f);
        const float4 gq = *(const float4*)(p.ln2g + tid * 4), bq = *(const float4*)(p.ln2b + tid * 4);
        *(float4*)(p.out + (size_t)t * D + tid * 4) = make_float4(dx * rstd * gq.x + bq.x, dy * rstd * gq.y + bq.y, dz * rstd * gq.z + bq.z, dw * rstd * gq.w + bq.w);
    }
}

constexpr int SM_FLOATS = 16384 + 512;

#define DEF_KERNEL(name) \
    __global__ void __launch_bounds__(NT) k_##name(Params p) { __shared__ __attribute__((aligned(16))) float sm[SM_FLOATS]; ph_##name(p, sm, (int)blockIdx.x, (int)gridDim.x); }


#define XB_TMO      128
#define XB_XCNT(j)  (256  + 64 * (j))
#define XB_XSUB(j)  (1280 + 64 * (j))
#define XB_XGEN(j)  (2304 + 64 * (j))
#define XB_TOP      3328
#define XB_TOPGEN   3392
#define XCD_BAR_WORDS 3456
#define XB_SPIN_CAP (1u << 18)
__device__ __forceinline__ unsigned xb_ld(unsigned* p)              { return __hip_atomic_load(p, __ATOMIC_RELAXED, __HIP_MEMORY_SCOPE_AGENT); }
__device__ __forceinline__ unsigned xb_add(unsigned* p, unsigned v) { return __hip_atomic_fetch_add(p, v, __ATOMIC_RELAXED, __HIP_MEMORY_SCOPE_AGENT); }
__device__ __forceinline__ unsigned xb_xcc_id() { return (unsigned)__builtin_amdgcn_s_getreg((3 << 11) | 20) & 0xFu; }
#define XB_SPIN(cond, bar) do { unsigned _sp = 0; while (cond) { __builtin_amdgcn_s_sleep(1); \
    if ((++_sp & 255u) == 0u) { if (xb_ld(&(bar)[XB_TMO])) break; if (_sp > XB_SPIN_CAP) { atomicAdd(&(bar)[XB_TMO], 1u); break; } } } } while (0)
struct XcdBarrier { unsigned* bar; unsigned x; volatile LAS unsigned* st; };
__device__ __forceinline__ XcdBarrier xcd_barrier_post(unsigned* bar, volatile LAS unsigned* st) {
    XcdBarrier b; b.bar = bar; b.x = xb_xcc_id(); b.st = st;
    if (threadIdx.x == 0) (void)xb_add(&bar[XB_XCNT(b.x)], 1u);
    return b;
}
__device__ __forceinline__ void xcd_barrier_complete(unsigned* bar, unsigned x, unsigned& nloc, unsigned& nx) {
    const unsigned G = gridDim.x * gridDim.y * gridDim.z;
    unsigned sum, cnt, mine, sp = 0u;
    for (;;) {
        sum = 0u; cnt = 0u; mine = 0u;
#pragma unroll
        for (unsigned j = 0; j < 16; ++j) { const unsigned c = xb_ld(&bar[XB_XCNT(j)]); sum += c; cnt += (c > 0u) ? 1u : 0u; mine = (j == x) ? c : mine; }
        if (sum == G) break;
        __builtin_amdgcn_s_sleep(1);
        if ((++sp & 255u) == 0u) { if (xb_ld(&bar[XB_TMO])) break; if (sp > XB_SPIN_CAP) { atomicAdd(&bar[XB_TMO], 1u); break; } }
    }
    nloc = mine > 0u ? mine : 1u; nx = cnt > 0u ? cnt : 1u;
}
__device__ __forceinline__ void xcd_barrier(const XcdBarrier& b) {
    asm volatile("s_waitcnt vmcnt(0)" ::: "memory");
    __syncthreads();
    if (threadIdx.x == 0) {
        unsigned* bar = b.bar;
        __builtin_amdgcn_s_waitcnt(0);
        unsigned nloc = b.st[0], nx = b.st[1];
        if (nloc == 0u) { xcd_barrier_complete(bar, b.x, nloc, nx); b.st[0] = nloc; b.st[1] = nx; }
        const unsigned old = xb_add(&bar[XB_XSUB(b.x)], 1u);
        const unsigned gen = old / nloc;
        if (old + 1u == (gen + 1u) * nloc) {
            __builtin_amdgcn_fence(__ATOMIC_RELEASE, "agent");
            asm volatile("s_waitcnt vmcnt(0)" ::: "memory");
            const unsigned og = xb_add(&bar[XB_TOP], 1u);
            const unsigned tg = og / nx;
            if (og + 1u == (tg + 1u) * nx) xb_add(&bar[XB_TOPGEN], 1u);
            else XB_SPIN(xb_ld(&bar[XB_TOPGEN]) == tg, bar);
            __builtin_amdgcn_fence(__ATOMIC_ACQUIRE, "agent");
            xb_add(&bar[XB_XGEN(b.x)], 1u);
            asm volatile("s_waitcnt vmcnt(0)" ::: "memory");
        } else {
            XB_SPIN(xb_ld(&bar[XB_XGEN(b.x)]) == gen, bar);
            __builtin_amdgcn_fence(__ATOMIC_ACQUIRE, "agent");
            asm volatile("s_waitcnt vmcnt(0)" ::: "memory");
        }
    }
    __syncthreads();
}

namespace cg = cooperative_groups;
__global__ void __launch_bounds__(NT, 2) mega(Params p) {
    __shared__ __attribute__((aligned(16))) float sm[SM_FLOATS];
    __shared__ __attribute__((aligned(16))) unsigned bar_st[4];
    cg::grid_group grid = cg::this_grid();
    if (threadIdx.x < 4) bar_st[threadIdx.x] = 0u;
    __syncthreads();
    const XcdBarrier xbar = xcd_barrier_post(p.BAR, (volatile LAS unsigned*)bar_st);
#define GSYNC() xcd_barrier(xbar)
    const int bid = (int)blockIdx.x, nb = (int)gridDim.x;
#ifndef PROBE_REP
#define PROBE_REP 0
#endif
#define GROUP(k, ...) { __VA_ARGS__ } if (PROBE_REP == (k)) { __VA_ARGS__ }
    GROUP(1, ph_cvt_x(p, sm, bid, nb); grid.sync(); ph_inproj(p, sm, bid, nb); GSYNC();)
    GROUP(2, ph_prep(p, sm, bid, nb); GSYNC();
             ph_prep_gemm(p, sm, bid, nb); GSYNC();
             ph_cmp2(p, sm, bid, nb); ph_scan_pre(p, sm, bid, nb); GSYNC();
             ph_cmp_rope(p, sm, bid, nb); GSYNC();)
    GROUP(3, if (bid < 16) ph_scan_seq(p, sm, bid, 16); else ph_nsa_fast(p, sm, bid - 16, nb - 16);
             GSYNC();)
    GROUP(4, ph_rwkv_post(p, sm, bid, nb); GSYNC();
             ph_branch_a(p, sm, bid, nb); ph_branch_b(p, sm, bid, nb); GSYNC();
             ph_outproj(p, sm, bid, nb); GSYNC();
             ph_ln1(p, sm, bid, nb); GSYNC();)
    GROUP(5, ph_router_gemm(p, sm, bid, nb); ph_shared_gu(p, sm, bid, nb); GSYNC();
             ph_router_sel(p, sm, bid, nb); ph_shared_down(p, sm, bid, nb); GSYNC();)
    GROUP(6, ph_moe_gu(p, sm, bid, nb); GSYNC();
             ph_moe_down(p, sm, bid, nb); GSYNC();)
    ph_final(p, sm, bid, nb);
}
}

extern "C" void kernel_launch(void* const* d_in, const int* in_sizes, int n_in, void* d_out, int out_size, void* d_ws, size_t ws_size, hipStream_t stream) {
    Params p{};
    const float* const* in = (const float* const*)d_in;
    p.x = in[0]; p.w_in = in[1]; p.mu = in[2]; p.w0 = in[3]; p.w2 = in[4]; p.a0 = in[5]; p.a2 = in[6]; p.g2 = in[7]; p.k_k = in[8]; p.k_a = in[9];
    p.r_k = in[10]; p.lnx_w = in[11]; p.lnx_b = in[12]; p.pe_k = in[13]; p.w1_k = in[14]; p.w2_k = in[15]; p.pe_v = in[16]; p.w1_v = in[17]; p.w2_v = in[18];
    p.wba = in[19]; p.wbb = in[20]; p.wout = in[21]; p.ln1g = in[22]; p.ln1b = in[23]; p.rw = in[24]; p.rbias = in[25]; p.egu = in[26]; p.edown = in[27];
    p.sgu = in[28]; p.sdown = in[29]; p.ln2g = in[30]; p.ln2b = in[31];
    p.out = (float*)d_out;
    char* w = (char*)d_ws; size_t off = 0;
    auto carve = [&](size_t bytes) { char* r = w + off; off += (bytes + 255) & ~(size_t)255; return r; };
    p.BAR = (unsigned*)carve(16384);
    p.P = (unsigned short*)carve((size_t)T * INW * 2);
    p.R = (float*)carve((size_t)T * 512 * 4); p.DC = (float*)carve((size_t)T * 512 * 4); p.K2 = (float*)carve((size_t)T * 512 * 4); p.V = (float*)carve((size_t)T * 512 * 4);
    p.KK = (float*)carve((size_t)T * 512 * 4); p.BB = (float*)carve((size_t)T * 512 * 4); p.G = (float*)carve((size_t)T * 512 * 4);
    p.O = (float*)carve((size_t)T * 512 * 4); p.YA = (float*)carve((size_t)T * 512 * 4);
    p.KCraw = (float*)carve((size_t)NCROWS * 64 * 4); p.KCR = (float*)carve((size_t)NCROWS * 64 * 4); p.VC = (float*)carve((size_t)NCROWS * 64 * 4);
    p.Z = (float*)carve((size_t)T * D * 4); p.PRE1 = (float*)carve((size_t)T * D * 4); p.X1 = (float*)carve((size_t)T * D * 4);
    p.LOGITS = (float*)carve((size_t)T * NE * 4); p.EW = (float*)carve((size_t)T * 8 * 4); p.EIDX = (int*)carve((size_t)T * 8 * 4);
    p.LIST = (int*)carve((size_t)NE * LISTCAP * 4); p.CNT = (int*)((char*)d_ws + 14336);
    p.Xb = (unsigned short*)carve((size_t)T * D * 2); p.YAb = (unsigned short*)carve((size_t)T * 512 * 2); p.YBb = (unsigned short*)carve((size_t)T * 512 * 2);
    p.Zb = (unsigned short*)carve((size_t)T * D * 2); p.X1b = (unsigned short*)carve((size_t)T * D * 2);
    p.Qb = (unsigned short*)carve((size_t)T * 512 * 2); p.KSb = (unsigned short*)carve((size_t)T * 128 * 2); p.VSb = (unsigned short*)carve((size_t)T * 128 * 2);
    p.KWb = (unsigned short*)carve((size_t)T * 128 * 2); p.VWb = (unsigned short*)carve((size_t)T * 128 * 2);
    p.KCb = (unsigned short*)carve((size_t)4 * 512 * 64 * 2); p.VCb = (unsigned short*)carve((size_t)4 * 512 * 64 * 2);
    p.GT = (float*)carve((size_t)T * 24 * 4);
    p.WINb = (unsigned short*)carve((size_t)D * INW * 2); p.WBAb = (unsigned short*)carve((size_t)512 * D * 2); p.WBBb = (unsigned short*)carve((size_t)512 * D * 2);
    p.WOUTb = (unsigned short*)carve((size_t)D * D * 2); p.RWb = (unsigned short*)carve((size_t)D * NE * 2); p.SGUb = (unsigned short*)carve((size_t)D * 512 * 2); p.SDOWNb = (unsigned short*)carve((size_t)256 * D * 2);
    p.W1Kb = (unsigned short*)carve((size_t)2048 * 256 * 2); p.W1Vb = (unsigned short*)carve((size_t)2048 * 256 * 2); p.W2Kb = (unsigned short*)carve((size_t)256 * 64 * 2); p.W2Vb = (unsigned short*)carve((size_t)256 * 64 * 2);
    p.LW2b = (unsigned short*)carve((size_t)64 * 512 * 2); p.LA2b = (unsigned short*)carve((size_t)64 * 512 * 2); p.LG2b = (unsigned short*)carve((size_t)128 * 512 * 2);
    p.LORA = (unsigned short*)carve((size_t)T * 256 * 2); p.KCin = (unsigned short*)carve((size_t)4 * S * 64 * 2 + 4096); p.VCin = (unsigned short*)carve((size_t)4 * S * 64 * 2 + 4096);
    p.H1Kb = (unsigned short*)carve((size_t)NCROWS * 256 * 2); p.H1Vb = (unsigned short*)carve((size_t)NCROWS * 256 * 2);
    p.TABC = (float*)carve((size_t)S * 32 * 4); p.TABS = (float*)carve((size_t)S * 32 * 4); p.CB = (float*)carve(2 * 256 * 4); p.KSH = (float*)carve((size_t)T * 512 * 4);
    p.SCANI = (char*)carve((size_t)8192 * SCI_BYTES);
    p.ACTS = (unsigned short*)carve((size_t)T * 256 * 2); p.SH = (float*)carve((size_t)T * D * 4);
    p.ACT = (unsigned short*)carve((size_t)T * 8 * 256 * 2);
    p.Y = (unsigned short*)carve((size_t)T * 8 * D * 2);
    if (off > ws_size) { fprintf(stderr, "kernel_launch: workspace too small: need %zu have %zu\n", off, ws_size); return; }
    static int grid_blocks = 0;
    if (!grid_blocks) {
        int dev = 0, cus = 0, per_cu = 0;
        hipGetDevice(&dev);
        hipDeviceGetAttribute(&cus, hipDeviceAttributeMultiprocessorCount, dev);
        hipOccupancyMaxActiveBlocksPerMultiprocessor(&per_cu, mega, NT, 0);
        if (per_cu > 2) per_cu = 2;
        if (per_cu < 1) per_cu = 1;
        grid_blocks = cus * per_cu;
    }
    hipMemsetAsync(d_ws, 0, 16384, stream);
    void* args[] = {&p};
    hipError_t e = hipLaunchCooperativeKernel((void*)mega, dim3(grid_blocks), dim3(NT), args, 0, stream);
    if (e != hipSuccess) fprintf(stderr, "cooperative launch failed: %s (grid %d)\n", hipGetErrorString(e), grid_blocks);
}
```

```cpp
#include <hip/hip_runtime.h>
#include <hip/hip_cooperative_groups.h>
#include <cstdio>
#include <cstdint>
#include <cmath>

namespace {

constexpr int NB = 2, S = 8192, T = NB * S, D = 1024, INW = 5144;
constexpr int C_R = 0, C_K = 512, C_V = 1024, C_WL = 1536, C_AL = 1600, C_GL = 1664, RW_IN = 1792;
constexpr int C_Q = 1792, C_KC = 2304, C_VC = 2432, C_KS = 2560, C_VS = 2688, C_KW = 2816, C_VW = 2944, C_GT = 3072;
constexpr int C_GA = 3096, C_GB = 4120;
constexpr int NCMP = 511, NCROWS = NB * NCMP * 2;
constexpr int NE = 256, TOPK = 8, LISTCAP = 16384;
constexpr float ALPHA = 1.189207115002721f;
constexpr float QSCALE = 0.125f * 1.4426950408889634f;
constexpr int NT = 256;

struct Params {
    const float *x, *w_in, *mu, *w0, *w2, *a0, *a2, *g2, *k_k, *k_a, *r_k, *lnx_w, *lnx_b;
    const float *pe_k, *w1_k, *w2_k, *pe_v, *w1_v, *w2_v, *wba, *wbb, *wout, *ln1g, *ln1b;
    const float *rw, *rbias, *egu, *edown, *sgu, *sdown, *ln2g, *ln2b;
    float* out;
    unsigned short* P;
    unsigned short *Rb, *Vb, *KSHb, *KKb, *EWXb, *K2b, *BBb, *Gb;
    float *R, *DC, *K2, *V, *KK, *BB, *G, *O, *YA, *QR, *KSR, *KWR, *KCraw, *KCR, *VC, *H1K, *H1V, *YB, *Z, *PRE1, *X1;
    float *LOGITS, *EW, *SH;
    unsigned short* Y;
    unsigned short *ACT, *ACTS, *Xb, *YAb, *YBb, *Zb, *X1b;
    unsigned short *Qb, *KSb, *VSb, *KWb, *VWb, *KCb, *VCb;
    float *GT, *OC, *OS, *OW, *OCf, *OSf, *OWf;
    unsigned *SELM, *SELMf;
    unsigned short *WINb, *WBAb, *WBBb, *WOUTb, *RWb, *SGUb, *SDOWNb, *W1Kb, *W1Vb, *W2Kb, *W2Vb, *LW2b, *LA2b, *LG2b;
    unsigned short *LORA, *KCin, *VCin, *H1Kb, *H1Vb;
    float *TABC, *TABS, *CB, *KSH;
    char* SCANI;
    int *EIDX, *LIST, *CNT;
    unsigned* BAR;
    int pad_[2];
};

__device__ __forceinline__ float wave_sum(float v) {
#pragma unroll
    for (int o = 1; o < 64; o <<= 1) v += __shfl_xor(v, o);
    return v;
}
__device__ __forceinline__ float wave_max(float v) {
#pragma unroll
    for (int o = 1; o < 64; o <<= 1) v = fmaxf(v, __shfl_xor(v, o));
    return v;
}
__device__ __forceinline__ float sigmoidf_(float x) { return 1.0f / (1.0f + expf(-x)); }
__device__ __forceinline__ float gelu_tanh(float x) { return 0.5f * x * (1.0f + tanhf(0.7978845608028654f * (x + 0.044715f * x * x * x))); }

template <class AL, class BL, class EP>
__device__ __forceinline__ void sgemm_unit(float* sm, int K, const AL& aload, const BL& bload, const EP& epi) {
    float (*As)[68] = (float (*)[68])sm;
    float (*Bs)[68] = (float (*)[68])(sm + 16 * 68);
    const int tid = threadIdx.x, ty = tid >> 4, tx = tid & 15;
    const int arow = tid >> 2, ak = (tid & 3) * 4, bk = tid >> 4, bn = (tid & 15) * 4;
    float acc[4][4];
#pragma unroll
    for (int i = 0; i < 4; ++i)
#pragma unroll
        for (int j = 0; j < 4; ++j) acc[i][j] = 0.f;
    for (int k0 = 0; k0 < K; k0 += 16) {
        const float4 av = aload(arow, k0 + ak);
        const float4 bv = bload(k0 + bk, bn);
        __syncthreads();
        As[ak + 0][arow] = av.x; As[ak + 1][arow] = av.y; As[ak + 2][arow] = av.z; As[ak + 3][arow] = av.w;
        *(float4*)&Bs[bk][bn] = bv;
        __syncthreads();
#pragma unroll
        for (int k = 0; k < 16; ++k) {
            const float4 a = *(const float4*)&As[k][ty * 4];
            const float4 b = *(const float4*)&Bs[k][tx * 4];
            acc[0][0] += a.x * b.x; acc[0][1] += a.x * b.y; acc[0][2] += a.x * b.z; acc[0][3] += a.x * b.w;
            acc[1][0] += a.y * b.x; acc[1][1] += a.y * b.y; acc[1][2] += a.y * b.z; acc[1][3] += a.y * b.w;
            acc[2][0] += a.z * b.x; acc[2][1] += a.z * b.y; acc[2][2] += a.z * b.z; acc[2][3] += a.z * b.w;
            acc[3][0] += a.w * b.x; acc[3][1] += a.w * b.y; acc[3][2] += a.w * b.z; acc[3][3] += a.w * b.w;
        }
    }
#pragma unroll
    for (int i = 0; i < 4; ++i) epi(ty * 4 + i, tx * 4, make_float4(acc[i][0], acc[i][1], acc[i][2], acc[i][3]));
}

template <class EP>
__device__ __forceinline__ void dense_gemm_phase(float* sm, int bid, int nb, const float* A, int lda, const float* B, int ldb, int M, int N, int K, const EP& epi) {
    const int ntn = (N + 63) / 64, nu = (M / 64) * ntn;
    for (int u = bid; u < nu; u += nb) {
        const int m0 = (u / ntn) * 64, n0 = (u % ntn) * 64;
        auto al = [&](int m, int k) { return *(const float4*)(A + (size_t)(m0 + m) * lda + k); };
        auto bl = [&](int k, int n) { return (n0 + n < N) ? *(const float4*)(B + (size_t)k * ldb + n0 + n) : make_float4(0.f, 0.f, 0.f, 0.f); };
        auto ep = [&](int m, int n, float4 v) { if (n0 + n < N) epi(m0 + m, n0 + n, v); };
        sgemm_unit(sm, K, al, bl, ep);
    }
}

typedef short s16x8 __attribute__((ext_vector_type(8)));
typedef short s16x4 __attribute__((ext_vector_type(4)));
typedef float f32x4 __attribute__((ext_vector_type(4)));
typedef float f32x2 __attribute__((ext_vector_type(2)));
typedef __bf16 bf16x2_t __attribute__((ext_vector_type(2)));
typedef unsigned short bf16_t;
#define LAS __attribute__((address_space(3)))
__device__ __forceinline__ unsigned cvtpk(float lo, float hi) { f32x2 v = {lo, hi}; bf16x2_t b = __builtin_convertvector(v, bf16x2_t); return __builtin_bit_cast(unsigned, b); }
__device__ __forceinline__ s16x4 packf4(f32x4 v) { uint2 w; w.x = cvtpk(v[0], v[1]); w.y = cvtpk(v[2], v[3]); return __builtin_bit_cast(s16x4, w); }
__device__ __forceinline__ s16x8 packf8(f32x4 a, f32x4 b) { uint4 w; w.x = cvtpk(a[0], a[1]); w.y = cvtpk(a[2], a[3]); w.z = cvtpk(b[0], b[1]); w.w = cvtpk(b[2], b[3]); return __builtin_bit_cast(s16x8, w); }
__device__ __forceinline__ float bf2f(unsigned short h) { return __uint_as_float(((unsigned)h) << 16); }
__device__ __forceinline__ int bimg_off(int k, int ch) { return 256 * k + 16 * (ch ^ (((k & 3) << 2) | ((k >> 2) & 3))); }

template <bool B_F32, bool GLU, class AR, class BC, class EP>
__device__ __forceinline__ void mgemm_unit(char* lds, int K, const AR& arow, const void* Bp, int ldb, const BC& bcol, const EP& epi) {
    const int tid = threadIdx.x, lane = tid & 63, wid = __builtin_amdgcn_readfirstlane(tid >> 6), wm = wid >> 1, wn = wid & 1, fr = lane & 15, fq = lane >> 4;
    const int ac = (tid & 7) ^ ((tid >> 4) & 7);
    const char* ap[4];
#pragma unroll
    for (int i = 0; i < 4; ++i) ap[i] = (const char*)arow((tid >> 3) + 32 * i);
    const char* bp; int bo_e, bo_o;
    if constexpr (B_F32) {
        const int n4 = tid & 31, kb = tid >> 5; const int col = bcol(n4 * 4);
        bp = (const char*)((const float*)Bp + col) + (size_t)kb * ldb * 4;
        bo_e = 16384 + bimg_off(kb, n4 >> 1) + 8 * (n4 & 1); bo_o = 16384 + bimg_off(kb + 8, n4 >> 1) + 8 * (n4 & 1);
    } else {
        const int kb = tid >> 4; const int ch = (tid & 15) ^ (((kb & 3) << 2) | ((kb >> 2) & 3)); const int col = bcol(ch * 8);
        bp = (const char*)((const bf16_t*)Bp + col) + (size_t)kb * ldb * 2;
        bo_e = 0; bo_o = 0;
    }
    const int a_base = (wm * 64 + fr) * 128, a_sw = (fr >> 1) & 7;
    const int li = lane & 15, wq = li >> 2, wp = li & 3;
    float4 rf0, rf1, rf2, rf3, rf4, rf5, rf6, rf7;
#define MG_DMA16(gp_, ldsp_) do { unsigned keep_; asm volatile("s_mov_b32 %0, m0\n\ts_mov_b32 m0, %2\n\ts_nop 0\n\tglobal_load_lds_dwordx4 %1, off\n\ts_mov_b32 m0, %0" : "=&s"(keep_) : "v"(gp_), "s"((unsigned)__builtin_amdgcn_readfirstlane((int)(unsigned)(uintptr_t)(ldsp_))) : "memory"); } while (0)
#define MG_LOAD_TILES(kt_, buf_) do { \
        const size_t ka_ = (size_t)((kt_) * 64 + ac * 8) * 2; char* ab_ = (buf_) + wid * 1024; \
        MG_DMA16(ap[0] + ka_, ab_); MG_DMA16(ap[1] + ka_, ab_ + 4096); MG_DMA16(ap[2] + ka_, ab_ + 8192); MG_DMA16(ap[3] + ka_, ab_ + 12288); \
        if constexpr (B_F32) { const char* b_ = bp + (size_t)((kt_) * 64) * ldb * 4; const size_t st_ = (size_t)8 * ldb * 4; \
            rf0 = *(const float4*)(b_); rf1 = *(const float4*)(b_ + st_); rf2 = *(const float4*)(b_ + 2 * st_); rf3 = *(const float4*)(b_ + 3 * st_); \
            rf4 = *(const float4*)(b_ + 4 * st_); rf5 = *(const float4*)(b_ + 5 * st_); rf6 = *(const float4*)(b_ + 6 * st_); rf7 = *(const float4*)(b_ + 7 * st_); } \
        else { const char* b_ = bp + (size_t)((kt_) * 64) * ldb * 2; const size_t st_ = (size_t)16 * ldb * 2; char* bb_ = (buf_) + 16384 + wid * 1024; \
            MG_DMA16(b_, bb_); MG_DMA16(b_ + st_, bb_ + 4096); MG_DMA16(b_ + 2 * st_, bb_ + 8192); MG_DMA16(b_ + 3 * st_, bb_ + 12288); } \
    } while (0)
#define MG_CVT8(buf_, off_, v_) do { uint2 w_; w_.x = cvtpk((v_).x, (v_).y); w_.y = cvtpk((v_).z, (v_).w); *(uint2*)((buf_) + (off_)) = w_; } while (0)
#define MG_STORE_TILES(buf_) do { \
        if constexpr (B_F32) { \
            MG_CVT8(buf_, bo_e, rf0); MG_CVT8(buf_, bo_o, rf1); MG_CVT8(buf_, bo_e + 4096, rf2); MG_CVT8(buf_, bo_o + 4096, rf3); \
            MG_CVT8(buf_, bo_e + 8192, rf4); MG_CVT8(buf_, bo_o + 8192, rf5); MG_CVT8(buf_, bo_e + 12288, rf6); MG_CVT8(buf_, bo_o + 12288, rf7); } \
    } while (0)
    f32x4 acc[4][4];
#pragma unroll
    for (int i = 0; i < 4; ++i)
#pragma unroll
        for (int j = 0; j < 4; ++j) acc[i][j] = (f32x4){0.f, 0.f, 0.f, 0.f};
    const int nk = K / 64;
    __syncthreads();
    MG_LOAD_TILES(0, lds);
    MG_STORE_TILES(lds);
    asm volatile("s_waitcnt vmcnt(0)" ::: "memory");
    __syncthreads();
#define MG_COMPUTE(CUR_OFF) do { \
        _Pragma("unroll") for (int ks = 0; ks < 2; ++ks) { \
            s16x8 af[4], wf[4]; \
            const int axor = ((ks * 4 + fq) ^ a_sw) << 4; \
            _Pragma("unroll") for (int mi = 0; mi < 4; ++mi) af[mi] = *(const s16x8*)(lds + (CUR_OFF) + a_base + mi * 2048 + axor); \
            const int r1 = ks * 32 + 8 * fq + wq, r2 = r1 + 4; \
            _Pragma("unroll") for (int ni = 0; ni < 4; ++ni) { \
                const int chunk = wn * 8 + ni * 2 + (wp >> 1); \
                const LAS char* p1 = (const LAS char*)(lds + (CUR_OFF) + 16384 + bimg_off(r1, chunk) + 8 * (wp & 1)); \
                const LAS char* p2 = (const LAS char*)(lds + (CUR_OFF) + 16384 + bimg_off(r2, chunk) + 8 * (wp & 1)); \
                const s16x4 t1 = __builtin_bit_cast(s16x4, __builtin_amdgcn_ds_read_tr16_b64_v4i16((LAS s16x4*)p1)); \
                const s16x4 t2 = __builtin_bit_cast(s16x4, __builtin_amdgcn_ds_read_tr16_b64_v4i16((LAS s16x4*)p2)); \
                wf[ni] = (s16x8){t1[0], t1[1], t1[2], t1[3], t2[0], t2[1], t2[2], t2[3]}; \
            } \
            _Pragma("unroll") for (int mi = 0; mi < 4; ++mi) \
                _Pragma("unroll") for (int ni = 0; ni < 4; ++ni) acc[mi][ni] = __builtin_amdgcn_mfma_f32_16x16x32_bf16(wf[ni], af[mi], acc[mi][ni], 0, 0, 0); \
            if (ks == 0) __builtin_amdgcn_sched_barrier(0); \
        } } while (0)
    for (int kt = 0; kt < nk; kt += 2) {
        if (kt + 1 < nk) MG_LOAD_TILES(kt + 1, lds + 32768);
        __builtin_amdgcn_sched_barrier(0);
        MG_COMPUTE(0);
        __builtin_amdgcn_sched_barrier(0);
        if (kt + 1 < nk) MG_STORE_TILES(lds + 32768);
        asm volatile("s_waitcnt vmcnt(0)" ::: "memory");
        __syncthreads();
        if (kt + 1 >= nk) break;
        if (kt + 2 < nk) MG_LOAD_TILES(kt + 2, lds);
        __builtin_amdgcn_sched_barrier(0);
        MG_COMPUTE(32768);
        __builtin_amdgcn_sched_barrier(0);
        if (kt + 2 < nk) MG_STORE_TILES(lds);
        asm volatile("s_waitcnt vmcnt(0)" ::: "memory");
        __syncthreads();
    }
#undef MG_COMPUTE
    {
        constexpr int NCH = GLU ? 16 : 32;
#pragma unroll
        for (int mi = 0; mi < 4; ++mi) {
            const int m = wm * 64 + mi * 16 + fr;
            if constexpr (GLU) {
#pragma unroll
                for (int ni = 0; ni < 2; ++ni) {
                    const f32x4 g = acc[mi][ni], u = acc[mi][ni + 2];
                    f32x4 r;
#pragma unroll
                    for (int j = 0; j < 4; ++j) r[j] = g[j] / (1.0f + expf(-g[j])) * u[j];
                    const int ch = wn * 8 + ni * 4 + fq;
                    *(f32x4*)(lds + m * 256 + ((ch ^ (m & 7)) << 4)) = r;
                }
            } else {
#pragma unroll
                for (int ni = 0; ni < 4; ++ni) { const int ch = wn * 16 + ni * 4 + fq; *(f32x4*)(lds + m * 512 + ((ch ^ (m & 7)) << 4)) = acc[mi][ni]; }
            }
        }
        __syncthreads();
#pragma unroll 4
        for (int i = 0; i < NCH / 2; ++i) {
            const int idx = i * 256 + tid, m = idx / NCH, ch = idx % NCH;
            const f32x4 v = *(const f32x4*)(lds + m * (NCH * 16) + ((ch ^ (m & 7)) << 4));
            epi(m, ch * 4, v);
        }
    }
}

__device__ __forceinline__ unsigned short f2bf(float v) { return (unsigned short)(cvtpk(v, 0.f) & 0xffffu); }
__device__ __forceinline__ void cvt_seg(const float* src, unsigned short* dst, size_t n, int bid, int nb) {
    const size_t n8 = n / 8;
    for (size_t i = (size_t)bid * NT + threadIdx.x; i < n8; i += (size_t)nb * NT) {
        const float4 a = *(const float4*)(src + i * 8), b = *(const float4*)(src + i * 8 + 4);
        uint4 v; v.x = cvtpk(a.x, a.y); v.y = cvtpk(a.z, a.w); v.z = cvtpk(b.x, b.y); v.w = cvtpk(b.z, b.w);
        *(uint4*)(dst + i * 8) = v;
    }
}
__device__ __forceinline__ void ph_cvt_x(const Params& p, float* sm, int bid, int nb) {
    cvt_seg(p.x, p.Xb, (size_t)T * D, bid, nb);
    cvt_seg(p.w_in, p.WINb, (size_t)D * INW, bid, nb);
    cvt_seg(p.wba, p.WBAb, (size_t)512 * D, bid, nb); cvt_seg(p.wbb, p.WBBb, (size_t)512 * D, bid, nb); cvt_seg(p.wout, p.WOUTb, (size_t)D * D, bid, nb);
    cvt_seg(p.rw, p.RWb, (size_t)D * NE, bid, nb); cvt_seg(p.sgu, p.SGUb, (size_t)D * 512, bid, nb); cvt_seg(p.sdown, p.SDOWNb, (size_t)256 * D, bid, nb);
    cvt_seg(p.w1_k, p.W1Kb, (size_t)2048 * 256, bid, nb); cvt_seg(p.w1_v, p.W1Vb, (size_t)2048 * 256, bid, nb);
    cvt_seg(p.w2_k, p.W2Kb, (size_t)256 * 64, bid, nb); cvt_seg(p.w2_v, p.W2Vb, (size_t)256 * 64, bid, nb);
    cvt_seg(p.w2, p.LW2b, (size_t)64 * 512, bid, nb); cvt_seg(p.a2, p.LA2b, (size_t)64 * 512, bid, nb); cvt_seg(p.g2, p.LG2b, (size_t)128 * 512, bid, nb);
    for (int i = bid * NT + threadIdx.x; i < S * 32; i += nb * NT) {
        const int pos = i >> 5, d = i & 31;
        const float inv = exp2f(-(float)d * (13.287712379549449f / 32.0f));
        float sn, cs; sincosf((float)pos * inv, &sn, &cs);
        p.TABC[i] = cs; p.TABS[i] = sn;
    }
    if (bid < 64) {
        const int kv = bid >> 5, seg = bid & 31;
        const float* pe = kv ? p.pe_v : p.pe_k; const float* w1 = kv ? p.w1_v : p.w1_k;
        float acc = 0.f;
#pragma unroll 8
        for (int k = seg * 64; k < seg * 64 + 64; ++k) acc += pe[k] * w1[(size_t)k * 256 + threadIdx.x];
        p.CB[(kv * 32 + seg) * 256 + threadIdx.x] = acc;
    }
}
__device__ __forceinline__ int xcd_tile(int ul, int nM, int nN, int x) {
    const int q = nN >> 3, r = nN & 7, nmain = nM * q;
    if (ul < nmain) return ((ul / q) << 16) | (x + 8 * (ul % q));
    const int v = ul - nmain, per = nM >> 3;
    if (v < per * r) return (((v % per) * 8 + x) << 16) | (8 * q + v / per);
    return -1;
}
#define XCD_TILE_LOOP(nM_, nN_) for (int ul_ = bid >> 3, tc_ = xcd_tile(ul_, (nM_), (nN_), bid & 7); tc_ >= 0; ul_ += nb >> 3, tc_ = xcd_tile(ul_, (nM_), (nN_), bid & 7))
#define tm_ (tc_ >> 16)
#define tn_ (tc_ & 0xffff)
__device__ __forceinline__ void ph_inproj(const Params& p, float* sm, int bid, int nb) {
    bf16_t* P = p.P; const bf16_t* x = p.Xb;
    XCD_TILE_LOOP(T / 128, (INW + 127) / 128) {
        const int m0 = tm_ * 128, n0 = tn_ * 128;
        auto ar = [&](int r) { return (const void*)(x + (size_t)(m0 + r) * D); };
        auto bc = [&](int c) { return (n0 + c < INW) ? n0 + c : INW - 8; };
        auto ep = [&](int m, int n, f32x4 v) { if (n0 + n < INW) { uint2 w; w.x = cvtpk(v[0], v[1]); w.y = cvtpk(v[2], v[3]); *(uint2*)(P + (size_t)(m0 + m) * INW + n0 + n) = w; } };
        mgemm_unit<false, false>((char*)sm, D, ar, p.WINb, INW, bc, ep);
    }
}

__device__ __forceinline__ void unpack8(const uint4 v, float (&f)[8]) {
    f[0] = bf2f(v.x & 0xffff); f[1] = bf2f(v.x >> 16); f[2] = bf2f(v.y & 0xffff); f[3] = bf2f(v.y >> 16);
    f[4] = bf2f(v.z & 0xffff); f[5] = bf2f(v.z >> 16); f[6] = bf2f(v.w & 0xffff); f[7] = bf2f(v.w >> 16);
}
__device__ __forceinline__ uint4 pack8(const float (&f)[8]) { uint4 v; v.x = cvtpk(f[0], f[1]); v.y = cvtpk(f[2], f[3]); v.z = cvtpk(f[4], f[5]); v.w = cvtpk(f[6], f[7]); return v; }
__device__ __forceinline__ void ph_prep(const Params& p, float* sm, int bid, int nb) {
    const int tid = threadIdx.x;
    for (int t = bid; t < T; t += nb) {
        const int s = t & (S - 1), b = t >> 13;
        const bf16_t* Pt = p.P + (size_t)t * INW;
        if (tid < 224) {
            const int c0 = tid * 8;
            float cur[8], prv[8], x[8];
            unpack8(*(const uint4*)(Pt + c0), cur);
            if (s > 0) unpack8(*(const uint4*)(Pt + c0 - INW), prv); else { for (int j = 0; j < 8; ++j) prv[j] = 0.f; }
            const float4 mu0 = *(const float4*)(p.mu + c0), mu1 = *(const float4*)(p.mu + c0 + 4);
            const float muv[8] = {mu0.x, mu0.y, mu0.z, mu0.w, mu1.x, mu1.y, mu1.z, mu1.w};
#pragma unroll
            for (int j = 0; j < 8; ++j) x[j] = cur[j] + (prv[j] - cur[j]) * muv[j];
            if (tid < 192) {
                const int region = tid >> 6, c = (tid & 63) * 8;
                const size_t o = (size_t)t * 512 + c;
                if (region == 1) {
                    const float4 k0 = *(const float4*)(p.k_k + c), k1 = *(const float4*)(p.k_k + c + 4);
                    const float kkv[8] = {x[0] * k0.x, x[1] * k0.y, x[2] * k0.z, x[3] * k0.w, x[4] * k1.x, x[5] * k1.y, x[6] * k1.z, x[7] * k1.w};
                    float ss = 0.f;
#pragma unroll
                    for (int j = 0; j < 8; ++j) ss += kkv[j] * kkv[j];
                    ss += __shfl_xor(ss, 1); ss += __shfl_xor(ss, 2); ss += __shfl_xor(ss, 4);
                    const float inv = 1.0f / fmaxf(sqrtf(ss), 1e-12f);
                    *(uint4*)(p.KSHb + o) = pack8(x);
                    const float kkn[8] = {kkv[0] * inv, kkv[1] * inv, kkv[2] * inv, kkv[3] * inv, kkv[4] * inv, kkv[5] * inv, kkv[6] * inv, kkv[7] * inv};
                    *(uint4*)(p.KKb + o) = pack8(kkn);
                } else {
                    bf16_t* dst = (region == 0) ? p.Rb : p.Vb;
                    *(uint4*)(dst + o) = pack8(x);
                }
            } else {
                const int c = (tid - 192) * 8;
                float y[8];
#pragma unroll
                for (int j = 0; j < 8; ++j) y[j] = (c < 64) ? tanhf(x[j]) : (c < 128) ? x[j] : sigmoidf_(x[j]);
                *(uint4*)(p.LORA + (size_t)t * 256 + c) = pack8(y);
            }
        } else if (tid < 248) {
            const int i = tid - 224;
            p.GT[(size_t)t * 24 + i] = sigmoidf_(bf2f(Pt[C_GT + i]));
        }
        if (tid < 48) {
            const int hs = tid >> 2, i0 = (tid & 3) * 8;
            const bf16_t* src = (hs < 8) ? Pt + C_Q + hs * 64 : (hs < 10) ? Pt + C_KS + (hs - 8) * 64 : Pt + C_KW + (hs - 10) * 64;
            bf16_t* dst = (hs < 8) ? p.Qb + (size_t)t * 512 + hs * 64 : (hs < 10) ? p.KSb + (size_t)t * 128 + (hs - 8) * 64 : p.KWb + (size_t)t * 128 + (hs - 10) * 64;
            const float scl = (hs < 8) ? QSCALE : 1.0f;
            float x1[8], x2[8], y1[8], y2[8];
            unpack8(*(const uint4*)(src + i0), x1); unpack8(*(const uint4*)(src + i0 + 32), x2);
            const float4 c0 = *(const float4*)(p.TABC + s * 32 + i0), c1 = *(const float4*)(p.TABC + s * 32 + i0 + 4), s0 = *(const float4*)(p.TABS + s * 32 + i0), s1 = *(const float4*)(p.TABS + s * 32 + i0 + 4);
            const float cs[8] = {c0.x, c0.y, c0.z, c0.w, c1.x, c1.y, c1.z, c1.w}, sn[8] = {s0.x, s0.y, s0.z, s0.w, s1.x, s1.y, s1.z, s1.w};
#pragma unroll
            for (int j = 0; j < 8; ++j) { y1[j] = (x1[j] * cs[j] - x2[j] * sn[j]) * scl; y2[j] = (x2[j] * cs[j] + x1[j] * sn[j]) * scl; }
            *(uint4*)(dst + i0) = pack8(y1); *(uint4*)(dst + i0 + 32) = pack8(y2);
        } else if (tid >= 64 && tid < 128) {
            const int i = tid - 64, which = i >> 4, c = (i & 15) * 8;
            const int scol = (which == 0) ? C_VS : (which == 1) ? C_VW : (which == 2) ? C_KC : C_VC;
            const uint4 v = *(const uint4*)(Pt + scol + c);
            if (which == 0) *(uint4*)(p.VSb + (size_t)t * 128 + c) = v;
            else if (which == 1) *(uint4*)(p.VWb + (size_t)t * 128 + c) = v;
            else { bf16_t* base = (which == 2) ? p.KCin : p.VCin; *(uint4*)(base + ((size_t)(b * 2 + (c >> 6)) * S + s) * 64 + (c & 63)) = v; }
        }
    }
}
__device__ __forceinline__ void ph_prep_gemm(const Params& p, float* sm, int bid, int nb) {
    const int n_lora = (T / 128) * 4 * 3, n_cmp = 16 * 2 * 2;
    for (int u = bid; u < n_lora + n_cmp; u += nb) {
        if (u < n_lora) {
            const int part = u % 3, n0 = ((u / 3) % 4) * 128, m0 = (u / 12) * 128;
            const bf16_t* A = p.LORA + (part == 0 ? 0 : part == 1 ? 64 : 128);
            const bf16_t* Bw = (part == 0) ? p.LW2b : (part == 1) ? p.LA2b : p.LG2b;
            auto ar = [&](int r) { return (const void*)(A + (size_t)(m0 + r) * 256); };
            auto bc = [&](int c) { return n0 + c; };
            if (part == 0) {
                bf16_t* EWX = p.EWXb; const float* w0 = p.w0;
                auto ep = [&](int m, int n, f32x4 v) {
                    const int c = n0 + n; const f32x4 w0v = *(const f32x4*)(w0 + c); f32x4 o;
#pragma unroll
                    for (int j = 0; j < 4; ++j) { const float nx = -(w0v[j] + v[j]); const float sp = (nx > 20.f) ? nx : log1pf(expf(nx)); o[j] = expf(-sp - 0.5f); }
                    *(uint2*)(EWX + (size_t)(m0 + m) * 512 + c) = __builtin_bit_cast(uint2, packf4(o));
                };
                mgemm_unit<false, false>((char*)sm, 64, ar, Bw, 512, bc, ep);
            } else if (part == 1) {
                bf16_t* K2 = p.K2b; bf16_t* BB = p.BBb; const bf16_t* KSH = p.KSHb; const bf16_t* KK = p.KKb; const float* a0 = p.a0; const float* k_a = p.k_a;
                auto ep = [&](int m, int n, f32x4 v) {
                    const int c = n0 + n; const size_t o = (size_t)(m0 + m) * 512 + c;
                    const f32x4 a0v = *(const f32x4*)(a0 + c), kav = *(const f32x4*)(k_a + c);
                    const uint2 kw = *(const uint2*)(KSH + o), kkw = *(const uint2*)(KK + o);
                    const f32x4 kv = {bf2f(kw.x & 0xffff), bf2f(kw.x >> 16), bf2f(kw.y & 0xffff), bf2f(kw.y >> 16)}, kkv = {bf2f(kkw.x & 0xffff), bf2f(kkw.x >> 16), bf2f(kkw.y & 0xffff), bf2f(kkw.y >> 16)};
                    f32x4 k2, bb;
#pragma unroll
                    for (int j = 0; j < 4; ++j) { const float a = sigmoidf_(a0v[j] + v[j]); k2[j] = kv[j] * (1.0f + (a - 1.0f) * kav[j]); bb[j] = kkv[j] * a; }
                    *(uint2*)(K2 + o) = __builtin_bit_cast(uint2, packf4(k2)); *(uint2*)(BB + o) = __builtin_bit_cast(uint2, packf4(bb));
                };
                mgemm_unit<false, false>((char*)sm, 64, ar, Bw, 512, bc, ep);
            } else {
                bf16_t* G = p.Gb;
                auto ep = [&](int m, int n, f32x4 v) { *(uint2*)(G + (size_t)(m0 + m) * 512 + n0 + n) = __builtin_bit_cast(uint2, packf4(v)); };
                mgemm_unit<false, false>((char*)sm, 128, ar, Bw, 512, bc, ep);
            }
        } else {
            const int v = u - n_lora, kv = v & 1, n0 = ((v >> 1) & 1) * 128, m0 = (v >> 2) * 128;
            const bf16_t* IN = kv ? p.VCin : p.KCin; const bf16_t* Bw = kv ? p.W1Vb : p.W1Kb; bf16_t* H1 = kv ? p.H1Vb : p.H1Kb;
            float* cb = sm + 16384 + 512;
            __syncthreads();
            { float a_ = 0.f; for (int sg = 0; sg < 32; ++sg) a_ += p.CB[(kv * 32 + sg) * 256 + threadIdx.x]; cb[threadIdx.x] = a_; }
            auto ar = [&](int r) { int rr = m0 + r; if (rr >= NCROWS) rr = NCROWS - 1; const int g = rr & 1, bc_ = rr >> 1, b = bc_ / NCMP, c = bc_ % NCMP; return (const void*)(IN + ((size_t)(b * 2 + g) * S + 16 * c) * 64); };
            auto bc = [&](int c) { return n0 + c; };
            auto ep = [&](int m, int n, f32x4 v4) {
                const int rr = m0 + m; if (rr >= NCROWS) return;
                const f32x4 bv = *(const f32x4*)(cb + n0 + n);
                uint2 w; w.x = cvtpk(gelu_tanh(v4[0] + bv[0]), gelu_tanh(v4[1] + bv[1])); w.y = cvtpk(gelu_tanh(v4[2] + bv[2]), gelu_tanh(v4[3] + bv[3]));
                *(uint2*)(H1 + (size_t)rr * 256 + n0 + n) = w;
            };
            mgemm_unit<false, false>((char*)sm, 2048, ar, Bw, 256, bc, ep);
        }
    }
}

constexpr int SCI_AP = 0, SCI_RP = 2048, SCI_BQ = 4096, SCI_KQ = 6144, SCI_LAK = 8192, SCI_TT = 8704, SCI_MRB = 9216, SCI_MRK = 9728, SCI_GC = 10240, SCI_BYTES = 10496;
__device__ __forceinline__ f32x4 mfma16(s16x4 a, s16x4 b, f32x4 c) { const s16x8 a8 = {a[0], a[1], a[2], a[3], 0, 0, 0, 0}, b8 = {b[0], b[1], b[2], b[3], 0, 0, 0, 0}; return __builtin_amdgcn_mfma_f32_16x16x32_bf16(a8, b8, c, 0, 0, 0); }
__device__ __forceinline__ f32x4 mfma32(s16x8 a, s16x8 b, f32x4 c) { return __builtin_amdgcn_mfma_f32_16x16x32_bf16(a, b, c, 0, 0, 0); }
#define WAVE_LDS_SYNC() asm volatile("s_waitcnt lgkmcnt(0)" ::: "memory")
__device__ __forceinline__ void ph_scan_pre(const Params& p, float* sm, int bid, int nb) {
    const int tid = threadIdx.x, lane = tid & 63, wave = tid >> 6, li = lane & 15, fq = lane >> 4;
    char* wl = (char*)sm + wave * 10240;
    bf16_t* A_l = (bf16_t*)wl; bf16_t* R_l = A_l + 1024; bf16_t* B_l = A_l + 2048; bf16_t* K_l = A_l + 3072;
    float* Lf = (float*)(wl + 8192); float* Tf = (float*)(wl + 9216);
    __syncthreads();
    for (int item = bid * 4 + wave; item < 8192; item += nb * 4) {
        const int ch = item & 511, bh = item >> 9, b = bh >> 3, h = bh & 7;
        const size_t base = ((size_t)(b * S + ch * 16)) * 512 + h * 64 + lane;
        char* out = p.SCANI + (size_t)item * SCI_BYTES;
        float G = 1.0f;
        float bt[16], kt[16];
        WAVE_LDS_SYNC();
#pragma unroll
        for (int t = 0; t < 16; ++t) {
            const size_t o = base + (size_t)t * 512;
            const float d = expf(-bf2f(p.EWXb[o])), kk = bf2f(p.KKb[o]), bb = bf2f(p.BBb[o]), k2 = bf2f(p.K2b[o]), r = bf2f(p.Rb[o]);
            const float Gp = G; G *= d; const float ig = 1.0f / G;
            bt[t] = bb * ig; kt[t] = k2 * ig;
            A_l[t * 64 + lane] = f2bf(-kk * Gp); R_l[t * 64 + lane] = f2bf(r * G); B_l[t * 64 + lane] = f2bf(bt[t]); K_l[t * 64 + lane] = f2bf(kt[t]);
        }
        *(float*)(out + SCI_GC + lane * 4) = G;
        {
            uint4 w0, w1;
            w0.x = cvtpk(bt[0], bt[1]); w0.y = cvtpk(bt[2], bt[3]); w0.z = cvtpk(bt[4], bt[5]); w0.w = cvtpk(bt[6], bt[7]);
            w1.x = cvtpk(bt[8], bt[9]); w1.y = cvtpk(bt[10], bt[11]); w1.z = cvtpk(bt[12], bt[13]); w1.w = cvtpk(bt[14], bt[15]);
            *(uint4*)(out + SCI_BQ + lane * 32) = w0; *(uint4*)(out + SCI_BQ + lane * 32 + 16) = w1;
            w0.x = cvtpk(kt[0], kt[1]); w0.y = cvtpk(kt[2], kt[3]); w0.z = cvtpk(kt[4], kt[5]); w0.w = cvtpk(kt[6], kt[7]);
            w1.x = cvtpk(kt[8], kt[9]); w1.y = cvtpk(kt[10], kt[11]); w1.z = cvtpk(kt[12], kt[13]); w1.w = cvtpk(kt[14], kt[15]);
            *(uint4*)(out + SCI_KQ + lane * 32) = w0; *(uint4*)(out + SCI_KQ + lane * 32 + 16) = w1;
        }
        WAVE_LDS_SYNC();
        f32x4 Lab = {0.f, 0.f, 0.f, 0.f}, Lak = Lab, Mrb = Lab, Mrk = Lab;
#pragma unroll
        for (int s2 = 0; s2 < 2; ++s2) {
            const int o = li * 64 + s2 * 32 + fq * 8;
            const s16x8 bf = *(const s16x8*)(B_l + o), kf = *(const s16x8*)(K_l + o), af = *(const s16x8*)(A_l + o), rf = *(const s16x8*)(R_l + o);
            Lab = mfma32(bf, af, Lab); Lak = mfma32(kf, af, Lak); Mrb = mfma32(bf, rf, Mrb); Mrk = mfma32(kf, rf, Mrk);
        }
#pragma unroll
        for (int r = 0; r < 4; ++r) {
            const int i = 4 * fq + r;
            if (!(i < li)) { Lab[r] = 0.f; Lak[r] = 0.f; }
            if (!(i <= li)) { Mrb[r] = 0.f; Mrk[r] = 0.f; }
            Lf[i * 16 + li] = Lab[r];
        }
        *(uint2*)(out + SCI_LAK + (li * 16 + 4 * fq) * 2) = __builtin_bit_cast(uint2, packf4(Lak));
        *(uint2*)(out + SCI_MRB + (li * 16 + 4 * fq) * 2) = __builtin_bit_cast(uint2, packf4(Mrb));
        *(uint2*)(out + SCI_MRK + (li * 16 + 4 * fq) * 2) = __builtin_bit_cast(uint2, packf4(Mrk));
        WAVE_LDS_SYNC();
        float Tr[16];
#pragma unroll
        for (int t = 0; t < 16; ++t) {
            float acc = (t == li) ? 1.0f : 0.0f;
#pragma unroll
            for (int j = 0; j < t; ++j) acc += Tr[j] * Lf[j * 16 + t];
            Tr[t] = acc;
        }
        if (fq == 0) {
#pragma unroll
            for (int t = 0; t < 16; t += 4) *(float4*)(Tf + li * 16 + t) = make_float4(Tr[t], Tr[t + 1], Tr[t + 2], Tr[t + 3]);
        }
        WAVE_LDS_SYNC();
        {
            const f32x4 tv = {Tf[(4 * fq + 0) * 16 + li], Tf[(4 * fq + 1) * 16 + li], Tf[(4 * fq + 2) * 16 + li], Tf[(4 * fq + 3) * 16 + li]};
            *(uint2*)(out + SCI_TT + (li * 16 + 4 * fq) * 2) = __builtin_bit_cast(uint2, packf4(tv));
        }
#pragma unroll
        for (int c2 = 0; c2 < 2; ++c2) {
            const int q = lane + 64 * c2, s2 = q >> 6, t = (q >> 2) & 15, f = q & 3;
            const int e0 = t * 64 + 32 * s2 + 4 * f;
            uint4 w; const uint2 a0 = *(const uint2*)(A_l + e0), a1 = *(const uint2*)(A_l + e0 + 16);
            w.x = a0.x; w.y = a0.y; w.z = a1.x; w.w = a1.y; *(uint4*)(out + SCI_AP + q * 16) = w;
            const uint2 r0 = *(const uint2*)(R_l + e0), r1 = *(const uint2*)(R_l + e0 + 16);
            w.x = r0.x; w.y = r0.y; w.z = r1.x; w.w = r1.y; *(uint4*)(out + SCI_RP + q * 16) = w;
        }
    }
}
constexpr int SC_SLOT = 16384, SC_VOFF = SCI_BYTES;
__device__ __forceinline__ void ph_scan_seq(const Params& p, float* sm, int bid, int nb) {
    const int tid = threadIdx.x, lane = tid & 63, vs = tid >> 6, li = lane & 15, fq = lane >> 4;
    char* lds = (char*)sm;
    for (int bh = bid; bh < 16; bh += nb) {
        const int b = bh >> 3, h = bh & 7;
        const char* item = p.SCANI + (size_t)(bh * 512) * SCI_BYTES;
        const size_t vcol = (size_t)h * 64 + vs * 16 + li;
        const char* src2; size_t st2; const char* src3; size_t st3;
        {
            const int q2 = tid + 512, q3 = tid + 768;
            if (q2 < 656) { src2 = item + (size_t)q2 * 16; st2 = SCI_BYTES; } else { const int vq = q2 - 656; src2 = (const char*)(p.Vb + ((size_t)(b * S + (vq >> 3))) * 512 + h * 64 + (vq & 7) * 8); st2 = (size_t)16 * 512 * 2; }
            if (q3 < 784) { const int vq = q3 - 656; src3 = (const char*)(p.Vb + ((size_t)(b * S + (vq >> 3))) * 512 + h * 64 + (vq & 7) * 8); st3 = (size_t)16 * 512 * 2; } else { src3 = item; st3 = SCI_BYTES; }
        }
        const char* src0 = item + (size_t)tid * 16; const char* src1 = item + (size_t)(tid + 256) * 16;
        const int d2 = (tid + 512) * 16;
        const int d3 = (tid + 768 < 784) ? (tid + 768) * 16 : 15360 + (tid & 63) * 16;
        f32x4 S0 = {0.f, 0.f, 0.f, 0.f}, S1 = S0, S2 = S0, S3 = S0;
        uint4 rA0, rA1, rA2, rA3, rB0, rB1, rB2, rB3, rC0, rC1, rC2, rC3, rD0, rD1, rD2, rD3;
#define SC_GLOAD(R, chn_) do { const int cc_ = ((chn_) < 512) ? (chn_) : 511; \
        R##0 = *(const uint4*)(src0 + (size_t)cc_ * SCI_BYTES); R##1 = *(const uint4*)(src1 + (size_t)cc_ * SCI_BYTES); \
        R##2 = *(const uint4*)(src2 + (size_t)cc_ * st2); R##3 = *(const uint4*)(src3 + (size_t)cc_ * st3); } while (0)
#define SC_LSTORE(R, slot_) do { char* sl_ = lds + (slot_) * SC_SLOT; \
        *(uint4*)(sl_ + tid * 16) = R##0; *(uint4*)(sl_ + (tid + 256) * 16) = R##1; *(uint4*)(sl_ + d2) = R##2; *(uint4*)(sl_ + d3) = R##3; } while (0)
#define SC_COMPUTE(chn_, slot_) do { const char* it_ = lds + (slot_) * SC_SLOT; \
        const s16x8 ap0 = *(const s16x8*)(it_ + SCI_AP + ((0 * 16 + li) * 4 + fq) * 16), ap1 = *(const s16x8*)(it_ + SCI_AP + ((1 * 16 + li) * 4 + fq) * 16); \
        const s16x8 rp0 = *(const s16x8*)(it_ + SCI_RP + ((0 * 16 + li) * 4 + fq) * 16), rp1 = *(const s16x8*)(it_ + SCI_RP + ((1 * 16 + li) * 4 + fq) * 16); \
        const s16x4 bq0 = *(const s16x4*)(it_ + SCI_BQ + ((0 * 16 + li) * 16 + 4 * fq) * 2), bq1 = *(const s16x4*)(it_ + SCI_BQ + ((1 * 16 + li) * 16 + 4 * fq) * 2); \
        const s16x4 bq2 = *(const s16x4*)(it_ + SCI_BQ + ((2 * 16 + li) * 16 + 4 * fq) * 2), bq3 = *(const s16x4*)(it_ + SCI_BQ + ((3 * 16 + li) * 16 + 4 * fq) * 2); \
        const s16x4 kq0 = *(const s16x4*)(it_ + SCI_KQ + ((0 * 16 + li) * 16 + 4 * fq) * 2), kq1 = *(const s16x4*)(it_ + SCI_KQ + ((1 * 16 + li) * 16 + 4 * fq) * 2); \
        const s16x4 kq2 = *(const s16x4*)(it_ + SCI_KQ + ((2 * 16 + li) * 16 + 4 * fq) * 2), kq3 = *(const s16x4*)(it_ + SCI_KQ + ((3 * 16 + li) * 16 + 4 * fq) * 2); \
        const s16x4 lak = *(const s16x4*)(it_ + SCI_LAK + (li * 16 + 4 * fq) * 2), ttm = *(const s16x4*)(it_ + SCI_TT + (li * 16 + 4 * fq) * 2); \
        const s16x4 mrb = *(const s16x4*)(it_ + SCI_MRB + (li * 16 + 4 * fq) * 2), mrk = *(const s16x4*)(it_ + SCI_MRK + (li * 16 + 4 * fq) * 2); \
        const f32x4 g0 = *(const f32x4*)(it_ + SCI_GC + (0 * 16 + 4 * fq) * 4), g1 = *(const f32x4*)(it_ + SCI_GC + (1 * 16 + 4 * fq) * 4); \
        const f32x4 g2 = *(const f32x4*)(it_ + SCI_GC + (2 * 16 + 4 * fq) * 4), g3 = *(const f32x4*)(it_ + SCI_GC + (3 * 16 + 4 * fq) * 4); \
        const short* vl_ = (const short*)(it_ + SC_VOFF) + (4 * fq) * 64 + vs * 16 + li; \
        const s16x4 vb = {vl_[0], vl_[64], vl_[128], vl_[192]}; \
        const s16x8 sb0 = packf8(S0, S1), sb1 = packf8(S2, S3); \
        const f32x4 z_ = {0.f, 0.f, 0.f, 0.f}; \
        f32x4 W = mfma32(ap0, sb0, z_); W = mfma32(ap1, sb1, W); W = mfma16(lak, vb, W); \
        const f32x4 U = mfma16(ttm, packf4(W), z_); \
        const s16x4 ub = packf4(U); \
        f32x4 O = mfma32(rp0, sb0, z_); O = mfma32(rp1, sb1, O); O = mfma16(mrk, vb, O); O = mfma16(mrb, ub, O); \
        S0 = mfma16(kq0, vb, S0); S0 = mfma16(bq0, ub, S0); S1 = mfma16(kq1, vb, S1); S1 = mfma16(bq1, ub, S1); \
        S2 = mfma16(kq2, vb, S2); S2 = mfma16(bq2, ub, S2); S3 = mfma16(kq3, vb, S3); S3 = mfma16(bq3, ub, S3); \
        S0 *= g0; S1 *= g1; S2 *= g2; S3 *= g3; \
        float* op_ = p.O + ((size_t)(b * S + (chn_) * 16 + 4 * fq)) * 512 + vcol; \
        op_[0] = O[0]; op_[512] = O[1]; op_[1024] = O[2]; op_[1536] = O[3]; } while (0)
        const char* tp0; const char* tp1; size_t ts0, ts1;
        {
            const int i0 = tid, i1 = tid + 256;
            const int c0 = i0 / 98, l0 = i0 % 98, c1 = (i1 / 98 < 4) ? i1 / 98 : 3, l1 = (i1 / 98 < 4) ? i1 % 98 : 0;
            if (l0 < 82) { tp0 = item + (size_t)c0 * SCI_BYTES + l0 * 128; ts0 = SCI_BYTES; } else { tp0 = (const char*)(p.Vb + ((size_t)(b * S + c0 * 16 + (l0 - 82))) * 512 + h * 64); ts0 = (size_t)16 * 512 * 2; }
            if (l1 < 82) { tp1 = item + (size_t)c1 * SCI_BYTES + l1 * 128; ts1 = SCI_BYTES; } else { tp1 = (const char*)(p.Vb + ((size_t)(b * S + c1 * 16 + (l1 - 82))) * 512 + h * 64); ts1 = (size_t)16 * 512 * 2; }
        }
        int pfa0 = 0, pfa1 = 0, pfb0 = 0, pfb1 = 0;
        SC_GLOAD(rA, 0); SC_GLOAD(rB, 1); SC_GLOAD(rC, 2); SC_GLOAD(rD, 3);
#define SC_GROUP(ch_, PF0, PF1) do { \
            __syncthreads(); \
            SC_LSTORE(rA, 0); SC_LSTORE(rB, 1); SC_LSTORE(rC, 2); SC_LSTORE(rD, 3); \
            __syncthreads(); \
            SC_GLOAD(rA, (ch_) + 4); SC_GLOAD(rB, (ch_) + 5); SC_GLOAD(rC, (ch_) + 6); SC_GLOAD(rD, (ch_) + 7); \
            asm volatile("" :: "v"(PF0), "v"(PF1));        \
            { const int tc_ = ((ch_) + 12 < 512) ? (ch_) + 12 : 508; PF0 = *(const int*)(tp0 + (size_t)tc_ * ts0); PF1 = *(const int*)(tp1 + (size_t)tc_ * ts1); } \
            __builtin_amdgcn_sched_barrier(0); \
            SC_COMPUTE((ch_), 0); SC_COMPUTE((ch_) + 1, 1); SC_COMPUTE((ch_) + 2, 2); SC_COMPUTE((ch_) + 3, 3); } while (0)
        for (int ch = 0; ch < 512; ch += 8) { SC_GROUP(ch, pfa0, pfa1); SC_GROUP(ch + 4, pfb0, pfb1); }
#undef SC_GROUP
#undef SC_COMPUTE
#undef SC_LSTORE
#undef SC_GLOAD
    }
}

__device__ __forceinline__ void ph_rwkv_post(const Params& p, float* sm, int bid, int nb) {
    const int tid = threadIdx.x;
    for (int t = bid; t < T; t += nb) {
#pragma unroll
        for (int slot = 0; slot < 2; ++slot) {
            const int c = tid + slot * 256;
            const size_t o = (size_t)t * 512 + c;
            const float ov = p.O[o];
            const float m = wave_sum(ov) * (1.0f / 64.0f);
            const float dl = ov - m;
            const float var = wave_sum(dl * dl) * (1.0f / 64.0f);
            const float on = dl * rsqrtf(var + 64e-5f) * p.lnx_w[c] + p.lnx_b[c];
            const float bon = wave_sum(bf2f(p.Rb[o]) * bf2f(p.K2b[o]) * p.r_k[c]) * bf2f(p.Vb[o]);
            p.YAb[o] = f2bf((on + bon) * bf2f(p.Gb[o]));
        }
    }
}

__device__ __forceinline__ void ph_cmp2(const Params& p, float* sm, int bid, int nb) {
    for (int u = bid; u < 32; u += nb) {
        const int kv = u & 1, m0 = (u >> 1) * 128;
        const bf16_t* H1 = kv ? p.H1Vb : p.H1Kb; const bf16_t* Bw = kv ? p.W2Vb : p.W2Kb; float* OUT = kv ? p.VC : p.KCraw;
        auto ar = [&](int r) { int rr = m0 + r; if (rr >= NCROWS) rr = NCROWS - 1; return (const void*)(H1 + (size_t)rr * 256); };
        auto bc = [&](int c) { return (c < 64) ? c : 0; };
        auto ep = [&](int m, int n, f32x4 v) { const int rr = m0 + m; if (rr < NCROWS && n < 64) *(f32x4*)(OUT + (size_t)rr * 64 + n) = v; };
        mgemm_unit<false, false>((char*)sm, 256, ar, Bw, 64, bc, ep);
    }
}
__device__ __forceinline__ void ph_cmp_rope(const Params& p, float* sm, int bid, int nb) {
    const int tid = threadIdx.x;
    for (int i = bid * NT + tid; i < NCROWS * 32; i += nb * NT) {
        const int r = i >> 5, d = i & 31;
        const int c = (r >> 1) % NCMP;
        const int pos = 16 * c + 31;
        const float cs = p.TABC[pos * 32 + d], sn = p.TABS[pos * 32 + d];
        const float x1 = p.KCraw[(size_t)r * 64 + d], x2 = p.KCraw[(size_t)r * 64 + d + 32];
        const float y1 = x1 * cs - x2 * sn, y2 = x2 * cs + x1 * sn;
        const int g = r & 1, b = (r >> 1) / NCMP;
        const size_t ob = ((size_t)((b * 2 + g) * 512 + c)) * 64;
        p.KCb[ob + d] = f2bf(y1); p.KCb[ob + d + 32] = f2bf(y2);
        p.VCb[ob + d] = f2bf(p.VC[(size_t)r * 64 + d]); p.VCb[ob + d + 32] = f2bf(p.VC[(size_t)r * 64 + d + 32]);
    }
    for (int i = bid * NT + tid; i < 4 * 64; i += nb * NT) { const size_t ob = ((size_t)((i >> 6) * 512 + 511)) * 64 + (i & 63); p.KCb[ob] = 0; p.VCb[ob] = 0; }
}

__device__ __forceinline__ int kimg_off(int key, int c) { return key * 128 + ((c ^ ((key >> 1) & 7)) << 4); }
__device__ __forceinline__ int vimg_off(int key, int c) { return key * 128 + ((c ^ (((key >> 1) & 3) << 1)) << 4); }
__device__ __forceinline__ float fast_exp2(float x) { return __builtin_amdgcn_exp2f(x); }

struct NsaCtx {
    char* lds; int tid, lane, wave, fr, fq, li;
    s16x8 qf[2][2];
    int tq[2];
};

__device__ __forceinline__ void nsa_qk(const NsaCtx& c, const char* cur, f32x4 (&s)[2][4]) {
#pragma unroll
    for (int kt = 0; kt < 4; ++kt) {
#pragma unroll
        for (int ks = 0; ks < 2; ++ks) {
            const s16x8 kf = *(const s16x8*)(cur + kimg_off(kt * 16 + c.fr, ks * 4 + c.fq));
#pragma unroll
            for (int qt = 0; qt < 2; ++qt) {
                if (ks == 0) s[qt][kt] = __builtin_amdgcn_mfma_f32_16x16x32_bf16(kf, c.qf[qt][0], (f32x4){0.f, 0.f, 0.f, 0.f}, 0, 0, 0);
                else s[qt][kt] = __builtin_amdgcn_mfma_f32_16x16x32_bf16(kf, c.qf[qt][1], s[qt][kt], 0, 0, 0);
            }
        }
    }
}
__device__ __forceinline__ void nsa_pv(const NsaCtx& c, const char* cur, const f32x4 (&pr)[2][4], f32x4 (&O)[2][4]) {
    s16x8 pb[2][2];
#pragma unroll
    for (int qt = 0; qt < 2; ++qt)
#pragma unroll
        for (int k2 = 0; k2 < 2; ++k2) {
            const f32x4 a = pr[qt][2 * k2], b = pr[qt][2 * k2 + 1];
            const unsigned w0 = cvtpk(a[0], a[1]), w1 = cvtpk(a[2], a[3]), w2 = cvtpk(b[0], b[1]), w3 = cvtpk(b[2], b[3]);
            pb[qt][k2] = __builtin_bit_cast(s16x8, make_uint4(w0, w1, w2, w3));
        }
    const int q_ = c.li >> 2, p_ = c.li & 3;
#pragma unroll
    for (int dt = 0; dt < 4; ++dt)
#pragma unroll
        for (int k2 = 0; k2 < 2; ++k2) {
            const int key1 = k2 * 32 + 4 * c.fq + q_, key2 = key1 + 16;
            const int chunk = dt * 2 + (p_ >> 1);
            const LAS char* a1 = (const LAS char*)(cur + 8192 + vimg_off(key1, chunk) + 8 * (p_ & 1));
            const LAS char* a2 = (const LAS char*)(cur + 8192 + vimg_off(key2, chunk) + 8 * (p_ & 1));
            const s16x4 t1 = __builtin_bit_cast(s16x4, __builtin_amdgcn_ds_read_tr16_b64_v4i16((LAS s16x4*)a1));
            const s16x4 t2 = __builtin_bit_cast(s16x4, __builtin_amdgcn_ds_read_tr16_b64_v4i16((LAS s16x4*)a2));
            const s16x8 vf = (s16x8){t1[0], t1[1], t1[2], t1[3], t2[0], t2[1], t2[2], t2[3]};
#pragma unroll
            for (int qt = 0; qt < 2; ++qt) O[qt][dt] = __builtin_amdgcn_mfma_f32_16x16x32_bf16(vf, pb[qt][k2], O[qt][dt], 0, 0, 0);
        }
}
#define KVREGS uint4 rk0, rk1, rv0, rv1
#define KVARGS rk0, rk1, rv0, rv1
__device__ __forceinline__ void nsa_gload(const NsaCtx& c, uint4& rk0, uint4& rk1, uint4& rv0, uint4& rv1, const bf16_t* Kg, const bf16_t* Vg, int stride, int tile) {
    { const int idx = c.tid, key = idx >> 3, ch = idx & 7; const size_t off = (size_t)(tile * 64 + key) * stride + ch * 8; rk0 = *(const uint4*)(Kg + off); rv0 = *(const uint4*)(Vg + off); }
    { const int idx = 256 + c.tid, key = idx >> 3, ch = idx & 7; const size_t off = (size_t)(tile * 64 + key) * stride + ch * 8; rk1 = *(const uint4*)(Kg + off); rv1 = *(const uint4*)(Vg + off); }
}
__device__ __forceinline__ void nsa_lstore(const NsaCtx& c, const uint4& rk0, const uint4& rk1, const uint4& rv0, const uint4& rv1, char* buf) {
    { const int idx = c.tid, key = idx >> 3, ch = idx & 7; *(uint4*)(buf + kimg_off(key, ch)) = rk0; *(uint4*)(buf + 8192 + vimg_off(key, ch)) = rv0; }
    { const int idx = 256 + c.tid, key = idx >> 3, ch = idx & 7; *(uint4*)(buf + kimg_off(key, ch)) = rk1; *(uint4*)(buf + 8192 + vimg_off(key, ch)) = rv1; }
}
__device__ __forceinline__ bool selbit4(const unsigned (&w)[4], int tile) {
    const unsigned long long lo = ((unsigned long long)w[1] << 32) | w[0], hi = ((unsigned long long)w[3] << 32) | w[2];
    const unsigned long long x = (tile < 64) ? (lo >> (tile & 63)) : (hi >> (tile & 63));
    return (x & 1ull) != 0ull;
}
__device__ __forceinline__ float xmax16_32(float v) {
    auto a = __builtin_amdgcn_permlane16_swap(__float_as_uint(v), __float_as_uint(v), false, false);
    v = fmaxf(__uint_as_float(a[0]), __uint_as_float(a[1]));
    auto b = __builtin_amdgcn_permlane32_swap(__float_as_uint(v), __float_as_uint(v), false, false);
    return fmaxf(__uint_as_float(b[0]), __uint_as_float(b[1]));
}
__device__ __forceinline__ float xsum16_32(float v) {
    auto a = __builtin_amdgcn_permlane16_swap(__float_as_uint(v), __float_as_uint(v), false, false);
    v = __uint_as_float(a[0]) + __uint_as_float(a[1]);
    auto b = __builtin_amdgcn_permlane32_swap(__float_as_uint(v), __float_as_uint(v), false, false);
    return __uint_as_float(b[0]) + __uint_as_float(b[1]);
}

template <int BR>
__device__ __forceinline__ void nsa_flash(const NsaCtx& c, const bf16_t* Kg, const bf16_t* Vg, int stride, int tile_lo, int tile_hi, const unsigned (&selw)[2][4],
                                          float (&m)[2], float (&l)[2], f32x4 (&O)[2][4]) {
    if (tile_lo > tile_hi) return;
    KVREGS;
    __syncthreads();
    nsa_gload(c, KVARGS, Kg, Vg, stride, tile_lo);
    nsa_lstore(c, KVARGS, c.lds);
    __syncthreads();
    for (int tile = tile_lo; tile <= tile_hi; ++tile) {
        char* cur = c.lds + ((tile - tile_lo) & 1) * 16384;
        if (tile < tile_hi) nsa_gload(c, KVARGS, Kg, Vg, stride, tile + 1);
        __builtin_amdgcn_sched_barrier(0);
        bool need = true;
        bool rok0 = true, rok1 = true;
        if (BR == 1) {
            rok0 = selbit4(selw[0], tile); rok1 = selbit4(selw[1], tile);
            need = __ballot(rok0 || rok1) != 0ull;
        }
        if (need) {
            f32x4 s[2][4];
            nsa_qk(c, cur, s);
            const int t0w = c.tq[0] & ~31;
            const bool bnd = (tile == (t0w >> 6)) || (BR == 2 && tile * 64 + 480 < t0w);
            if (bnd) {
#pragma unroll
                for (int qt = 0; qt < 2; ++qt) {
                    const int t = c.tq[qt];
                    const bool rowok = (qt == 0) ? rok0 : rok1;
                    float tmax = -1e30f;
#pragma unroll
                    for (int kt = 0; kt < 4; ++kt)
#pragma unroll
                        for (int r = 0; r < 4; ++r) {
                            const int kap = tile * 64 + kt * 16 + 4 * c.fq + r;
                            bool ok = rowok && (kap <= t);
                            if (BR == 2) ok = ok && (kap + 511 >= t);
                            const float v = ok ? s[qt][kt][r] : -1e30f;
                            s[qt][kt][r] = v; tmax = fmaxf(tmax, v);
                        }
                    tmax = xmax16_32(tmax);
                    const float mn = fmaxf(m[qt], tmax);
                    const float alpha = fast_exp2(m[qt] - mn);
                    m[qt] = mn;
                    float rs = 0.f;
#pragma unroll
                    for (int kt = 0; kt < 4; ++kt)
#pragma unroll
                        for (int r = 0; r < 4; ++r) { const float v = s[qt][kt][r]; const float pv = (v > -1e29f) ? fast_exp2(v - mn) : 0.f; s[qt][kt][r] = pv; rs += pv; }
                    l[qt] = l[qt] * alpha + rs;
#pragma unroll
                    for (int dt = 0; dt < 4; ++dt) O[qt][dt] *= alpha;
                }
            } else {
                float tm[2];
#pragma unroll
                for (int qt = 0; qt < 2; ++qt) {
                    float a0 = fmaxf(fmaxf(s[qt][0][0], s[qt][0][1]), fmaxf(s[qt][0][2], s[qt][0][3]));
#pragma unroll
                    for (int kt = 1; kt < 4; ++kt) a0 = fmaxf(a0, fmaxf(fmaxf(s[qt][kt][0], s[qt][kt][1]), fmaxf(s[qt][kt][2], s[qt][kt][3])));
                    const bool rowok = (qt == 0) ? rok0 : rok1;
                    tm[qt] = xmax16_32(rowok ? a0 : -1e30f);
                }
                const bool grow = __ballot((tm[0] > m[0]) || (tm[1] > m[1])) != 0ull;
                if (grow) {
#pragma unroll
                    for (int qt = 0; qt < 2; ++qt) {
                        const float mn = fmaxf(m[qt], tm[qt]);
                        const float alpha = fast_exp2(m[qt] - mn);
                        m[qt] = mn; l[qt] *= alpha;
#pragma unroll
                        for (int dt = 0; dt < 4; ++dt) O[qt][dt] *= alpha;
                    }
                }
#pragma unroll
                for (int qt = 0; qt < 2; ++qt) {
                    const bool rowok = (qt == 0) ? rok0 : rok1;
                    const float msub = rowok ? m[qt] : 3e38f;
                    float rs = 0.f;
#pragma unroll
                    for (int kt = 0; kt < 4; ++kt)
#pragma unroll
                        for (int r = 0; r < 4; ++r) { const float pv = fast_exp2(s[qt][kt][r] - msub); s[qt][kt][r] = pv; rs += pv; }
                    l[qt] += rs;
                }
            }
            nsa_pv(c, cur, s, O);
        }
        if (tile < tile_hi) nsa_lstore(c, KVARGS, c.lds + ((tile - tile_lo + 1) & 1) * 16384);
        __syncthreads();
    }
}
template <bool NORM, int MODE>
__device__ __forceinline__ void nsa_accum(const NsaCtx& c, const float (&gate)[2], const float (&l)[2], const f32x4 (&O)[2][4], bf16_t* const (&yrow)[2]) {
#pragma unroll
    for (int qt = 0; qt < 2; ++qt) {
        float inv = 1.0f;
        if (NORM) { const float lt = xsum16_32(l[qt]); inv = (lt > 0.f) ? 1.0f / lt : 0.f; }
        inv *= gate[qt];
        float* acc = (float*)(c.lds + 32768) + (c.wave * 32 + qt * 16 + c.li) * 64 + 4 * c.fq;
#pragma unroll
        for (int dt = 0; dt < 4; ++dt) {
            f32x4 v = O[qt][dt] * inv;
            if (MODE >= 1) v += *(const f32x4*)(acc + dt * 16);
            if (MODE <= 1) *(f32x4*)(acc + dt * 16) = v;
            else { uint2 w; w.x = cvtpk(v[0], v[1]); w.y = cvtpk(v[2], v[3]); *(uint2*)(yrow[qt] + dt * 16) = w; }
        }
    }
}

__device__ __forceinline__ void ph_nsa_fast(const Params& p, float* sm, int bid, int nb) {
    NsaCtx c;
    c.lds = (char*)sm; c.tid = threadIdx.x; c.lane = c.tid & 63; c.wave = c.tid >> 6; c.fr = c.lane & 15; c.fq = c.lane >> 4; c.li = c.lane & 15;
    float* impA = (float*)(c.lds + 32768); float* impE = (float*)(c.lds + 49152); unsigned* selm = (unsigned*)(c.lds + 49152);
    int* wq = (int*)sm + 16384 + 300;
    for (;;) {
        __syncthreads();
        if (c.tid == 0) *wq = atomicAdd(p.CNT + 256, 1);
        __syncthreads();
        const int u = *wq;
        if (u >= 1024) break;
        const int tt = 255 - (u >> 2), b = (u >> 1) & 1, g = u & 1, t0 = tt * 32;
        const int head = c.li & 3;
#pragma unroll
        for (int qt = 0; qt < 2; ++qt) {
            c.tq[qt] = t0 + c.wave * 8 + qt * 4 + (c.li >> 2);
            const bf16_t* qrow = p.Qb + (size_t)(b * S + c.tq[qt]) * 512 + (g * 4 + head) * 64 + 8 * c.fq;
            c.qf[qt][0] = *(const s16x8*)qrow; c.qf[qt][1] = *(const s16x8*)(qrow + 32);
        }
        unsigned selw[2][4];
        float gt0[2], gt1[2], gt2[2];
        bf16_t* yrow[2];
#pragma unroll
        for (int qt = 0; qt < 2; ++qt) {
#pragma unroll
            for (int w = 0; w < 4; ++w) selw[qt][w] = 0u;
            const float* gp = p.GT + (size_t)(b * S + c.tq[qt]) * 24 + (g * 4 + head) * 3;
            gt0[qt] = gp[0]; gt1[qt] = gp[1]; gt2[qt] = gp[2];
            yrow[qt] = p.YBb + (size_t)(b * S + c.tq[qt]) * 512 + (g * 4 + head) * 64 + 4 * c.fq;
        }
        f32x4 Oc[2][4];
#if 1
        {
            const bf16_t* Kg = p.KCb + (size_t)((b * 2 + g) * 512) * 64; const bf16_t* Vg = p.VCb + (size_t)((b * 2 + g) * 512) * 64;
            const int tl = t0 + 31; const int nvmax = (tl >= 31) ? ((tl - 31) >> 4) + 1 : 0; const int ntile = (nvmax + 63) >> 6;
            float m[2] = {-1e30f, -1e30f}, l[2] = {0.f, 0.f};
#pragma unroll
            for (int qt = 0; qt < 2; ++qt)
#pragma unroll
                for (int dt = 0; dt < 4; ++dt) Oc[qt][dt] = (f32x4){0.f, 0.f, 0.f, 0.f};
            __syncthreads();
            for (int i = c.tid; i < 32 * 128; i += NT) { impA[i] = 0.f; impE[i] = 0.f; }
            KVREGS;
            for (int pass = 0; pass < 2; ++pass) {
                float linv[2] = {0.f, 0.f};
                if (pass == 1) {
#pragma unroll
                    for (int qt = 0; qt < 2; ++qt) { const float lt = xsum16_32(l[qt]); linv[qt] = (lt > 0.f) ? 1.0f / lt : 0.f; }
                }
                if (ntile > 0) {
                    __syncthreads();
                    nsa_gload(c, KVARGS, Kg, Vg, 64, 0); nsa_lstore(c, KVARGS, c.lds); __syncthreads();
                    for (int tile = 0; tile < ntile; ++tile) {
                        char* cur = c.lds + (tile & 1) * 16384;
                        if (tile + 1 < ntile) nsa_gload(c, KVARGS, Kg, Vg, 64, tile + 1);
                        __builtin_amdgcn_sched_barrier(0);
                        f32x4 s[2][4];
                        nsa_qk(c, cur, s);
#pragma unroll
                        for (int qt = 0; qt < 2; ++qt) {
                            const int t = c.tq[qt];
                            if (pass == 0) {
                                float tmax = -1e30f;
#pragma unroll
                                for (int kt = 0; kt < 4; ++kt)
#pragma unroll
                                    for (int r = 0; r < 4; ++r) { const int cc = tile * 64 + kt * 16 + 4 * c.fq + r; const float v = (16 * cc + 31 <= t) ? s[qt][kt][r] : -1e30f; s[qt][kt][r] = v; tmax = fmaxf(tmax, v); }
                                tmax = xmax16_32(tmax);
                                const float mn = fmaxf(m[qt], tmax); const float alpha = fast_exp2(m[qt] - mn); m[qt] = mn;
                                float rs = 0.f;
#pragma unroll
                                for (int kt = 0; kt < 4; ++kt)
#pragma unroll
                                    for (int r = 0; r < 4; ++r) { const float v = s[qt][kt][r]; rs += (v > -1e29f) ? fast_exp2(v - mn) : 0.f; }
                                l[qt] = l[qt] * alpha + rs;
                            } else {
#pragma unroll
                                for (int kt = 0; kt < 4; ++kt) {
#pragma unroll
                                    for (int r = 0; r < 4; ++r) { const int cc = tile * 64 + kt * 16 + 4 * c.fq + r; s[qt][kt][r] = (16 * cc + 31 <= t) ? fast_exp2(s[qt][kt][r] - m[qt]) * linv[qt] : 0.f; }
                                    float e = s[qt][kt][3];
                                    float a = 2.0f * ((s[qt][kt][0] + s[qt][kt][1]) + (s[qt][kt][2] + e)) - e;
                                    a += __shfl_xor(a, 1); a += __shfl_xor(a, 2); e += __shfl_xor(e, 1); e += __shfl_xor(e, 2);
                                    if (head == 0) { const int j = tile * 16 + kt * 4 + c.fq; const int tokl = c.wave * 8 + qt * 4 + (c.li >> 2); impA[tokl * 128 + j] = a; impE[tokl * 128 + j] = e; }
                                }
                            }
                        }
                        if (pass == 1) nsa_pv(c, cur, s, Oc);
                        if (tile + 1 < ntile) nsa_lstore(c, KVARGS, c.lds + ((tile + 1) & 1) * 16384);
                        __syncthreads();
                    }
                }
            }
        }
#endif
#if 1
        {
            __syncthreads();
            float scv[16];
#pragma unroll
            for (int i = 0; i < 16; ++i) {
                const int e = c.tid + 256 * i, tok = e >> 7, j = e & 127; const int t = t0 + tok, cur = t >> 6;
                const bool valid = (j <= cur), forced = (j == 0) || (j == cur) || (j == cur - 1);
                scv[i] = valid ? (impA[e] + ((j > 0) ? impE[e - 1] : 0.f) + (forced ? 1e4f : 0.f)) : -1.0f;
            }
            __syncthreads();
#pragma unroll
            for (int i = 0; i < 16; ++i) impA[c.tid + 256 * i] = scv[i];
            __syncthreads();
#pragma unroll 1
            for (int ti = 0; ti < 8; ++ti) {
                const int tok = c.wave * 8 + ti;
                const float f0 = impA[tok * 128 + c.lane], f1 = impA[tok * 128 + 64 + c.lane];
                const unsigned k0 = (f0 >= 0.f) ? __float_as_uint(f0) + 1u : 0u, k1 = (f1 >= 0.f) ? __float_as_uint(f1) + 1u : 0u;
                unsigned T = 0u;
#pragma unroll 1
                for (int bit = 31; bit >= 0; --bit) {
                    const unsigned cand = T | (1u << bit);
                    const int cnt = __popcll(__ballot(k0 >= cand)) + __popcll(__ballot(k1 >= cand));
                    if (cnt >= 16) T = cand;
                }
                const bool g0 = k0 > T, g1 = k1 > T;
                const int need = 16 - (__popcll(__ballot(g0)) + __popcll(__ballot(g1)));
                const bool e0 = (k0 == T) && (k0 != 0u), e1 = (k1 == T) && (k1 != 0u);
                const unsigned long long be0 = __ballot(e0), be1 = __ballot(e1);
                const unsigned long long lt = (1ull << c.lane) - 1ull;
                const bool s0 = g0 || (e0 && __popcll(be0 & lt) < need);
                const bool s1 = g1 || (e1 && __popcll(be0) + __popcll(be1 & lt) < need);
                const unsigned long long m0 = __ballot(s0), m1 = __ballot(s1);
                if (c.lane == 0) { selm[tok * 4 + 0] = (unsigned)m0; selm[tok * 4 + 1] = (unsigned)(m0 >> 32); selm[tok * 4 + 2] = (unsigned)m1; selm[tok * 4 + 3] = (unsigned)(m1 >> 32); }
            }
            __syncthreads();
#pragma unroll
            for (int qt = 0; qt < 2; ++qt) {
                const int tokl = c.wave * 8 + qt * 4 + (c.li >> 2);
#pragma unroll
                for (int w = 0; w < 4; ++w) selw[qt][w] = selm[tokl * 4 + w];
            }
            __syncthreads();
            { const float dummy[2] = {0.f, 0.f}; nsa_accum<false, 0>(c, gt0, dummy, Oc, yrow); }
        }
#endif
#if 1
        {
            float m[2] = {-1e30f, -1e30f}, l[2] = {0.f, 0.f};
            f32x4 O[2][4];
#pragma unroll
            for (int qt = 0; qt < 2; ++qt)
#pragma unroll
                for (int dt = 0; dt < 4; ++dt) O[qt][dt] = (f32x4){0.f, 0.f, 0.f, 0.f};
            nsa_flash<1>(c, p.KSb + (size_t)(b * S) * 128 + g * 64, p.VSb + (size_t)(b * S) * 128 + g * 64, 128, 0, (t0 + 31) >> 6, selw, m, l, O);
            nsa_accum<true, 1>(c, gt1, l, O, yrow);
        }
#endif
#if 1
        {
            float m[2] = {-1e30f, -1e30f}, l[2] = {0.f, 0.f};
            f32x4 O[2][4];
#pragma unroll
            for (int qt = 0; qt < 2; ++qt)
#pragma unroll
                for (int dt = 0; dt < 4; ++dt) O[qt][dt] = (f32x4){0.f, 0.f, 0.f, 0.f};
            const int lo = (t0 >= 511) ? ((t0 - 511) >> 6) : 0;
            nsa_flash<2>(c, p.KWb + (size_t)(b * S) * 128 + g * 64, p.VWb + (size_t)(b * S) * 128 + g * 64, 128, lo, (t0 + 31) >> 6, selw, m, l, O);
            nsa_accum<true, 2>(c, gt2, l, O, yrow);
        }
#endif
    }
}
__device__ __forceinline__ void ph_branch_a(const Params& p, float* sm, int bid, int nb) {
    const bf16_t* P = p.P; float* Z = p.Z; const bf16_t* YA = p.YAb;
    XCD_TILE_LOOP(T / 128, D / 128) {
        const int m0 = tm_ * 128, n0 = tn_ * 128;
        auto ar = [&](int r) { return (const void*)(YA + (size_t)(m0 + r) * 512); };
        auto bc = [&](int c) { return n0 + c; };
        auto ep = [&](int m, int n, f32x4 v) {
            const size_t r = m0 + m; const int c = n0 + n;
            const uint2 gw = *(const uint2*)(P + r * INW + C_GA + c); const f32x4 gq = {bf2f(gw.x & 0xffff), bf2f(gw.x >> 16), bf2f(gw.y & 0xffff), bf2f(gw.y >> 16)};
            f32x4 o;
#pragma unroll
            for (int j = 0; j < 4; ++j) o[j] = sigmoidf_(gq[j]) * v[j];
            *(f32x4*)(Z + r * D + c) = o;
        };
        mgemm_unit<false, false>((char*)sm, 512, ar, p.WBAb, D, bc, ep);
    }
}
__device__ __forceinline__ void ph_branch_b(const Params& p, float* sm, int bid, int nb) {
    const bf16_t* P = p.P; float* Z = p.Z; const bf16_t* YB = p.YBb; bf16_t* Zb = p.Zb;
    XCD_TILE_LOOP(T / 128, D / 128) {
        const int m0 = tm_ * 128, n0 = tn_ * 128;
        auto ar = [&](int r) { return (const void*)(YB + (size_t)(m0 + r) * 512); };
        auto bc = [&](int c) { return n0 + c; };
        auto ep = [&](int m, int n, f32x4 v) {
            const size_t r = m0 + m; const int c = n0 + n;
            const uint2 gw = *(const uint2*)(P + r * INW + C_GB + c); const f32x4 gq = {bf2f(gw.x & 0xffff), bf2f(gw.x >> 16), bf2f(gw.y & 0xffff), bf2f(gw.y >> 16)};
            f32x4 o = *(const f32x4*)(Z + r * D + c);
#pragma unroll
            for (int j = 0; j < 4; ++j) o[j] += sigmoidf_(gq[j]) * v[j];
            uint2 w; w.x = cvtpk(o[0], o[1]); w.y = cvtpk(o[2], o[3]);
            *(uint2*)(Zb + r * D + c) = w;
        };
        mgemm_unit<false, false>((char*)sm, 512, ar, p.WBBb, D, bc, ep);
    }
}
__device__ __forceinline__ void ph_outproj(const Params& p, float* sm, int bid, int nb) {
    const float* x = p.x; float* PRE1 = p.PRE1; const bf16_t* Z = p.Zb;
    XCD_TILE_LOOP(T / 128, D / 128) {
        const int m0 = tm_ * 128, n0 = tn_ * 128;
        auto ar = [&](int r) { return (const void*)(Z + (size_t)(m0 + r) * D); };
        auto bc = [&](int c) { return n0 + c; };
        auto ep = [&](int m, int n, f32x4 v) {
            const size_t r = m0 + m; const int c = n0 + n;
            const f32x4 xv = *(const f32x4*)(x + r * D + c);
            *(f32x4*)(PRE1 + r * D + c) = xv * ALPHA + v;
        };
        mgemm_unit<false, false>((char*)sm, D, ar, p.WOUTb, D, bc, ep);
    }
}
__device__ __forceinline__ void ln_rows(float* sm, int bid, int nb, const float* src, float* dst, unsigned short* dstb, const float* gam, const float* bet) {
    const int tid = threadIdx.x, wave = tid >> 6, lane = tid & 63;
    for (int t = bid; t < T; t += nb) {
        const float4 v = *(const float4*)(src + (size_t)t * D + tid * 4);
        float s = (v.x + v.y) + (v.z + v.w);
        s = wave_sum(s);
        __syncthreads();
        if (lane == 0) sm[wave] = s;
        __syncthreads();
        const float mean = (sm[0] + sm[1] + sm[2] + sm[3]) * (1.0f / D);
        const float dx = v.x - mean, dy = v.y - mean, dz = v.z - mean, dw = v.w - mean;
        float q = (dx * dx + dy * dy) + (dz * dz + dw * dw);
        q = wave_sum(q);
        __syncthreads();
        if (lane == 0) sm[wave] = q;
        __syncthreads();
        const float rstd = rsqrtf((sm[0] + sm[1] + sm[2] + sm[3]) * (1.0f / D) + 1e-5f);
        const float4 gq = *(const float4*)(gam + tid * 4), bq = *(const float4*)(bet + tid * 4);
        const float4 o = make_float4(dx * rstd * gq.x + bq.x, dy * rstd * gq.y + bq.y, dz * rstd * gq.z + bq.z, dw * rstd * gq.w + bq.w);
        *(float4*)(dst + (size_t)t * D + tid * 4) = o;
        uint2 w; w.x = cvtpk(o.x, o.y); w.y = cvtpk(o.z, o.w);
        *(uint2*)(dstb + (size_t)t * D + tid * 4) = w;
    }
}
__device__ __forceinline__ void ph_ln1(const Params& p, float* sm, int bid, int nb) { ln_rows(sm, bid, nb, p.PRE1, p.X1, p.X1b, p.ln1g, p.ln1b); }

__device__ __forceinline__ void ph_router_gemm(const Params& p, float* sm, int bid, int nb) {
    float* L = p.LOGITS; const bf16_t* X1 = p.X1b;
    XCD_TILE_LOOP(T / 128, 2) {
        const int m0 = tm_ * 128, n0 = tn_ * 128;
        auto ar = [&](int r) { return (const void*)(X1 + (size_t)(m0 + r) * D); };
        auto bc = [&](int c) { return n0 + c; };
        auto ep = [&](int m, int n, f32x4 v) { *(f32x4*)(L + (size_t)(m0 + m) * NE + n0 + n) = v; };
        mgemm_unit<false, false>((char*)sm, D, ar, p.RWb, NE, bc, ep);
    }
}
__device__ __forceinline__ void ph_router_sel(const Params& p, float* sm, int bid, int nb) {
    const int tid = threadIdx.x, lane = tid & 63, wave = tid >> 6;
    const float4 bias4 = *(const float4*)(p.rbias + lane * 4);
    for (int t = bid * 4 + wave; t < T; t += nb * 4) {
        const float4 lg = *(const float4*)(p.LOGITS + (size_t)t * NE + lane * 4);
        float sc[4] = {sigmoidf_(lg.x), sigmoidf_(lg.y), sigmoidf_(lg.z), sigmoidf_(lg.w)};
        float ch[4] = {sc[0] + bias4.x, sc[1] + bias4.y, sc[2] + bias4.z, sc[3] + bias4.w};
        float m1 = fmaxf(fmaxf(ch[0], ch[1]), fmaxf(ch[2], ch[3]));
        float m2;
        {
            const float a = fmaxf(ch[0], ch[1]), b = fminf(ch[0], ch[1]), c = fmaxf(ch[2], ch[3]), d = fminf(ch[2], ch[3]);
            m2 = fmaxf(fminf(a, c), fmaxf(b, d));
        }
#pragma unroll
        for (int o = 1; o < 8; o <<= 1) {
            const float o1 = __shfl_xor(m1, o), o2 = __shfl_xor(m2, o);
            const float n1 = fmaxf(m1, o1), n2 = fmaxf(fminf(m1, o1), fmaxf(m2, o2));
            m1 = n1; m2 = n2;
        }
        const float gs = m1 + m2;
        const int grp = lane >> 3;
        int grank = 0;
#pragma unroll
        for (int g = 0; g < 8; ++g) { const float og = __shfl(gs, g * 8); grank += (og > gs || (og == gs && g < grp)) ? 1 : 0; }
        const bool gsel = grank < 4;
        float mc[4];
#pragma unroll
        for (int j = 0; j < 4; ++j) mc[j] = gsel ? ch[j] : -1e30f;
        int myk = -1; float mysc = 0.f, wsum = 0.f;
#pragma unroll 1
        for (int k = 0; k < 8; ++k) {
            float bv = mc[0]; int bi = lane * 4;
#pragma unroll
            for (int j = 1; j < 4; ++j) if (mc[j] > bv) { bv = mc[j]; bi = lane * 4 + j; }
#pragma unroll
            for (int o = 1; o < 64; o <<= 1) {
                const float ov = __shfl_xor(bv, o); const int oi = __shfl_xor(bi, o);
                if (ov > bv || (ov == bv && oi < bi)) { bv = ov; bi = oi; }
            }
            const int own = bi >> 2, jj = bi & 3;
            const float wsc = __shfl((jj == 0) ? sc[0] : (jj == 1) ? sc[1] : (jj == 2) ? sc[2] : sc[3], own);
            if (lane == own) { if (jj == 0) mc[0] = -3e38f; else if (jj == 1) mc[1] = -3e38f; else if (jj == 2) mc[2] = -3e38f; else mc[3] = -3e38f; }
            if (lane == k) { myk = bi; mysc = wsc; }
            wsum += wsc;
        }
        if (lane < 8) {
            const int a = t * 8 + lane;
            p.EIDX[a] = myk;
            p.EW[a] = mysc / wsum * 2.5f;
            const int pos = atomicAdd(p.CNT + myk, 1);
            if (pos < LISTCAP) p.LIST[(size_t)myk * LISTCAP + pos] = a;
        }
    }
}
__device__ __forceinline__ int moe_tile_prefix(const Params& p, int* pre) {
    const int tid = threadIdx.x;
    __syncthreads();
    int c = __hip_atomic_load(p.CNT + tid, __ATOMIC_RELAXED, __HIP_MEMORY_SCOPE_AGENT); if (c > LISTCAP) c = LISTCAP;
    pre[tid + 1] = (c + 127) >> 7;
    if (tid == 0) pre[0] = 0;
    __syncthreads();
    if (tid == 0) { int a = 0; for (int i = 1; i <= 256; ++i) { a += pre[i]; pre[i] = a; } }
    __syncthreads();
    return pre[256];
}
__device__ __forceinline__ int moe_find_expert(const int* pre, int tile) {
    int lo = 0, hi = 255;
    while (lo < hi) { const int mid = (lo + hi + 1) >> 1; if (pre[mid] <= tile) lo = mid; else hi = mid - 1; }
    return lo;
}
__device__ __forceinline__ int glu_col(int j0, int c) { const int wn = c >> 6, ni = (c >> 4) & 3, x = c & 15; return ((ni >> 1) ? 256 : 0) + j0 + wn * 32 + (ni & 1) * 16 + x; }
__device__ __forceinline__ void ph_moe_gu(const Params& p, float* sm, int bid, int nb) {
    int* pre = (int*)sm + 16384;
    int* px = (int*)sm + 16384 + 260;
    (void)moe_tile_prefix(p, pre);
    const int x = bid & 7, par = x >> 2, j0 = (x & 3) * 64;
    if (threadIdx.x == 0) { int a_ = 0; px[0] = 0; for (int i = 0; i < 128; ++i) { a_ += pre[par + 2 * i + 1] - pre[par + 2 * i]; px[i + 1] = a_; } }
    __syncthreads();
    const int nun = px[128];
    for (int ul = bid >> 3; ul < nun; ul += nb >> 3) {
        int lo = 0, hi = 127;
        while (lo < hi) { const int mid = (lo + hi + 1) >> 1; if (px[mid] <= ul) lo = mid; else hi = mid - 1; }
        const int e = par + 2 * lo, mt = ul - px[lo];
        int cnt = __hip_atomic_load(p.CNT + e, __ATOMIC_RELAXED, __HIP_MEMORY_SCOPE_AGENT); if (cnt > LISTCAP) cnt = LISTCAP;
        const int* lst = p.LIST + (size_t)e * LISTCAP + mt * 128;
        const int nrow = cnt - mt * 128;
        const bf16_t* X1 = p.X1b; bf16_t* ACT = p.ACT;
        int* rowA = (int*)sm + 16384 + 512;
        __syncthreads();
        if (threadIdx.x < 128) rowA[threadIdx.x] = lst[(int)threadIdx.x < nrow ? threadIdx.x : 0];
        auto ar = [&](int r) { return (const void*)(X1 + (size_t)(lst[r < nrow ? r : 0] >> 3) * D); };
        auto bc = [&](int c) { return glu_col(j0, c); };
        auto ep = [&](int m, int n, f32x4 v) { if (m < nrow) { const int a = rowA[m]; uint2 w; w.x = cvtpk(v[0], v[1]); w.y = cvtpk(v[2], v[3]); *(uint2*)(ACT + (size_t)a * 256 + j0 + n) = w; } };
        mgemm_unit<true, true>((char*)sm, D, ar, p.egu + (size_t)e * D * 512, 512, bc, ep);
    }
}
__device__ __forceinline__ void ph_moe_down(const Params& p, float* sm, int bid, int nb) {
    int* pre = (int*)sm + 16384;
    const int ntile = moe_tile_prefix(p, pre);
    for (int u = bid; u < ntile * 8; u += nb) {
        const int tile = u >> 3, n0 = (u & 7) * 128;
        const int e = moe_find_expert(pre, tile), mt = tile - pre[e];
        int cnt = __hip_atomic_load(p.CNT + e, __ATOMIC_RELAXED, __HIP_MEMORY_SCOPE_AGENT); if (cnt > LISTCAP) cnt = LISTCAP;
        const int* lst = p.LIST + (size_t)e * LISTCAP + mt * 128;
        const int nrow = cnt - mt * 128;
        const bf16_t* ACT = p.ACT; bf16_t* Y = p.Y; const float* EW = p.EW;
        int* rowA = (int*)sm + 16384 + 512; float* rowW = (float*)sm + 16384 + 640;
        __syncthreads();
        if (threadIdx.x < 128) { const int a_ = lst[(int)threadIdx.x < nrow ? threadIdx.x : 0]; rowA[threadIdx.x] = a_; rowW[threadIdx.x] = EW[a_]; }
        auto ar = [&](int r) { return (const void*)(ACT + (size_t)lst[r < nrow ? r : 0] * 256); };
        auto bc = [&](int c) { return n0 + c; };
        auto ep = [&](int m, int n, f32x4 v) { if (m < nrow) { const int a = rowA[m]; const float w = rowW[m]; uint2 o; o.x = cvtpk(v[0] * w, v[1] * w); o.y = cvtpk(v[2] * w, v[3] * w); *(uint2*)(Y + (size_t)a * D + n0 + n) = o; } };
        mgemm_unit<true, false>((char*)sm, 256, ar, p.edown + (size_t)e * 256 * D, D, bc, ep);
    }
}
__device__ __forceinline__ void ph_shared_gu(const Params& p, float* sm, int bid, int nb) {
    const bf16_t* X1 = p.X1b; bf16_t* ACTS = p.ACTS;
    XCD_TILE_LOOP(T / 128, 4) {
        const int m0 = tm_ * 128, j0 = tn_ * 64;
        auto ar = [&](int r) { return (const void*)(X1 + (size_t)(m0 + r) * D); };
        auto bc = [&](int c) { return glu_col(j0, c); };
        auto ep = [&](int m, int n, f32x4 v) { uint2 w; w.x = cvtpk(v[0], v[1]); w.y = cvtpk(v[2], v[3]); *(uint2*)(ACTS + (size_t)(m0 + m) * 256 + j0 + n) = w; };
        mgemm_unit<false, true>((char*)sm, D, ar, p.SGUb, 512, bc, ep);
    }
}
__device__ __forceinline__ void ph_shared_down(const Params& p, float* sm, int bid, int nb) {
    const bf16_t* ACTS = p.ACTS; float* SH = p.SH;
    XCD_TILE_LOOP(T / 128, 8) {
        const int m0 = tm_ * 128, n0 = tn_ * 128;
        auto ar = [&](int r) { return (const void*)(ACTS + (size_t)(m0 + r) * 256); };
        auto bc = [&](int c) { return n0 + c; };
        auto ep = [&](int m, int n, f32x4 v) { *(f32x4*)(SH + (size_t)(m0 + m) * D + n0 + n) = v; };
        mgemm_unit<false, false>((char*)sm, 256, ar, p.SDOWNb, D, bc, ep);
    }
}
__device__ __forceinline__ void ph_final(const Params& p, float* sm, int bid, int nb) {
    const int tid = threadIdx.x, wave = tid >> 6, lane = tid & 63;
    for (int t = bid; t < T; t += nb) {
        const float4 xv = *(const float4*)(p.X1 + (size_t)t * D + tid * 4);
        float4 v = *(const float4*)(p.SH + (size_t)t * D + tid * 4);
        float4 r = make_float4(0.f, 0.f, 0.f, 0.f);
#pragma unroll
        for (int k = 0; k < 8; ++k) { const uint2 y = *(const uint2*)(p.Y + ((size_t)t * 8 + k) * D + tid * 4); r.x += bf2f(y.x & 0xffff); r.y += bf2f(y.x >> 16); r.z += bf2f(y.y & 0xffff); r.w += bf2f(y.y >> 16); }
        v.x = ALPHA * xv.x + (r.x + v.x); v.y = ALPHA * xv.y + (r.y + v.y); v.z = ALPHA * xv.z + (r.z + v.z); v.w = ALPHA * xv.w + (r.w + v.w);
        float s = (v.x + v.y) + (v.z + v.w);
        s = wave_sum(s);
        __syncthreads();
        if (lane == 0) sm[wave] = s;
        __syncthreads();
        const float mean = (sm[0] + sm[1] + sm[2] + sm[3]) * (1.0f / D);
        const float dx = v.x - mean, dy = v.y - mean, dz = v.z - mean, dw = v.w - mean;
        float q = (dx * dx + dy * dy) + (dz * dz + dw * dw);
        q = wave_sum(q);
        __syncthreads();
        if (lane == 0) sm[wave] = q;
        __syncthreads();
        const float rstd = rsqrtf((sm[0] + sm[1] + sm[2] + sm[3]) * (1.0f / D) + 1e-5f);
        const float4 gq = *(const float4*)(p.ln2g + tid * 4), bq = *(const float4*)(p.ln2b + tid * 4);
        *(float4*)(p.out + (size_t)t * D + tid * 4) = make_float4(dx * rstd * gq.x + bq.x, dy * rstd * gq.y + bq.y, dz * rstd * gq.z + bq.z, dw * rstd * gq.w + bq.w);
    }
}

constexpr int SM_FLOATS = 16384 + 768 + 4;

#define DEF_KERNEL(name) \
    __global__ void __launch_bounds__(NT) k_##name(Params p) { __shared__ __attribute__((aligned(16))) float sm[SM_FLOATS]; ph_##name(p, sm, (int)blockIdx.x, (int)gridDim.x); }


#define XB_TMO      128
#define XB_XCNT(j)  (256  + 64 * (j))
#define XB_XSUB(j)  (1280 + 64 * (j))
#define XB_XGEN(j)  (2304 + 64 * (j))
#define XB_TOP      3328
#define XB_TOPGEN   3392
#define XCD_BAR_WORDS 3456
#define XB_SPIN_CAP (1u << 18)
__device__ __forceinline__ unsigned xb_ld(unsigned* p)              { return __hip_atomic_load(p, __ATOMIC_RELAXED, __HIP_MEMORY_SCOPE_AGENT); }
__device__ __forceinline__ unsigned xb_add(unsigned* p, unsigned v) { return __hip_atomic_fetch_add(p, v, __ATOMIC_RELAXED, __HIP_MEMORY_SCOPE_AGENT); }
__device__ __forceinline__ unsigned xb_xcc_id() { return (unsigned)__builtin_amdgcn_s_getreg((3 << 11) | 20) & 0xFu; }
#define XB_SPIN(cond, bar) do { unsigned _sp = 0; while (cond) { __builtin_amdgcn_s_sleep(1); \
    if ((++_sp & 255u) == 0u) { if (xb_ld(&(bar)[XB_TMO])) break; if (_sp > XB_SPIN_CAP) { atomicAdd(&(bar)[XB_TMO], 1u); break; } } } } while (0)
struct XcdBarrier { unsigned* bar; unsigned x; volatile LAS unsigned* st; };
__device__ __forceinline__ XcdBarrier xcd_barrier_post(unsigned* bar, volatile LAS unsigned* st) {
    XcdBarrier b; b.bar = bar; b.x = xb_xcc_id(); b.st = st;
    if (threadIdx.x == 0) (void)xb_add(&bar[XB_XCNT(b.x)], 1u);
    return b;
}
__device__ __forceinline__ void xcd_barrier_complete(unsigned* bar, unsigned x, unsigned& nloc, unsigned& nx) {
    const unsigned G = gridDim.x * gridDim.y * gridDim.z;
    unsigned sum, cnt, mine, sp = 0u;
    for (;;) {
        sum = 0u; cnt = 0u; mine = 0u;
#pragma unroll
        for (unsigned j = 0; j < 16; ++j) { const unsigned c = xb_ld(&bar[XB_XCNT(j)]); sum += c; cnt += (c > 0u) ? 1u : 0u; mine = (j == x) ? c : mine; }
        if (sum == G) break;
        __builtin_amdgcn_s_sleep(1);
        if ((++sp & 255u) == 0u) { if (xb_ld(&bar[XB_TMO])) break; if (sp > XB_SPIN_CAP) { atomicAdd(&bar[XB_TMO], 1u); break; } }
    }
    nloc = mine > 0u ? mine : 1u; nx = cnt > 0u ? cnt : 1u;
}
__device__ __forceinline__ void xcd_barrier(const XcdBarrier& b) {
    asm volatile("s_waitcnt vmcnt(0)" ::: "memory");
    __syncthreads();
    if (threadIdx.x == 0) {
        unsigned* bar = b.bar;
        __builtin_amdgcn_s_waitcnt(0);
        unsigned nloc = b.st[0], nx = b.st[1];
        if (nloc == 0u) { xcd_barrier_complete(bar, b.x, nloc, nx); b.st[0] = nloc; b.st[1] = nx; }
        const unsigned old = xb_add(&bar[XB_XSUB(b.x)], 1u);
        const unsigned gen = old / nloc;
        if (old + 1u == (gen + 1u) * nloc) {
            __builtin_amdgcn_fence(__ATOMIC_RELEASE, "agent");
            asm volatile("s_waitcnt vmcnt(0)" ::: "memory");
            const unsigned og = xb_add(&bar[XB_TOP], 1u);
            const unsigned tg = og / nx;
            if (og + 1u == (tg + 1u) * nx) xb_add(&bar[XB_TOPGEN], 1u);
            else XB_SPIN(xb_ld(&bar[XB_TOPGEN]) == tg, bar);
            __builtin_amdgcn_fence(__ATOMIC_ACQUIRE, "agent");
            xb_add(&bar[XB_XGEN(b.x)], 1u);
            asm volatile("s_waitcnt vmcnt(0)" ::: "memory");
        } else {
            XB_SPIN(xb_ld(&bar[XB_XGEN(b.x)]) == gen, bar);
            __builtin_amdgcn_fence(__ATOMIC_ACQUIRE, "agent");
            asm volatile("s_waitcnt vmcnt(0)" ::: "memory");
        }
    }
    __syncthreads();
}

namespace cg = cooperative_groups;
__global__ void __launch_bounds__(NT, 2) mega(Params p) {
    __shared__ __attribute__((aligned(16))) float sm[SM_FLOATS];
    unsigned* bar_st = (unsigned*)(sm + SM_FLOATS - 4);
    cg::grid_group grid = cg::this_grid();
    if (threadIdx.x < 4) bar_st[threadIdx.x] = 0u;
    __syncthreads();
    const XcdBarrier xbar = xcd_barrier_post(p.BAR, (volatile LAS unsigned*)bar_st);
#define GSYNC() xcd_barrier(xbar)
    const int bid = (int)blockIdx.x, nb = (int)gridDim.x;
#ifndef PROBE_REP
#define PROBE_REP 0
#endif
#define GROUP(k, ...) { __VA_ARGS__ } if (PROBE_REP == (k)) { __VA_ARGS__ }
    GROUP(1, ph_cvt_x(p, sm, bid, nb); grid.sync(); ph_inproj(p, sm, bid, nb); GSYNC();)
    GROUP(2, ph_prep(p, sm, bid, nb); GSYNC();
             ph_prep_gemm(p, sm, bid, nb); GSYNC();
             ph_cmp2(p, sm, bid, nb); ph_scan_pre(p, sm, bid, nb); GSYNC();
             ph_cmp_rope(p, sm, bid, nb); GSYNC();)
    GROUP(3, if (bid < 16) { __builtin_amdgcn_s_setprio(3); ph_scan_seq(p, sm, bid, 16); __builtin_amdgcn_s_setprio(0); } else ph_nsa_fast(p, sm, bid - 16, nb - 16);
             GSYNC();)
    GROUP(4, ph_rwkv_post(p, sm, bid, nb); GSYNC();
             ph_branch_a(p, sm, bid, nb); ph_branch_b(p, sm, bid, nb); GSYNC();
             ph_outproj(p, sm, bid, nb); GSYNC();
             ph_ln1(p, sm, bid, nb); GSYNC();)
    GROUP(5, ph_router_gemm(p, sm, bid, nb); ph_shared_gu(p, sm, bid, nb); GSYNC();
             ph_router_sel(p, sm, bid, nb); ph_shared_down(p, sm, bid, nb); GSYNC();)
    GROUP(6, ph_moe_gu(p, sm, bid, nb); GSYNC();
             ph_moe_down(p, sm, bid, nb); GSYNC();)
    ph_final(p, sm, bid, nb);
}
}

extern "C" void kernel_launch(void* const* d_in, const int* in_sizes, int n_in, void* d_out, int out_size, void* d_ws, size_t ws_size, hipStream_t stream) {
    Params p{};
    const float* const* in = (const float* const*)d_in;
    p.x = in[0]; p.w_in = in[1]; p.mu = in[2]; p.w0 = in[3]; p.w2 = in[4]; p.a0 = in[5]; p.a2 = in[6]; p.g2 = in[7]; p.k_k = in[8]; p.k_a = in[9];
    p.r_k = in[10]; p.lnx_w = in[11]; p.lnx_b = in[12]; p.pe_k = in[13]; p.w1_k = in[14]; p.w2_k = in[15]; p.pe_v = in[16]; p.w1_v = in[17]; p.w2_v = in[18];
    p.wba = in[19]; p.wbb = in[20]; p.wout = in[21]; p.ln1g = in[22]; p.ln1b = in[23]; p.rw = in[24]; p.rbias = in[25]; p.egu = in[26]; p.edown = in[27];
    p.sgu = in[28]; p.sdown = in[29]; p.ln2g = in[30]; p.ln2b = in[31];
    p.out = (float*)d_out;
    char* w = (char*)d_ws; size_t off = 0;
    auto carve = [&](size_t bytes) { char* r = w + off; off += (bytes + 255) & ~(size_t)255; return r; };
    p.BAR = (unsigned*)carve(16384);
    p.P = (unsigned short*)carve((size_t)T * INW * 2);
    p.R = (float*)carve((size_t)T * 512 * 4); p.DC = (float*)carve((size_t)T * 512 * 4); p.K2 = (float*)carve((size_t)T * 512 * 4); p.V = (float*)carve((size_t)T * 512 * 4);
    p.KK = (float*)carve((size_t)T * 512 * 4); p.BB = (float*)carve((size_t)T * 512 * 4); p.G = (float*)carve((size_t)T * 512 * 4);
    p.O = (float*)carve((size_t)T * 512 * 4); p.YA = (float*)carve((size_t)T * 512 * 4);
    p.KCraw = (float*)carve((size_t)NCROWS * 64 * 4); p.KCR = (float*)carve((size_t)NCROWS * 64 * 4); p.VC = (float*)carve((size_t)NCROWS * 64 * 4);
    p.Z = (float*)carve((size_t)T * D * 4); p.PRE1 = (float*)carve((size_t)T * D * 4); p.X1 = (float*)carve((size_t)T * D * 4);
    p.LOGITS = (float*)carve((size_t)T * NE * 4); p.EW = (float*)carve((size_t)T * 8 * 4); p.EIDX = (int*)carve((size_t)T * 8 * 4);
    p.LIST = (int*)carve((size_t)NE * LISTCAP * 4); p.CNT = (int*)((char*)d_ws + 14336);
    p.Xb = (unsigned short*)carve((size_t)T * D * 2); p.YAb = (unsigned short*)carve((size_t)T * 512 * 2); p.YBb = (unsigned short*)carve((size_t)T * 512 * 2);
    p.Zb = (unsigned short*)carve((size_t)T * D * 2); p.X1b = (unsigned short*)carve((size_t)T * D * 2);
    p.Qb = (unsigned short*)carve((size_t)T * 512 * 2); p.KSb = (unsigned short*)carve((size_t)T * 128 * 2); p.VSb = (unsigned short*)carve((size_t)T * 128 * 2);
    p.KWb = (unsigned short*)carve((size_t)T * 128 * 2); p.VWb = (unsigned short*)carve((size_t)T * 128 * 2);
    p.KCb = (unsigned short*)carve((size_t)4 * 512 * 64 * 2); p.VCb = (unsigned short*)carve((size_t)4 * 512 * 64 * 2);
    p.GT = (float*)carve((size_t)T * 24 * 4);
    p.WINb = (unsigned short*)carve((size_t)D * INW * 2); p.WBAb = (unsigned short*)carve((size_t)512 * D * 2); p.WBBb = (unsigned short*)carve((size_t)512 * D * 2);
    p.WOUTb = (unsigned short*)carve((size_t)D * D * 2); p.RWb = (unsigned short*)carve((size_t)D * NE * 2); p.SGUb = (unsigned short*)carve((size_t)D * 512 * 2); p.SDOWNb = (unsigned short*)carve((size_t)256 * D * 2);
    p.W1Kb = (unsigned short*)carve((size_t)2048 * 256 * 2); p.W1Vb = (unsigned short*)carve((size_t)2048 * 256 * 2); p.W2Kb = (unsigned short*)carve((size_t)256 * 64 * 2); p.W2Vb = (unsigned short*)carve((size_t)256 * 64 * 2);
    p.LW2b = (unsigned short*)carve((size_t)64 * 512 * 2); p.LA2b = (unsigned short*)carve((size_t)64 * 512 * 2); p.LG2b = (unsigned short*)carve((size_t)128 * 512 * 2);
    p.LORA = (unsigned short*)carve((size_t)T * 256 * 2); p.KCin = (unsigned short*)carve((size_t)4 * S * 64 * 2 + 4096); p.VCin = (unsigned short*)carve((size_t)4 * S * 64 * 2 + 4096);
    p.H1Kb = (unsigned short*)carve((size_t)NCROWS * 256 * 2); p.H1Vb = (unsigned short*)carve((size_t)NCROWS * 256 * 2);
    p.TABC = (float*)carve((size_t)S * 32 * 4); p.TABS = (float*)carve((size_t)S * 32 * 4); p.CB = (float*)carve(2 * 32 * 256 * 4); p.KSH = (float*)carve((size_t)T * 512 * 4);
    p.SCANI = (char*)carve((size_t)8192 * SCI_BYTES);
    p.Rb = (unsigned short*)carve((size_t)T * 512 * 2); p.Vb = (unsigned short*)carve((size_t)T * 512 * 2); p.KSHb = (unsigned short*)carve((size_t)T * 512 * 2); p.KKb = (unsigned short*)carve((size_t)T * 512 * 2);
    p.EWXb = (unsigned short*)carve((size_t)T * 512 * 2); p.K2b = (unsigned short*)carve((size_t)T * 512 * 2); p.BBb = (unsigned short*)carve((size_t)T * 512 * 2); p.Gb = (unsigned short*)carve((size_t)T * 512 * 2);
    p.ACTS = (unsigned short*)carve((size_t)T * 256 * 2); p.SH = (float*)carve((size_t)T * D * 4);
    p.ACT = (unsigned short*)carve((size_t)T * 8 * 256 * 2);
    p.Y = (unsigned short*)carve((size_t)T * 8 * D * 2);
    if (off > ws_size) { fprintf(stderr, "kernel_launch: workspace too small: need %zu have %zu\n", off, ws_size); return; }
    static int grid_blocks = 0;
    if (!grid_blocks) {
        int dev = 0, cus = 0, per_cu = 0;
        hipGetDevice(&dev);
        hipDeviceGetAttribute(&cus, hipDeviceAttributeMultiprocessorCount, dev);
        hipOccupancyMaxActiveBlocksPerMultiprocessor(&per_cu, mega, NT, 0);
        if (per_cu > 2) per_cu = 2;
        if (per_cu < 1) per_cu = 1;
        grid_blocks = cus * per_cu;
    }
    hipMemsetAsync(d_ws, 0, 16384, stream);
    void* args[] = {&p};
    hipError_t e = hipLaunchCooperativeKernel((void*)mega, dim3(grid_blocks), dim3(NT), args, 0, stream);
    if (e != hipSuccess) fprintf(stderr, "cooperative launch failed: %s (grid %d)\n", hipGetErrorString(e), grid_blocks);
}
```

```cpp
#include <hip/hip_runtime.h>
#include <hip/hip_cooperative_groups.h>
#include <cstdio>
#include <cstdint>
#include <cmath>

namespace {

constexpr int NB = 2, S = 8192, T = NB * S, D = 1024, INW = 5144;
constexpr int C_R = 0, C_K = 512, C_V = 1024, C_WL = 1536, C_AL = 1600, C_GL = 1664, RW_IN = 1792;
constexpr int C_Q = 1792, C_KC = 2304, C_VC = 2432, C_KS = 2560, C_VS = 2688, C_KW = 2816, C_VW = 2944, C_GT = 3072;
constexpr int C_GA = 3096, C_GB = 4120;
constexpr int NCMP = 511, NCROWS = NB * NCMP * 2;
constexpr int NE = 256, TOPK = 8, LISTCAP = 16384;
constexpr float ALPHA = 1.189207115002721f;
constexpr float QSCALE = 0.125f * 1.4426950408889634f;
constexpr int NT = 256;

struct Params {
    const float *x, *w_in, *mu, *w0, *w2, *a0, *a2, *g2, *k_k, *k_a, *r_k, *lnx_w, *lnx_b;
    const float *pe_k, *w1_k, *w2_k, *pe_v, *w1_v, *w2_v, *wba, *wbb, *wout, *ln1g, *ln1b;
    const float *rw, *rbias, *egu, *edown, *sgu, *sdown, *ln2g, *ln2b;
    float* out;
    unsigned short* P;
    unsigned short *Rb, *Vb, *KSHb, *KKb, *EWXb, *K2b, *BBb, *Gb;
    float *R, *DC, *K2, *V, *KK, *BB, *G, *O, *YA, *QR, *KSR, *KWR, *KCraw, *KCR, *VC, *H1K, *H1V, *YB, *Z, *PRE1, *X1;
    float *LOGITS, *EW, *SH;
    unsigned short* Y;
    unsigned short *ACT, *ACTS, *Xb, *YAb, *YBb, *Zb, *X1b;
    unsigned short *Qb, *KSb, *VSb, *KWb, *VWb, *KCb, *VCb;
    float *GT, *OC, *OS, *OW, *OCf, *OSf, *OWf;
    unsigned *SELM, *SELMf;
    unsigned short *WINb, *WBAb, *WBBb, *WOUTb, *RWb, *SGUb, *SDOWNb, *W1Kb, *W1Vb, *W2Kb, *W2Vb, *LW2b, *LA2b, *LG2b;
    unsigned short *LORA, *KCin, *VCin, *H1Kb, *H1Vb;
    float *TABC, *TABS, *CB, *KSH;
    char* SCANI;
    int *EIDX, *LIST, *CNT;
    unsigned* BAR;
    int pad_[2];
};

__device__ __forceinline__ float wave_sum(float v) {
#pragma unroll
    for (int o = 1; o < 64; o <<= 1) v += __shfl_xor(v, o);
    return v;
}
__device__ __forceinline__ float wave_max(float v) {
#pragma unroll
    for (int o = 1; o < 64; o <<= 1) v = fmaxf(v, __shfl_xor(v, o));
    return v;
}
__device__ __forceinline__ float sigmoidf_(float x) { return 1.0f / (1.0f + expf(-x)); }
__device__ __forceinline__ float gelu_tanh(float x) { return 0.5f * x * (1.0f + tanhf(0.7978845608028654f * (x + 0.044715f * x * x * x))); }

template <class AL, class BL, class EP>
__device__ __forceinline__ void sgemm_unit(float* sm, int K, const AL& aload, const BL& bload, const EP& epi) {
    float (*As)[68] = (float (*)[68])sm;
    float (*Bs)[68] = (float (*)[68])(sm + 16 * 68);
    const int tid = threadIdx.x, ty = tid >> 4, tx = tid & 15;
    const int arow = tid >> 2, ak = (tid & 3) * 4, bk = tid >> 4, bn = (tid & 15) * 4;
    float acc[4][4];
#pragma unroll
    for (int i = 0; i < 4; ++i)
#pragma unroll
        for (int j = 0; j < 4; ++j) acc[i][j] = 0.f;
    for (int k0 = 0; k0 < K; k0 += 16) {
        const float4 av = aload(arow, k0 + ak);
        const float4 bv = bload(k0 + bk, bn);
        __syncthreads();
        As[ak + 0][arow] = av.x; As[ak + 1][arow] = av.y; As[ak + 2][arow] = av.z; As[ak + 3][arow] = av.w;
        *(float4*)&Bs[bk][bn] = bv;
        __syncthreads();
#pragma unroll
        for (int k = 0; k < 16; ++k) {
            const float4 a = *(const float4*)&As[k][ty * 4];
            const float4 b = *(const float4*)&Bs[k][tx * 4];
            acc[0][0] += a.x * b.x; acc[0][1] += a.x * b.y; acc[0][2] += a.x * b.z; acc[0][3] += a.x * b.w;
            acc[1][0] += a.y * b.x; acc[1][1] += a.y * b.y; acc[1][2] += a.y * b.z; acc[1][3] += a.y * b.w;
            acc[2][0] += a.z * b.x; acc[2][1] += a.z * b.y; acc[2][2] += a.z * b.z; acc[2][3] += a.z * b.w;
            acc[3][0] += a.w * b.x; acc[3][1] += a.w * b.y; acc[3][2] += a.w * b.z; acc[3][3] += a.w * b.w;
        }
    }
#pragma unroll
    for (int i = 0; i < 4; ++i) epi(ty * 4 + i, tx * 4, make_float4(acc[i][0], acc[i][1], acc[i][2], acc[i][3]));
}

template <class EP>
__device__ __forceinline__ void dense_gemm_phase(float* sm, int bid, int nb, const float* A, int lda, const float* B, int ldb, int M, int N, int K, const EP& epi) {
    const int ntn = (N + 63) / 64, nu = (M / 64) * ntn;
    for (int u = bid; u < nu; u += nb) {
        const int m0 = (u / ntn) * 64, n0 = (u % ntn) * 64;
        auto al = [&](int m, int k) { return *(const float4*)(A + (size_t)(m0 + m) * lda + k); };
        auto bl = [&](int k, int n) { return (n0 + n < N) ? *(const float4*)(B + (size_t)k * ldb + n0 + n) : make_float4(0.f, 0.f, 0.f, 0.f); };
        auto ep = [&](int m, int n, float4 v) { if (n0 + n < N) epi(m0 + m, n0 + n, v); };
        sgemm_unit(sm, K, al, bl, ep);
    }
}

typedef short s16x8 __attribute__((ext_vector_type(8)));
typedef short s16x4 __attribute__((ext_vector_type(4)));
typedef float f32x4 __attribute__((ext_vector_type(4)));
typedef float f32x2 __attribute__((ext_vector_type(2)));
typedef __bf16 bf16x2_t __attribute__((ext_vector_type(2)));
typedef unsigned short bf16_t;
#define LAS __attribute__((address_space(3)))
__device__ __forceinline__ unsigned cvtpk(float lo, float hi) { f32x2 v = {lo, hi}; bf16x2_t b = __builtin_convertvector(v, bf16x2_t); return __builtin_bit_cast(unsigned, b); }
__device__ __forceinline__ s16x4 packf4(f32x4 v) { uint2 w; w.x = cvtpk(v[0], v[1]); w.y = cvtpk(v[2], v[3]); return __builtin_bit_cast(s16x4, w); }
__device__ __forceinline__ s16x8 packf8(f32x4 a, f32x4 b) { uint4 w; w.x = cvtpk(a[0], a[1]); w.y = cvtpk(a[2], a[3]); w.z = cvtpk(b[0], b[1]); w.w = cvtpk(b[2], b[3]); return __builtin_bit_cast(s16x8, w); }
__device__ __forceinline__ float bf2f(unsigned short h) { return __uint_as_float(((unsigned)h) << 16); }
__device__ __forceinline__ int bimg_off(int k, int ch) { return 256 * k + 16 * (ch ^ (((k & 3) << 2) | ((k >> 2) & 3))); }

template <bool B_F32, bool GLU, class AR, class BC, class EP>
__device__ __forceinline__ void mgemm_unit(char* lds, int K, const AR& arow, const void* Bp, int ldb, const BC& bcol, const EP& epi) {
    const int tid = threadIdx.x, lane = tid & 63, wid = __builtin_amdgcn_readfirstlane(tid >> 6), wm = wid >> 1, wn = wid & 1, fr = lane & 15, fq = lane >> 4;
    const int ac = (tid & 7) ^ ((tid >> 4) & 7);
    const char* ap[4];
#pragma unroll
    for (int i = 0; i < 4; ++i) ap[i] = (const char*)arow((tid >> 3) + 32 * i);
    const char* bp; int bo_e, bo_o;
    if constexpr (B_F32) {
        const int n4 = tid & 31, kb = tid >> 5; const int col = bcol(n4 * 4);
        bp = (const char*)((const float*)Bp + col) + (size_t)kb * ldb * 4;
        bo_e = 16384 + bimg_off(kb, n4 >> 1) + 8 * (n4 & 1); bo_o = 16384 + bimg_off(kb + 8, n4 >> 1) + 8 * (n4 & 1);
    } else {
        const int kb = tid >> 4; const int ch = (tid & 15) ^ (((kb & 3) << 2) | ((kb >> 2) & 3)); const int col = bcol(ch * 8);
        bp = (const char*)((const bf16_t*)Bp + col) + (size_t)kb * ldb * 2;
        bo_e = 0; bo_o = 0;
    }
    const int a_base = (wm * 64 + fr) * 128, a_sw = (fr >> 1) & 7;
    const int li = lane & 15, wq = li >> 2, wp = li & 3;
    float4 rf0, rf1, rf2, rf3, rf4, rf5, rf6, rf7;
#define MG_DMA16(gp_, ldsp_) do { unsigned keep_; asm volatile("s_mov_b32 %0, m0\n\ts_mov_b32 m0, %2\n\ts_nop 0\n\tglobal_load_lds_dwordx4 %1, off\n\ts_mov_b32 m0, %0" : "=&s"(keep_) : "v"(gp_), "s"((unsigned)__builtin_amdgcn_readfirstlane((int)(unsigned)(uintptr_t)(ldsp_))) : "memory"); } while (0)
#define MG_LOAD_TILES(kt_, buf_) do { \
        const size_t ka_ = (size_t)((kt_) * 64 + ac * 8) * 2; char* ab_ = (buf_) + wid * 1024; \
        MG_DMA16(ap[0] + ka_, ab_); MG_DMA16(ap[1] + ka_, ab_ + 4096); MG_DMA16(ap[2] + ka_, ab_ + 8192); MG_DMA16(ap[3] + ka_, ab_ + 12288); \
        if constexpr (B_F32) { const char* b_ = bp + (size_t)((kt_) * 64) * ldb * 4; const size_t st_ = (size_t)8 * ldb * 4; \
            rf0 = *(const float4*)(b_); rf1 = *(const float4*)(b_ + st_); rf2 = *(const float4*)(b_ + 2 * st_); rf3 = *(const float4*)(b_ + 3 * st_); \
            rf4 = *(const float4*)(b_ + 4 * st_); rf5 = *(const float4*)(b_ + 5 * st_); rf6 = *(const float4*)(b_ + 6 * st_); rf7 = *(const float4*)(b_ + 7 * st_); } \
        else { const char* b_ = bp + (size_t)((kt_) * 64) * ldb * 2; const size_t st_ = (size_t)16 * ldb * 2; char* bb_ = (buf_) + 16384 + wid * 1024; \
            MG_DMA16(b_, bb_); MG_DMA16(b_ + st_, bb_ + 4096); MG_DMA16(b_ + 2 * st_, bb_ + 8192); MG_DMA16(b_ + 3 * st_, bb_ + 12288); } \
    } while (0)
#define MG_CVT8(buf_, off_, v_) do { uint2 w_; w_.x = cvtpk((v_).x, (v_).y); w_.y = cvtpk((v_).z, (v_).w); *(uint2*)((buf_) + (off_)) = w_; } while (0)
#define MG_STORE_TILES(buf_) do { \
        if constexpr (B_F32) { \
            MG_CVT8(buf_, bo_e, rf0); MG_CVT8(buf_, bo_o, rf1); MG_CVT8(buf_, bo_e + 4096, rf2); MG_CVT8(buf_, bo_o + 4096, rf3); \
            MG_CVT8(buf_, bo_e + 8192, rf4); MG_CVT8(buf_, bo_o + 8192, rf5); MG_CVT8(buf_, bo_e + 12288, rf6); MG_CVT8(buf_, bo_o + 12288, rf7); } \
    } while (0)
    f32x4 acc[4][4];
#pragma unroll
    for (int i = 0; i < 4; ++i)
#pragma unroll
        for (int j = 0; j < 4; ++j) acc[i][j] = (f32x4){0.f, 0.f, 0.f, 0.f};
    const int nk = K / 64;
    __syncthreads();
    MG_LOAD_TILES(0, lds);
    MG_STORE_TILES(lds);
    asm volatile("s_waitcnt vmcnt(0)" ::: "memory");
    __syncthreads();
#define MG_COMPUTE(CUR_OFF) do { \
        _Pragma("unroll") for (int ks = 0; ks < 2; ++ks) { \
            s16x8 af[4], wf[4]; \
            const int axor = ((ks * 4 + fq) ^ a_sw) << 4; \
            _Pragma("unroll") for (int mi = 0; mi < 4; ++mi) af[mi] = *(const s16x8*)(lds + (CUR_OFF) + a_base + mi * 2048 + axor); \
            const int r1 = ks * 32 + 8 * fq + wq, r2 = r1 + 4; \
            _Pragma("unroll") for (int ni = 0; ni < 4; ++ni) { \
                const int chunk = wn * 8 + ni * 2 + (wp >> 1); \
                const LAS char* p1 = (const LAS char*)(lds + (CUR_OFF) + 16384 + bimg_off(r1, chunk) + 8 * (wp & 1)); \
                const LAS char* p2 = (const LAS char*)(lds + (CUR_OFF) + 16384 + bimg_off(r2, chunk) + 8 * (wp & 1)); \
                const s16x4 t1 = __builtin_bit_cast(s16x4, __builtin_amdgcn_ds_read_tr16_b64_v4i16((LAS s16x4*)p1)); \
                const s16x4 t2 = __builtin_bit_cast(s16x4, __builtin_amdgcn_ds_read_tr16_b64_v4i16((LAS s16x4*)p2)); \
                wf[ni] = (s16x8){t1[0], t1[1], t1[2], t1[3], t2[0], t2[1], t2[2], t2[3]}; \
            } \
            _Pragma("unroll") for (int mi = 0; mi < 4; ++mi) \
                _Pragma("unroll") for (int ni = 0; ni < 4; ++ni) acc[mi][ni] = __builtin_amdgcn_mfma_f32_16x16x32_bf16(wf[ni], af[mi], acc[mi][ni], 0, 0, 0); \
            if (ks == 0) __builtin_amdgcn_sched_barrier(0); \
        } } while (0)
    for (int kt = 0; kt < nk; kt += 2) {
        if (kt + 1 < nk) MG_LOAD_TILES(kt + 1, lds + 32768);
        __builtin_amdgcn_sched_barrier(0);
        MG_COMPUTE(0);
        __builtin_amdgcn_sched_barrier(0);
        if (kt + 1 < nk) MG_STORE_TILES(lds + 32768);
        asm volatile("s_waitcnt vmcnt(0)" ::: "memory");
        __syncthreads();
        if (kt + 1 >= nk) break;
        if (kt + 2 < nk) MG_LOAD_TILES(kt + 2, lds);
        __builtin_amdgcn_sched_barrier(0);
        MG_COMPUTE(32768);
        __builtin_amdgcn_sched_barrier(0);
        if (kt + 2 < nk) MG_STORE_TILES(lds);
        asm volatile("s_waitcnt vmcnt(0)" ::: "memory");
        __syncthreads();
    }
#undef MG_COMPUTE
    {
        constexpr int NCH = GLU ? 16 : 32;
#pragma unroll
        for (int mi = 0; mi < 4; ++mi) {
            const int m = wm * 64 + mi * 16 + fr;
            if constexpr (GLU) {
#pragma unroll
                for (int ni = 0; ni < 2; ++ni) {
                    const f32x4 g = acc[mi][ni], u = acc[mi][ni + 2];
                    f32x4 r;
#pragma unroll
                    for (int j = 0; j < 4; ++j) r[j] = g[j] / (1.0f + expf(-g[j])) * u[j];
                    const int ch = wn * 8 + ni * 4 + fq;
                    *(f32x4*)(lds + m * 256 + ((ch ^ (m & 7)) << 4)) = r;
                }
            } else {
#pragma unroll
                for (int ni = 0; ni < 4; ++ni) { const int ch = wn * 16 + ni * 4 + fq; *(f32x4*)(lds + m * 512 + ((ch ^ (m & 7)) << 4)) = acc[mi][ni]; }
            }
        }
        __syncthreads();
#pragma unroll 4
        for (int i = 0; i < NCH / 2; ++i) {
            const int idx = i * 256 + tid, m = idx / NCH, ch = idx % NCH;
            const f32x4 v = *(const f32x4*)(lds + m * (NCH * 16) + ((ch ^ (m & 7)) << 4));
            epi(m, ch * 4, v);
        }
    }
}

__device__ __forceinline__ unsigned short f2bf(float v) { return (unsigned short)(cvtpk(v, 0.f) & 0xffffu); }
__device__ __forceinline__ void cvt_seg(const float* src, unsigned short* dst, size_t n, int bid, int nb) {
    const size_t n8 = n / 8;
    for (size_t i = (size_t)bid * NT + threadIdx.x; i < n8; i += (size_t)nb * NT) {
        const float4 a = *(const float4*)(src + i * 8), b = *(const float4*)(src + i * 8 + 4);
        uint4 v; v.x = cvtpk(a.x, a.y); v.y = cvtpk(a.z, a.w); v.z = cvtpk(b.x, b.y); v.w = cvtpk(b.z, b.w);
        *(uint4*)(dst + i * 8) = v;
    }
}
__device__ __forceinline__ void ph_cvt_x(const Params& p, float* sm, int bid, int nb) {
    cvt_seg(p.x, p.Xb, (size_t)T * D, bid, nb);
    cvt_seg(p.w_in, p.WINb, (size_t)D * INW, bid, nb);
    cvt_seg(p.wba, p.WBAb, (size_t)512 * D, bid, nb); cvt_seg(p.wbb, p.WBBb, (size_t)512 * D, bid, nb); cvt_seg(p.wout, p.WOUTb, (size_t)D * D, bid, nb);
    cvt_seg(p.rw, p.RWb, (size_t)D * NE, bid, nb); cvt_seg(p.sgu, p.SGUb, (size_t)D * 512, bid, nb); cvt_seg(p.sdown, p.SDOWNb, (size_t)256 * D, bid, nb);
    cvt_seg(p.w1_k, p.W1Kb, (size_t)2048 * 256, bid, nb); cvt_seg(p.w1_v, p.W1Vb, (size_t)2048 * 256, bid, nb);
    cvt_seg(p.w2_k, p.W2Kb, (size_t)256 * 64, bid, nb); cvt_seg(p.w2_v, p.W2Vb, (size_t)256 * 64, bid, nb);
    cvt_seg(p.w2, p.LW2b, (size_t)64 * 512, bid, nb); cvt_seg(p.a2, p.LA2b, (size_t)64 * 512, bid, nb); cvt_seg(p.g2, p.LG2b, (size_t)128 * 512, bid, nb);
    for (int i = bid * NT + threadIdx.x; i < S * 32; i += nb * NT) {
        const int pos = i >> 5, d = i & 31;
        const float inv = exp2f(-(float)d * (13.287712379549449f / 32.0f));
        float sn, cs; sincosf((float)pos * inv, &sn, &cs);
        p.TABC[i] = cs; p.TABS[i] = sn;
    }
    if (bid < 64) {
        const int kv = bid >> 5, seg = bid & 31;
        const float* pe = kv ? p.pe_v : p.pe_k; const float* w1 = kv ? p.w1_v : p.w1_k;
        float acc = 0.f;
#pragma unroll 8
        for (int k = seg * 64; k < seg * 64 + 64; ++k) acc += pe[k] * w1[(size_t)k * 256 + threadIdx.x];
        p.CB[(kv * 32 + seg) * 256 + threadIdx.x] = acc;
    }
}
__device__ __forceinline__ int xcd_tile(int ul, int nM, int nN, int x) {
    const int q = nN >> 3, r = nN & 7, nmain = nM * q;
    if (ul < nmain) return ((ul / q) << 16) | (x + 8 * (ul % q));
    const int v = ul - nmain, per = nM >> 3;
    if (v < per * r) return (((v % per) * 8 + x) << 16) | (8 * q + v / per);
    return -1;
}
#define XCD_TILE_LOOP(nM_, nN_) for (int ul_ = bid >> 3, tc_ = xcd_tile(ul_, (nM_), (nN_), bid & 7); tc_ >= 0; ul_ += nb >> 3, tc_ = xcd_tile(ul_, (nM_), (nN_), bid & 7))
#define tm_ (tc_ >> 16)
#define tn_ (tc_ & 0xffff)
__device__ __forceinline__ void ph_inproj(const Params& p, float* sm, int bid, int nb) {
    bf16_t* P = p.P; const bf16_t* x = p.Xb;
    XCD_TILE_LOOP(T / 128, (INW + 127) / 128) {
        const int m0 = tm_ * 128, n0 = tn_ * 128;
        auto ar = [&](int r) { return (const void*)(x + (size_t)(m0 + r) * D); };
        auto bc = [&](int c) { return (n0 + c < INW) ? n0 + c : INW - 8; };
        auto ep = [&](int m, int n, f32x4 v) { if (n0 + n < INW) { uint2 w; w.x = cvtpk(v[0], v[1]); w.y = cvtpk(v[2], v[3]); *(uint2*)(P + (size_t)(m0 + m) * INW + n0 + n) = w; } };
        mgemm_unit<false, false>((char*)sm, D, ar, p.WINb, INW, bc, ep);
    }
}

__device__ __forceinline__ void unpack8(const uint4 v, float (&f)[8]) {
    f[0] = bf2f(v.x & 0xffff); f[1] = bf2f(v.x >> 16); f[2] = bf2f(v.y & 0xffff); f[3] = bf2f(v.y >> 16);
    f[4] = bf2f(v.z & 0xffff); f[5] = bf2f(v.z >> 16); f[6] = bf2f(v.w & 0xffff); f[7] = bf2f(v.w >> 16);
}
__device__ __forceinline__ uint4 pack8(const float (&f)[8]) { uint4 v; v.x = cvtpk(f[0], f[1]); v.y = cvtpk(f[2], f[3]); v.z = cvtpk(f[4], f[5]); v.w = cvtpk(f[6], f[7]); return v; }
__device__ __forceinline__ void ph_prep(const Params& p, float* sm, int bid, int nb) {
    const int tid = threadIdx.x;
    for (int t = bid; t < T; t += nb) {
        const int s = t & (S - 1), b = t >> 13;
        const bf16_t* Pt = p.P + (size_t)t * INW;
        if (tid < 224) {
            const int c0 = tid * 8;
            float cur[8], prv[8], x[8];
            unpack8(*(const uint4*)(Pt + c0), cur);
            if (s > 0) unpack8(*(const uint4*)(Pt + c0 - INW), prv); else { for (int j = 0; j < 8; ++j) prv[j] = 0.f; }
            const float4 mu0 = *(const float4*)(p.mu + c0), mu1 = *(const float4*)(p.mu + c0 + 4);
            const float muv[8] = {mu0.x, mu0.y, mu0.z, mu0.w, mu1.x, mu1.y, mu1.z, mu1.w};
#pragma unroll
            for (int j = 0; j < 8; ++j) x[j] = cur[j] + (prv[j] - cur[j]) * muv[j];
            if (tid < 192) {
                const int region = tid >> 6, c = (tid & 63) * 8;
                const size_t o = (size_t)t * 512 + c;
                if (region == 1) {
                    const float4 k0 = *(const float4*)(p.k_k + c), k1 = *(const float4*)(p.k_k + c + 4);
                    const float kkv[8] = {x[0] * k0.x, x[1] * k0.y, x[2] * k0.z, x[3] * k0.w, x[4] * k1.x, x[5] * k1.y, x[6] * k1.z, x[7] * k1.w};
                    float ss = 0.f;
#pragma unroll
                    for (int j = 0; j < 8; ++j) ss += kkv[j] * kkv[j];
                    ss += __shfl_xor(ss, 1); ss += __shfl_xor(ss, 2); ss += __shfl_xor(ss, 4);
                    const float inv = 1.0f / fmaxf(sqrtf(ss), 1e-12f);
                    *(uint4*)(p.KSHb + o) = pack8(x);
                    const float kkn[8] = {kkv[0] * inv, kkv[1] * inv, kkv[2] * inv, kkv[3] * inv, kkv[4] * inv, kkv[5] * inv, kkv[6] * inv, kkv[7] * inv};
                    *(uint4*)(p.KKb + o) = pack8(kkn);
                } else {
                    bf16_t* dst = (region == 0) ? p.Rb : p.Vb;
                    *(uint4*)(dst + o) = pack8(x);
                }
            } else {
                const int c = (tid - 192) * 8;
                float y[8];
#pragma unroll
                for (int j = 0; j < 8; ++j) y[j] = (c < 64) ? tanhf(x[j]) : (c < 128) ? x[j] : sigmoidf_(x[j]);
                *(uint4*)(p.LORA + (size_t)t * 256 + c) = pack8(y);
            }
        } else if (tid < 248) {
            const int i = tid - 224;
            p.GT[(size_t)t * 24 + i] = sigmoidf_(bf2f(Pt[C_GT + i]));
        }
        if (tid < 48) {
            const int hs = tid >> 2, i0 = (tid & 3) * 8;
            const bf16_t* src = (hs < 8) ? Pt + C_Q + hs * 64 : (hs < 10) ? Pt + C_KS + (hs - 8) * 64 : Pt + C_KW + (hs - 10) * 64;
            bf16_t* dst = (hs < 8) ? p.Qb + (size_t)t * 512 + hs * 64 : (hs < 10) ? p.KSb + (size_t)t * 128 + (hs - 8) * 64 : p.KWb + (size_t)t * 128 + (hs - 10) * 64;
            const float scl = (hs < 8) ? QSCALE : 1.0f;
            float x1[8], x2[8], y1[8], y2[8];
            unpack8(*(const uint4*)(src + i0), x1); unpack8(*(const uint4*)(src + i0 + 32), x2);
            const float4 c0 = *(const float4*)(p.TABC + s * 32 + i0), c1 = *(const float4*)(p.TABC + s * 32 + i0 + 4), s0 = *(const float4*)(p.TABS + s * 32 + i0), s1 = *(const float4*)(p.TABS + s * 32 + i0 + 4);
            const float cs[8] = {c0.x, c0.y, c0.z, c0.w, c1.x, c1.y, c1.z, c1.w}, sn[8] = {s0.x, s0.y, s0.z, s0.w, s1.x, s1.y, s1.z, s1.w};
#pragma unroll
            for (int j = 0; j < 8; ++j) { y1[j] = (x1[j] * cs[j] - x2[j] * sn[j]) * scl; y2[j] = (x2[j] * cs[j] + x1[j] * sn[j]) * scl; }
            *(uint4*)(dst + i0) = pack8(y1); *(uint4*)(dst + i0 + 32) = pack8(y2);
        } else if (tid >= 64 && tid < 128) {
            const int i = tid - 64, which = i >> 4, c = (i & 15) * 8;
            const int scol = (which == 0) ? C_VS : (which == 1) ? C_VW : (which == 2) ? C_KC : C_VC;
            const uint4 v = *(const uint4*)(Pt + scol + c);
            if (which == 0) *(uint4*)(p.VSb + (size_t)t * 128 + c) = v;
            else if (which == 1) *(uint4*)(p.VWb + (size_t)t * 128 + c) = v;
            else { bf16_t* base = (which == 2) ? p.KCin : p.VCin; *(uint4*)(base + ((size_t)(b * 2 + (c >> 6)) * S + s) * 64 + (c & 63)) = v; }
        }
    }
}
__device__ __forceinline__ void ph_prep_gemm(const Params& p, float* sm, int bid, int nb) {
    const int n_lora = (T / 128) * 4 * 3, n_cmp = 16 * 2 * 2;
    for (int u = bid; u < n_lora + n_cmp; u += nb) {
        if (u < n_lora) {
            const int part = u % 3, n0 = ((u / 3) % 4) * 128, m0 = (u / 12) * 128;
            const bf16_t* A = p.LORA + (part == 0 ? 0 : part == 1 ? 64 : 128);
            const bf16_t* Bw = (part == 0) ? p.LW2b : (part == 1) ? p.LA2b : p.LG2b;
            auto ar = [&](int r) { return (const void*)(A + (size_t)(m0 + r) * 256); };
            auto bc = [&](int c) { return n0 + c; };
            if (part == 0) {
                bf16_t* EWX = p.EWXb; const float* w0 = p.w0;
                auto ep = [&](int m, int n, f32x4 v) {
                    const int c = n0 + n; const f32x4 w0v = *(const f32x4*)(w0 + c); f32x4 o;
#pragma unroll
                    for (int j = 0; j < 4; ++j) { const float nx = -(w0v[j] + v[j]); const float sp = (nx > 20.f) ? nx : log1pf(expf(nx)); o[j] = expf(-sp - 0.5f); }
                    *(uint2*)(EWX + (size_t)(m0 + m) * 512 + c) = __builtin_bit_cast(uint2, packf4(o));
                };
                mgemm_unit<false, false>((char*)sm, 64, ar, Bw, 512, bc, ep);
            } else if (part == 1) {
                bf16_t* K2 = p.K2b; bf16_t* BB = p.BBb; const bf16_t* KSH = p.KSHb; const bf16_t* KK = p.KKb; const float* a0 = p.a0; const float* k_a = p.k_a;
                auto ep = [&](int m, int n, f32x4 v) {
                    const int c = n0 + n; const size_t o = (size_t)(m0 + m) * 512 + c;
                    const f32x4 a0v = *(const f32x4*)(a0 + c), kav = *(const f32x4*)(k_a + c);
                    const uint2 kw = *(const uint2*)(KSH + o), kkw = *(const uint2*)(KK + o);
                    const f32x4 kv = {bf2f(kw.x & 0xffff), bf2f(kw.x >> 16), bf2f(kw.y & 0xffff), bf2f(kw.y >> 16)}, kkv = {bf2f(kkw.x & 0xffff), bf2f(kkw.x >> 16), bf2f(kkw.y & 0xffff), bf2f(kkw.y >> 16)};
                    f32x4 k2, bb;
#pragma unroll
                    for (int j = 0; j < 4; ++j) { const float a = sigmoidf_(a0v[j] + v[j]); k2[j] = kv[j] * (1.0f + (a - 1.0f) * kav[j]); bb[j] = kkv[j] * a; }
                    *(uint2*)(K2 + o) = __builtin_bit_cast(uint2, packf4(k2)); *(uint2*)(BB + o) = __builtin_bit_cast(uint2, packf4(bb));
                };
                mgemm_unit<false, false>((char*)sm, 64, ar, Bw, 512, bc, ep);
            } else {
                bf16_t* G = p.Gb;
                auto ep = [&](int m, int n, f32x4 v) { *(uint2*)(G + (size_t)(m0 + m) * 512 + n0 + n) = __builtin_bit_cast(uint2, packf4(v)); };
                mgemm_unit<false, false>((char*)sm, 128, ar, Bw, 512, bc, ep);
            }
        } else {
            const int v = u - n_lora, kv = v & 1, n0 = ((v >> 1) & 1) * 128, m0 = (v >> 2) * 128;
            const bf16_t* IN = kv ? p.VCin : p.KCin; const bf16_t* Bw = kv ? p.W1Vb : p.W1Kb; bf16_t* H1 = kv ? p.H1Vb : p.H1Kb;
            float* cb = sm + 16384 + 512;
            __syncthreads();
            { float a_ = 0.f; for (int sg = 0; sg < 32; ++sg) a_ += p.CB[(kv * 32 + sg) * 256 + threadIdx.x]; cb[threadIdx.x] = a_; }
            auto ar = [&](int r) { int rr = m0 + r; if (rr >= NCROWS) rr = NCROWS - 1; const int g = rr & 1, bc_ = rr >> 1, b = bc_ / NCMP, c = bc_ % NCMP; return (const void*)(IN + ((size_t)(b * 2 + g) * S + 16 * c) * 64); };
            auto bc = [&](int c) { return n0 + c; };
            auto ep = [&](int m, int n, f32x4 v4) {
                const int rr = m0 + m; if (rr >= NCROWS) return;
                const f32x4 bv = *(const f32x4*)(cb + n0 + n);
                uint2 w; w.x = cvtpk(gelu_tanh(v4[0] + bv[0]), gelu_tanh(v4[1] + bv[1])); w.y = cvtpk(gelu_tanh(v4[2] + bv[2]), gelu_tanh(v4[3] + bv[3]));
                *(uint2*)(H1 + (size_t)rr * 256 + n0 + n) = w;
            };
            mgemm_unit<false, false>((char*)sm, 2048, ar, Bw, 256, bc, ep);
        }
    }
}

constexpr int SCI_AP = 0, SCI_RP = 2048, SCI_BQ = 4096, SCI_KQ = 6144, SCI_LAK = 8192, SCI_TT = 8704, SCI_MRB = 9216, SCI_MRK = 9728, SCI_GC = 10240, SCI_BYTES = 10496;
__device__ __forceinline__ f32x4 mfma16(s16x4 a, s16x4 b, f32x4 c) { const s16x8 a8 = {a[0], a[1], a[2], a[3], 0, 0, 0, 0}, b8 = {b[0], b[1], b[2], b[3], 0, 0, 0, 0}; return __builtin_amdgcn_mfma_f32_16x16x32_bf16(a8, b8, c, 0, 0, 0); }
__device__ __forceinline__ f32x4 mfma32(s16x8 a, s16x8 b, f32x4 c) { return __builtin_amdgcn_mfma_f32_16x16x32_bf16(a, b, c, 0, 0, 0); }
#define WAVE_LDS_SYNC() asm volatile("s_waitcnt lgkmcnt(0)" ::: "memory")
__device__ __forceinline__ void ph_scan_pre(const Params& p, float* sm, int bid, int nb) {
    const int tid = threadIdx.x, lane = tid & 63, wave = tid >> 6, li = lane & 15, fq = lane >> 4;
    char* wl = (char*)sm + wave * 10240;
    bf16_t* A_l = (bf16_t*)wl; bf16_t* R_l = A_l + 1024; bf16_t* B_l = A_l + 2048; bf16_t* K_l = A_l + 3072;
    float* Lf = (float*)(wl + 8192); float* Tf = (float*)(wl + 9216);
    __syncthreads();
    for (int item = bid * 4 + wave; item < 8192; item += nb * 4) {
        const int ch = item & 511, bh = item >> 9, b = bh >> 3, h = bh & 7;
        const size_t base = ((size_t)(b * S + ch * 16)) * 512 + h * 64 + lane;
        char* out = p.SCANI + (size_t)item * SCI_BYTES;
        float G = 1.0f;
        float bt[16], kt[16];
        WAVE_LDS_SYNC();
#pragma unroll
        for (int t = 0; t < 16; ++t) {
            const size_t o = base + (size_t)t * 512;
            const float d = expf(-bf2f(p.EWXb[o])), kk = bf2f(p.KKb[o]), bb = bf2f(p.BBb[o]), k2 = bf2f(p.K2b[o]), r = bf2f(p.Rb[o]);
            const float Gp = G; G *= d; const float ig = 1.0f / G;
            bt[t] = bb * ig; kt[t] = k2 * ig;
            A_l[t * 64 + lane] = f2bf(-kk * Gp); R_l[t * 64 + lane] = f2bf(r * G); B_l[t * 64 + lane] = f2bf(bt[t]); K_l[t * 64 + lane] = f2bf(kt[t]);
        }
        *(float*)(out + SCI_GC + lane * 4) = G;
        {
            uint4 w0, w1;
            w0.x = cvtpk(bt[0], bt[1]); w0.y = cvtpk(bt[2], bt[3]); w0.z = cvtpk(bt[4], bt[5]); w0.w = cvtpk(bt[6], bt[7]);
            w1.x = cvtpk(bt[8], bt[9]); w1.y = cvtpk(bt[10], bt[11]); w1.z = cvtpk(bt[12], bt[13]); w1.w = cvtpk(bt[14], bt[15]);
            *(uint4*)(out + SCI_BQ + lane * 32) = w0; *(uint4*)(out + SCI_BQ + lane * 32 + 16) = w1;
            w0.x = cvtpk(kt[0], kt[1]); w0.y = cvtpk(kt[2], kt[3]); w0.z = cvtpk(kt[4], kt[5]); w0.w = cvtpk(kt[6], kt[7]);
            w1.x = cvtpk(kt[8], kt[9]); w1.y = cvtpk(kt[10], kt[11]); w1.z = cvtpk(kt[12], kt[13]); w1.w = cvtpk(kt[14], kt[15]);
            *(uint4*)(out + SCI_KQ + lane * 32) = w0; *(uint4*)(out + SCI_KQ + lane * 32 + 16) = w1;
        }
        WAVE_LDS_SYNC();
        f32x4 Lab = {0.f, 0.f, 0.f, 0.f}, Lak = Lab, Mrb = Lab, Mrk = Lab;
#pragma unroll
        for (int s2 = 0; s2 < 2; ++s2) {
            const int o = li * 64 + s2 * 32 + fq * 8;
            const s16x8 bf = *(const s16x8*)(B_l + o), kf = *(const s16x8*)(K_l + o), af = *(const s16x8*)(A_l + o), rf = *(const s16x8*)(R_l + o);
            Lab = mfma32(bf, af, Lab); Lak = mfma32(kf, af, Lak); Mrb = mfma32(bf, rf, Mrb); Mrk = mfma32(kf, rf, Mrk);
        }
#pragma unroll
        for (int r = 0; r < 4; ++r) {
            const int i = 4 * fq + r;
            if (!(i < li)) { Lab[r] = 0.f; Lak[r] = 0.f; }
            if (!(i <= li)) { Mrb[r] = 0.f; Mrk[r] = 0.f; }
            Lf[i * 16 + li] = Lab[r];
        }
        *(uint2*)(out + SCI_LAK + (li * 16 + 4 * fq) * 2) = __builtin_bit_cast(uint2, packf4(Lak));
        *(uint2*)(out + SCI_MRB + (li * 16 + 4 * fq) * 2) = __builtin_bit_cast(uint2, packf4(Mrb));
        *(uint2*)(out + SCI_MRK + (li * 16 + 4 * fq) * 2) = __builtin_bit_cast(uint2, packf4(Mrk));
        WAVE_LDS_SYNC();
        float Tr[16];
#pragma unroll
        for (int t = 0; t < 16; ++t) {
            float acc = (t == li) ? 1.0f : 0.0f;
#pragma unroll
            for (int j = 0; j < t; ++j) acc += Tr[j] * Lf[j * 16 + t];
            Tr[t] = acc;
        }
        if (fq == 0) {
#pragma unroll
            for (int t = 0; t < 16; t += 4) *(float4*)(Tf + li * 16 + t) = make_float4(Tr[t], Tr[t + 1], Tr[t + 2], Tr[t + 3]);
        }
        WAVE_LDS_SYNC();
        {
            const f32x4 tv = {Tf[(4 * fq + 0) * 16 + li], Tf[(4 * fq + 1) * 16 + li], Tf[(4 * fq + 2) * 16 + li], Tf[(4 * fq + 3) * 16 + li]};
            *(uint2*)(out + SCI_TT + (li * 16 + 4 * fq) * 2) = __builtin_bit_cast(uint2, packf4(tv));
        }
#pragma unroll
        for (int c2 = 0; c2 < 2; ++c2) {
            const int q = lane + 64 * c2, s2 = q >> 6, t = (q >> 2) & 15, f = q & 3;
            const int e0 = t * 64 + 32 * s2 + 4 * f;
            uint4 w; const uint2 a0 = *(const uint2*)(A_l + e0), a1 = *(const uint2*)(A_l + e0 + 16);
            w.x = a0.x; w.y = a0.y; w.z = a1.x; w.w = a1.y; *(uint4*)(out + SCI_AP + q * 16) = w;
            const uint2 r0 = *(const uint2*)(R_l + e0), r1 = *(const uint2*)(R_l + e0 + 16);
            w.x = r0.x; w.y = r0.y; w.z = r1.x; w.w = r1.y; *(uint4*)(out + SCI_RP + q * 16) = w;
        }
    }
}
constexpr int SC_SLOT = 16384, SC_VOFF = SCI_BYTES;
__device__ __forceinline__ void ph_scan_seq(const Params& p, float* sm, int bid, int nb) {
    const int tid = threadIdx.x, lane = tid & 63, vs = tid >> 6, li = lane & 15, fq = lane >> 4;
    char* lds = (char*)sm;
    for (int bh = bid; bh < 16; bh += nb) {
        const int b = bh >> 3, h = bh & 7;
        const char* item = p.SCANI + (size_t)(bh * 512) * SCI_BYTES;
        const size_t vcol = (size_t)h * 64 + vs * 16 + li;
        const char* src2; size_t st2; const char* src3; size_t st3;
        {
            const int q2 = tid + 512, q3 = tid + 768;
            if (q2 < 656) { src2 = item + (size_t)q2 * 16; st2 = SCI_BYTES; } else { const int vq = q2 - 656; src2 = (const char*)(p.Vb + ((size_t)(b * S + (vq >> 3))) * 512 + h * 64 + (vq & 7) * 8); st2 = (size_t)16 * 512 * 2; }
            if (q3 < 784) { const int vq = q3 - 656; src3 = (const char*)(p.Vb + ((size_t)(b * S + (vq >> 3))) * 512 + h * 64 + (vq & 7) * 8); st3 = (size_t)16 * 512 * 2; } else { src3 = item; st3 = SCI_BYTES; }
        }
        const char* src0 = item + (size_t)tid * 16; const char* src1 = item + (size_t)(tid + 256) * 16;
        const int d2 = (tid + 512) * 16;
        const int d3 = (tid + 768 < 784) ? (tid + 768) * 16 : 15360 + (tid & 63) * 16;
        f32x4 S0 = {0.f, 0.f, 0.f, 0.f}, S1 = S0, S2 = S0, S3 = S0;
        const int wv = __builtin_amdgcn_readfirstlane(tid >> 6);
#define SC_DMA1(gp_, ldsp_) do { unsigned keep_; asm volatile("s_mov_b32 %0, m0\n\ts_mov_b32 m0, %2\n\ts_nop 0\n\tglobal_load_lds_dwordx4 %1, off\n\ts_mov_b32 m0, %0" : "=&s"(keep_) : "v"(gp_), "s"((unsigned)__builtin_amdgcn_readfirstlane((int)(unsigned)(uintptr_t)(ldsp_))) : "memory"); } while (0)
#define SC_DMA(chn_, slot_) do { const int cc_ = ((chn_) < 512) ? (chn_) : 511; char* sl_ = lds + (slot_) * SC_SLOT + wv * 1024; \
        SC_DMA1(src0 + (size_t)cc_ * SCI_BYTES, sl_); SC_DMA1(src1 + (size_t)cc_ * SCI_BYTES, sl_ + 4096); SC_DMA1(src2 + (size_t)cc_ * st2, sl_ + 8192); \
        if (wv == 0) SC_DMA1(src3 + (size_t)cc_ * st3, sl_ + 12288); } while (0)
#define SC_COMPUTE(chn_, slot_) do { const char* it_ = lds + (slot_) * SC_SLOT; \
        const s16x8 ap0 = *(const s16x8*)(it_ + SCI_AP + ((0 * 16 + li) * 4 + fq) * 16), ap1 = *(const s16x8*)(it_ + SCI_AP + ((1 * 16 + li) * 4 + fq) * 16); \
        const s16x8 rp0 = *(const s16x8*)(it_ + SCI_RP + ((0 * 16 + li) * 4 + fq) * 16), rp1 = *(const s16x8*)(it_ + SCI_RP + ((1 * 16 + li) * 4 + fq) * 16); \
        const s16x4 bq0 = *(const s16x4*)(it_ + SCI_BQ + ((0 * 16 + li) * 16 + 4 * fq) * 2), bq1 = *(const s16x4*)(it_ + SCI_BQ + ((1 * 16 + li) * 16 + 4 * fq) * 2); \
        const s16x4 bq2 = *(const s16x4*)(it_ + SCI_BQ + ((2 * 16 + li) * 16 + 4 * fq) * 2), bq3 = *(const s16x4*)(it_ + SCI_BQ + ((3 * 16 + li) * 16 + 4 * fq) * 2); \
        const s16x4 kq0 = *(const s16x4*)(it_ + SCI_KQ + ((0 * 16 + li) * 16 + 4 * fq) * 2), kq1 = *(const s16x4*)(it_ + SCI_KQ + ((1 * 16 + li) * 16 + 4 * fq) * 2); \
        const s16x4 kq2 = *(const s16x4*)(it_ + SCI_KQ + ((2 * 16 + li) * 16 + 4 * fq) * 2), kq3 = *(const s16x4*)(it_ + SCI_KQ + ((3 * 16 + li) * 16 + 4 * fq) * 2); \
        const s16x4 lak = *(const s16x4*)(it_ + SCI_LAK + (li * 16 + 4 * fq) * 2), ttm = *(const s16x4*)(it_ + SCI_TT + (li * 16 + 4 * fq) * 2); \
        const s16x4 mrb = *(const s16x4*)(it_ + SCI_MRB + (li * 16 + 4 * fq) * 2), mrk = *(const s16x4*)(it_ + SCI_MRK + (li * 16 + 4 * fq) * 2); \
        const f32x4 g0 = *(const f32x4*)(it_ + SCI_GC + (0 * 16 + 4 * fq) * 4), g1 = *(const f32x4*)(it_ + SCI_GC + (1 * 16 + 4 * fq) * 4); \
        const f32x4 g2 = *(const f32x4*)(it_ + SCI_GC + (2 * 16 + 4 * fq) * 4), g3 = *(const f32x4*)(it_ + SCI_GC + (3 * 16 + 4 * fq) * 4); \
        const short* vl_ = (const short*)(it_ + SC_VOFF) + (4 * fq) * 64 + vs * 16 + li; \
        const s16x4 vb = {vl_[0], vl_[64], vl_[128], vl_[192]}; \
        const s16x8 sb0 = packf8(S0, S1), sb1 = packf8(S2, S3); \
        const f32x4 z_ = {0.f, 0.f, 0.f, 0.f}; \
        f32x4 W = mfma32(ap0, sb0, z_); W = mfma32(ap1, sb1, W); W = mfma16(lak, vb, W); \
        const f32x4 U = mfma16(ttm, packf4(W), z_); \
        const s16x4 ub = packf4(U); \
        f32x4 O = mfma32(rp0, sb0, z_); O = mfma32(rp1, sb1, O); O = mfma16(mrk, vb, O); O = mfma16(mrb, ub, O); \
        S0 = mfma16(kq0, vb, S0); S0 = mfma16(bq0, ub, S0); S1 = mfma16(kq1, vb, S1); S1 = mfma16(bq1, ub, S1); \
        S2 = mfma16(kq2, vb, S2); S2 = mfma16(bq2, ub, S2); S3 = mfma16(kq3, vb, S3); S3 = mfma16(bq3, ub, S3); \
        S0 *= g0; S1 *= g1; S2 *= g2; S3 *= g3; \
        float* op_ = p.O + ((size_t)(b * S + (chn_) * 16 + 4 * fq)) * 512 + vcol; \
        op_[0] = O[0]; op_[512] = O[1]; op_[1024] = O[2]; op_[1536] = O[3]; } while (0)
        __syncthreads();
        SC_DMA(0, 0); SC_DMA(1, 1);
        asm volatile("s_waitcnt vmcnt(0)" ::: "memory");
        __syncthreads();
        for (int ch = 0; ch < 512; ch += 4) {
            SC_DMA(ch + 2, 2); SC_DMA(ch + 3, 3);
            __builtin_amdgcn_sched_barrier(0);
            SC_COMPUTE(ch, 0); SC_COMPUTE(ch + 1, 1);
            asm volatile("s_waitcnt vmcnt(0)" ::: "memory");
            __syncthreads();
            SC_DMA(ch + 4, 0); SC_DMA(ch + 5, 1);
            __builtin_amdgcn_sched_barrier(0);
            SC_COMPUTE(ch + 2, 2); SC_COMPUTE(ch + 3, 3);
            asm volatile("s_waitcnt vmcnt(0)" ::: "memory");
            __syncthreads();
        }
#undef SC_COMPUTE
#undef SC_DMA
#undef SC_DMA1
    }
}

__device__ __forceinline__ void ph_rwkv_post(const Params& p, float* sm, int bid, int nb) {
    const int tid = threadIdx.x;
    for (int t = bid; t < T; t += nb) {
#pragma unroll
        for (int slot = 0; slot < 2; ++slot) {
            const int c = tid + slot * 256;
            const size_t o = (size_t)t * 512 + c;
            const float ov = p.O[o];
            const float m = wave_sum(ov) * (1.0f / 64.0f);
            const float dl = ov - m;
            const float var = wave_sum(dl * dl) * (1.0f / 64.0f);
            const float on = dl * rsqrtf(var + 64e-5f) * p.lnx_w[c] + p.lnx_b[c];
            const float bon = wave_sum(bf2f(p.Rb[o]) * bf2f(p.K2b[o]) * p.r_k[c]) * bf2f(p.Vb[o]);
            p.YAb[o] = f2bf((on + bon) * bf2f(p.Gb[o]));
        }
    }
}

__device__ __forceinline__ void ph_cmp2(const Params& p, float* sm, int bid, int nb) {
    for (int u = bid; u < 32; u += nb) {
        const int kv = u & 1, m0 = (u >> 1) * 128;
        const bf16_t* H1 = kv ? p.H1Vb : p.H1Kb; const bf16_t* Bw = kv ? p.W2Vb : p.W2Kb; float* OUT = kv ? p.VC : p.KCraw;
        auto ar = [&](int r) { int rr = m0 + r; if (rr >= NCROWS) rr = NCROWS - 1; return (const void*)(H1 + (size_t)rr * 256); };
        auto bc = [&](int c) { return (c < 64) ? c : 0; };
        auto ep = [&](int m, int n, f32x4 v) { const int rr = m0 + m; if (rr < NCROWS && n < 64) *(f32x4*)(OUT + (size_t)rr * 64 + n) = v; };
        mgemm_unit<false, false>((char*)sm, 256, ar, Bw, 64, bc, ep);
    }
}
__device__ __forceinline__ void ph_cmp_rope(const Params& p, float* sm, int bid, int nb) {
    const int tid = threadIdx.x;
    for (int i = bid * NT + tid; i < NCROWS * 32; i += nb * NT) {
        const int r = i >> 5, d = i & 31;
        const int c = (r >> 1) % NCMP;
        const int pos = 16 * c + 31;
        const float cs = p.TABC[pos * 32 + d], sn = p.TABS[pos * 32 + d];
        const float x1 = p.KCraw[(size_t)r * 64 + d], x2 = p.KCraw[(size_t)r * 64 + d + 32];
        const float y1 = x1 * cs - x2 * sn, y2 = x2 * cs + x1 * sn;
        const int g = r & 1, b = (r >> 1) / NCMP;
        const size_t ob = ((size_t)((b * 2 + g) * 512 + c)) * 64;
        p.KCb[ob + d] = f2bf(y1); p.KCb[ob + d + 32] = f2bf(y2);
        p.VCb[ob + d] = f2bf(p.VC[(size_t)r * 64 + d]); p.VCb[ob + d + 32] = f2bf(p.VC[(size_t)r * 64 + d + 32]);
    }
    for (int i = bid * NT + tid; i < 4 * 64; i += nb * NT) { const size_t ob = ((size_t)((i >> 6) * 512 + 511)) * 64 + (i & 63); p.KCb[ob] = 0; p.VCb[ob] = 0; }
}

__device__ __forceinline__ int kimg_off(int key, int c) { return key * 128 + ((c ^ ((key >> 1) & 7)) << 4); }
__device__ __forceinline__ int vimg_off(int key, int c) { return key * 128 + ((c ^ (((key >> 1) & 3) << 1)) << 4); }
__device__ __forceinline__ float fast_exp2(float x) { return __builtin_amdgcn_exp2f(x); }

struct NsaCtx {
    char* lds; int tid, lane, wave, fr, fq, li;
    s16x8 qf[2][2];
    int tq[2];
};

__device__ __forceinline__ void nsa_qk(const NsaCtx& c, const char* cur, f32x4 (&s)[2][4]) {
#pragma unroll
    for (int kt = 0; kt < 4; ++kt) {
#pragma unroll
        for (int ks = 0; ks < 2; ++ks) {
            const s16x8 kf = *(const s16x8*)(cur + kimg_off(kt * 16 + c.fr, ks * 4 + c.fq));
#pragma unroll
            for (int qt = 0; qt < 2; ++qt) {
                if (ks == 0) s[qt][kt] = __builtin_amdgcn_mfma_f32_16x16x32_bf16(kf, c.qf[qt][0], (f32x4){0.f, 0.f, 0.f, 0.f}, 0, 0, 0);
                else s[qt][kt] = __builtin_amdgcn_mfma_f32_16x16x32_bf16(kf, c.qf[qt][1], s[qt][kt], 0, 0, 0);
            }
        }
    }
}
__device__ __forceinline__ void nsa_pv(const NsaCtx& c, const char* cur, const f32x4 (&pr)[2][4], f32x4 (&O)[2][4]) {
    s16x8 pb[2][2];
#pragma unroll
    for (int qt = 0; qt < 2; ++qt)
#pragma unroll
        for (int k2 = 0; k2 < 2; ++k2) {
            const f32x4 a = pr[qt][2 * k2], b = pr[qt][2 * k2 + 1];
            const unsigned w0 = cvtpk(a[0], a[1]), w1 = cvtpk(a[2], a[3]), w2 = cvtpk(b[0], b[1]), w3 = cvtpk(b[2], b[3]);
            pb[qt][k2] = __builtin_bit_cast(s16x8, make_uint4(w0, w1, w2, w3));
        }
    const int q_ = c.li >> 2, p_ = c.li & 3;
#pragma unroll
    for (int dt = 0; dt < 4; ++dt)
#pragma unroll
        for (int k2 = 0; k2 < 2; ++k2) {
            const int key1 = k2 * 32 + 4 * c.fq + q_, key2 = key1 + 16;
            const int chunk = dt * 2 + (p_ >> 1);
            const LAS char* a1 = (const LAS char*)(cur + 8192 + vimg_off(key1, chunk) + 8 * (p_ & 1));
            const LAS char* a2 = (const LAS char*)(cur + 8192 + vimg_off(key2, chunk) + 8 * (p_ & 1));
            const s16x4 t1 = __builtin_bit_cast(s16x4, __builtin_amdgcn_ds_read_tr16_b64_v4i16((LAS s16x4*)a1));
            const s16x4 t2 = __builtin_bit_cast(s16x4, __builtin_amdgcn_ds_read_tr16_b64_v4i16((LAS s16x4*)a2));
            const s16x8 vf = (s16x8){t1[0], t1[1], t1[2], t1[3], t2[0], t2[1], t2[2], t2[3]};
#pragma unroll
            for (int qt = 0; qt < 2; ++qt) O[qt][dt] = __builtin_amdgcn_mfma_f32_16x16x32_bf16(vf, pb[qt][k2], O[qt][dt], 0, 0, 0);
        }
}
#define KVREGS uint4 rk0, rk1, rv0, rv1
#define KVARGS rk0, rk1, rv0, rv1
__device__ __forceinline__ void nsa_gload(const NsaCtx& c, uint4& rk0, uint4& rk1, uint4& rv0, uint4& rv1, const bf16_t* Kg, const bf16_t* Vg, int stride, int tile) {
    { const int idx = c.tid, key = idx >> 3, ch = idx & 7; const size_t off = (size_t)(tile * 64 + key) * stride + ch * 8; rk0 = *(const uint4*)(Kg + off); rv0 = *(const uint4*)(Vg + off); }
    { const int idx = 256 + c.tid, key = idx >> 3, ch = idx & 7; const size_t off = (size_t)(tile * 64 + key) * stride + ch * 8; rk1 = *(const uint4*)(Kg + off); rv1 = *(const uint4*)(Vg + off); }
}
__device__ __forceinline__ void nsa_lstore(const NsaCtx& c, const uint4& rk0, const uint4& rk1, const uint4& rv0, const uint4& rv1, char* buf) {
    { const int idx = c.tid, key = idx >> 3, ch = idx & 7; *(uint4*)(buf + kimg_off(key, ch)) = rk0; *(uint4*)(buf + 8192 + vimg_off(key, ch)) = rv0; }
    { const int idx = 256 + c.tid, key = idx >> 3, ch = idx & 7; *(uint4*)(buf + kimg_off(key, ch)) = rk1; *(uint4*)(buf + 8192 + vimg_off(key, ch)) = rv1; }
}
__device__ __forceinline__ bool selbit4(const unsigned (&w)[4], int tile) {
    const unsigned long long lo = ((unsigned long long)w[1] << 32) | w[0], hi = ((unsigned long long)w[3] << 32) | w[2];
    const unsigned long long x = (tile < 64) ? (lo >> (tile & 63)) : (hi >> (tile & 63));
    return (x & 1ull) != 0ull;
}
__device__ __forceinline__ float xmax16_32(float v) {
    auto a = __builtin_amdgcn_permlane16_swap(__float_as_uint(v), __float_as_uint(v), false, false);
    v = fmaxf(__uint_as_float(a[0]), __uint_as_float(a[1]));
    auto b = __builtin_amdgcn_permlane32_swap(__float_as_uint(v), __float_as_uint(v), false, false);
    return fmaxf(__uint_as_float(b[0]), __uint_as_float(b[1]));
}
__device__ __forceinline__ float xsum16_32(float v) {
    auto a = __builtin_amdgcn_permlane16_swap(__float_as_uint(v), __float_as_uint(v), false, false);
    v = __uint_as_float(a[0]) + __uint_as_float(a[1]);
    auto b = __builtin_amdgcn_permlane32_swap(__float_as_uint(v), __float_as_uint(v), false, false);
    return __uint_as_float(b[0]) + __uint_as_float(b[1]);
}

template <int BR>
__device__ __forceinline__ void nsa_flash(const NsaCtx& c, const bf16_t* Kg, const bf16_t* Vg, int stride, int tile_lo, int tile_hi, const unsigned (&selw)[2][4],
                                          float (&m)[2], float (&l)[2], f32x4 (&O)[2][4]) {
    if (tile_lo > tile_hi) return;
    KVREGS;
    __syncthreads();
    nsa_gload(c, KVARGS, Kg, Vg, stride, tile_lo);
    nsa_lstore(c, KVARGS, c.lds);
    __syncthreads();
    for (int tile = tile_lo; tile <= tile_hi; ++tile) {
        char* cur = c.lds + ((tile - tile_lo) & 1) * 16384;
        if (tile < tile_hi) nsa_gload(c, KVARGS, Kg, Vg, stride, tile + 1);
        __builtin_amdgcn_sched_barrier(0);
        bool need = true;
        bool rok0 = true, rok1 = true;
        if (BR == 1) {
            rok0 = selbit4(selw[0], tile); rok1 = selbit4(selw[1], tile);
            need = __ballot(rok0 || rok1) != 0ull;
        }
        if (need) {
            f32x4 s[2][4];
            nsa_qk(c, cur, s);
            const int t0w = c.tq[0] & ~31;
            const bool bnd = (tile == (t0w >> 6)) || (BR == 2 && tile * 64 + 480 < t0w);
            if (bnd) {
#pragma unroll
                for (int qt = 0; qt < 2; ++qt) {
                    const int t = c.tq[qt];
                    const bool rowok = (qt == 0) ? rok0 : rok1;
                    float tmax = -1e30f;
#pragma unroll
                    for (int kt = 0; kt < 4; ++kt)
#pragma unroll
                        for (int r = 0; r < 4; ++r) {
                            const int kap = tile * 64 + kt * 16 + 4 * c.fq + r;
                            bool ok = rowok && (kap <= t);
                            if (BR == 2) ok = ok && (kap + 511 >= t);
                            const float v = ok ? s[qt][kt][r] : -1e30f;
                            s[qt][kt][r] = v; tmax = fmaxf(tmax, v);
                        }
                    tmax = xmax16_32(tmax);
                    const float mn = fmaxf(m[qt], tmax);
                    const float alpha = fast_exp2(m[qt] - mn);
                    m[qt] = mn;
                    float rs = 0.f;
#pragma unroll
                    for (int kt = 0; kt < 4; ++kt)
#pragma unroll
                        for (int r = 0; r < 4; ++r) { const float v = s[qt][kt][r]; const float pv = (v > -1e29f) ? fast_exp2(v - mn) : 0.f; s[qt][kt][r] = pv; rs += pv; }
                    l[qt] = l[qt] * alpha + rs;
#pragma unroll
                    for (int dt = 0; dt < 4; ++dt) O[qt][dt] *= alpha;
                }
            } else {
                float tm[2];
#pragma unroll
                for (int qt = 0; qt < 2; ++qt) {
                    float a0 = fmaxf(fmaxf(s[qt][0][0], s[qt][0][1]), fmaxf(s[qt][0][2], s[qt][0][3]));
#pragma unroll
                    for (int kt = 1; kt < 4; ++kt) a0 = fmaxf(a0, fmaxf(fmaxf(s[qt][kt][0], s[qt][kt][1]), fmaxf(s[qt][kt][2], s[qt][kt][3])));
                    const bool rowok = (qt == 0) ? rok0 : rok1;
                    tm[qt] = xmax16_32(rowok ? a0 : -1e30f);
                }
                const bool grow = __ballot((tm[0] > m[0]) || (tm[1] > m[1])) != 0ull;
                if (grow) {
#pragma unroll
                    for (int qt = 0; qt < 2; ++qt) {
                        const float mn = fmaxf(m[qt], tm[qt]);
                        const float alpha = fast_exp2(m[qt] - mn);
                        m[qt] = mn; l[qt] *= alpha;
#pragma unroll
                        for (int dt = 0; dt < 4; ++dt) O[qt][dt] *= alpha;
                    }
                }
#pragma unroll
                for (int qt = 0; qt < 2; ++qt) {
                    const bool rowok = (qt == 0) ? rok0 : rok1;
                    const float msub = rowok ? m[qt] : 3e38f;
                    float rs = 0.f;
#pragma unroll
                    for (int kt = 0; kt < 4; ++kt)
#pragma unroll
                        for (int r = 0; r < 4; ++r) { const float pv = fast_exp2(s[qt][kt][r] - msub); s[qt][kt][r] = pv; rs += pv; }
                    l[qt] += rs;
                }
            }
            nsa_pv(c, cur, s, O);
        }
        if (tile < tile_hi) nsa_lstore(c, KVARGS, c.lds + ((tile - tile_lo + 1) & 1) * 16384);
        __syncthreads();
    }
}
template <bool NORM, int MODE>
__device__ __forceinline__ void nsa_accum(const NsaCtx& c, const float (&gate)[2], const float (&l)[2], const f32x4 (&O)[2][4], bf16_t* const (&yrow)[2]) {
#pragma unroll
    for (int qt = 0; qt < 2; ++qt) {
        float inv = 1.0f;
        if (NORM) { const float lt = xsum16_32(l[qt]); inv = (lt > 0.f) ? 1.0f / lt : 0.f; }
        inv *= gate[qt];
        float* acc = (float*)(c.lds + 32768) + (c.wave * 32 + qt * 16 + c.li) * 64 + 4 * c.fq;
#pragma unroll
        for (int dt = 0; dt < 4; ++dt) {
            f32x4 v = O[qt][dt] * inv;
            if (MODE >= 1) v += *(const f32x4*)(acc + dt * 16);
            if (MODE <= 1) *(f32x4*)(acc + dt * 16) = v;
            else { uint2 w; w.x = cvtpk(v[0], v[1]); w.y = cvtpk(v[2], v[3]); *(uint2*)(yrow[qt] + dt * 16) = w; }
        }
    }
}

__device__ __forceinline__ void ph_nsa_fast(const Params& p, float* sm, int bid, int nb) {
    NsaCtx c;
    c.lds = (char*)sm; c.tid = threadIdx.x; c.lane = c.tid & 63; c.wave = c.tid >> 6; c.fr = c.lane & 15; c.fq = c.lane >> 4; c.li = c.lane & 15;
    float* impA = (float*)(c.lds + 32768); float* impE = (float*)(c.lds + 49152); unsigned* selm = (unsigned*)(c.lds + 49152);
    int* wq = (int*)sm + 16384 + 300;
    for (;;) {
        __syncthreads();
        if (c.tid == 0) *wq = atomicAdd(p.CNT + 256, 1);
        __syncthreads();
        const int u = *wq;
        if (u >= 1024) break;
        const int tt = 255 - (u >> 2), b = (u >> 1) & 1, g = u & 1, t0 = tt * 32;
        const int head = c.li & 3;
#pragma unroll
        for (int qt = 0; qt < 2; ++qt) {
            c.tq[qt] = t0 + c.wave * 8 + qt * 4 + (c.li >> 2);
            const bf16_t* qrow = p.Qb + (size_t)(b * S + c.tq[qt]) * 512 + (g * 4 + head) * 64 + 8 * c.fq;
            c.qf[qt][0] = *(const s16x8*)qrow; c.qf[qt][1] = *(const s16x8*)(qrow + 32);
        }
        unsigned selw[2][4];
        float gt0[2], gt1[2], gt2[2];
        bf16_t* yrow[2];
#pragma unroll
        for (int qt = 0; qt < 2; ++qt) {
#pragma unroll
            for (int w = 0; w < 4; ++w) selw[qt][w] = 0u;
            const float* gp = p.GT + (size_t)(b * S + c.tq[qt]) * 24 + (g * 4 + head) * 3;
            gt0[qt] = gp[0]; gt1[qt] = gp[1]; gt2[qt] = gp[2];
            yrow[qt] = p.YBb + (size_t)(b * S + c.tq[qt]) * 512 + (g * 4 + head) * 64 + 4 * c.fq;
        }
        f32x4 Oc[2][4];
#if 1
        {
            const bf16_t* Kg = p.KCb + (size_t)((b * 2 + g) * 512) * 64; const bf16_t* Vg = p.VCb + (size_t)((b * 2 + g) * 512) * 64;
            const int tl = t0 + 31; const int nvmax = (tl >= 31) ? ((tl - 31) >> 4) + 1 : 0; const int ntile = (nvmax + 63) >> 6;
            float m[2] = {-1e30f, -1e30f}, l[2] = {0.f, 0.f};
#pragma unroll
            for (int qt = 0; qt < 2; ++qt)
#pragma unroll
                for (int dt = 0; dt < 4; ++dt) Oc[qt][dt] = (f32x4){0.f, 0.f, 0.f, 0.f};
            __syncthreads();
            for (int i = c.tid; i < 32 * 128; i += NT) { impA[i] = 0.f; impE[i] = 0.f; }
            KVREGS;
            for (int pass = 0; pass < 2; ++pass) {
                float linv[2] = {0.f, 0.f};
                if (pass == 1) {
#pragma unroll
                    for (int qt = 0; qt < 2; ++qt) { const float lt = xsum16_32(l[qt]); linv[qt] = (lt > 0.f) ? 1.0f / lt : 0.f; }
                }
                if (ntile > 0) {
                    __syncthreads();
                    nsa_gload(c, KVARGS, Kg, Vg, 64, 0); nsa_lstore(c, KVARGS, c.lds); __syncthreads();
                    for (int tile = 0; tile < ntile; ++tile) {
                        char* cur = c.lds + (tile & 1) * 16384;
                        if (tile + 1 < ntile) nsa_gload(c, KVARGS, Kg, Vg, 64, tile + 1);
                        __builtin_amdgcn_sched_barrier(0);
                        f32x4 s[2][4];
                        nsa_qk(c, cur, s);
#pragma unroll
                        for (int qt = 0; qt < 2; ++qt) {
                            const int t = c.tq[qt];
                            if (pass == 0) {
                                float tmax = -1e30f;
#pragma unroll
                                for (int kt = 0; kt < 4; ++kt)
#pragma unroll
                                    for (int r = 0; r < 4; ++r) { const int cc = tile * 64 + kt * 16 + 4 * c.fq + r; const float v = (16 * cc + 31 <= t) ? s[qt][kt][r] : -1e30f; s[qt][kt][r] = v; tmax = fmaxf(tmax, v); }
                                tmax = xmax16_32(tmax);
                                const float mn = fmaxf(m[qt], tmax); const float alpha = fast_exp2(m[qt] - mn); m[qt] = mn;
                                float rs = 0.f;
#pragma unroll
                                for (int kt = 0; kt < 4; ++kt)
#pragma unroll
                                    for (int r = 0; r < 4; ++r) { const float v = s[qt][kt][r]; rs += (v > -1e29f) ? fast_exp2(v - mn) : 0.f; }
                                l[qt] = l[qt] * alpha + rs;
                            } else {
#pragma unroll
                                for (int kt = 0; kt < 4; ++kt) {
#pragma unroll
                                    for (int r = 0; r < 4; ++r) { const int cc = tile * 64 + kt * 16 + 4 * c.fq + r; s[qt][kt][r] = (16 * cc + 31 <= t) ? fast_exp2(s[qt][kt][r] - m[qt]) * linv[qt] : 0.f; }
                                    float e = s[qt][kt][3];
                                    float a = 2.0f * ((s[qt][kt][0] + s[qt][kt][1]) + (s[qt][kt][2] + e)) - e;
                                    a += __shfl_xor(a, 1); a += __shfl_xor(a, 2); e += __shfl_xor(e, 1); e += __shfl_xor(e, 2);
                                    if (head == 0) { const int j = tile * 16 + kt * 4 + c.fq; const int tokl = c.wave * 8 + qt * 4 + (c.li >> 2); impA[tokl * 128 + j] = a; impE[tokl * 128 + j] = e; }
                                }
                            }
                        }
                        if (pass == 1) nsa_pv(c, cur, s, Oc);
                        if (tile + 1 < ntile) nsa_lstore(c, KVARGS, c.lds + ((tile + 1) & 1) * 16384);
                        __syncthreads();
                    }
                }
            }
        }
#endif
#if 1
        {
            __syncthreads();
            float scv[16];
#pragma unroll
            for (int i = 0; i < 16; ++i) {
                const int e = c.tid + 256 * i, tok = e >> 7, j = e & 127; const int t = t0 + tok, cur = t >> 6;
                const bool valid = (j <= cur), forced = (j == 0) || (j == cur) || (j == cur - 1);
                scv[i] = valid ? (impA[e] + ((j > 0) ? impE[e - 1] : 0.f) + (forced ? 1e4f : 0.f)) : -1.0f;
            }
            __syncthreads();
#pragma unroll
            for (int i = 0; i < 16; ++i) impA[c.tid + 256 * i] = scv[i];
            __syncthreads();
#pragma unroll 1
            for (int ti = 0; ti < 8; ++ti) {
                const int tok = c.wave * 8 + ti;
                const float f0 = impA[tok * 128 + c.lane], f1 = impA[tok * 128 + 64 + c.lane];
                const unsigned k0 = (f0 >= 0.f) ? __float_as_uint(f0) + 1u : 0u, k1 = (f1 >= 0.f) ? __float_as_uint(f1) + 1u : 0u;
                unsigned T = 0u;
#pragma unroll 1
                for (int bit = 31; bit >= 0; --bit) {
                    const unsigned cand = T | (1u << bit);
                    const int cnt = __popcll(__ballot(k0 >= cand)) + __popcll(__ballot(k1 >= cand));
                    if (cnt >= 16) T = cand;
                }
                const bool g0 = k0 > T, g1 = k1 > T;
                const int need = 16 - (__popcll(__ballot(g0)) + __popcll(__ballot(g1)));
                const bool e0 = (k0 == T) && (k0 != 0u), e1 = (k1 == T) && (k1 != 0u);
                const unsigned long long be0 = __ballot(e0), be1 = __ballot(e1);
                const unsigned long long lt = (1ull << c.lane) - 1ull;
                const bool s0 = g0 || (e0 && __popcll(be0 & lt) < need);
                const bool s1 = g1 || (e1 && __popcll(be0) + __popcll(be1 & lt) < need);
                const unsigned long long m0 = __ballot(s0), m1 = __ballot(s1);
                if (c.lane == 0) { selm[tok * 4 + 0] = (unsigned)m0; selm[tok * 4 + 1] = (unsigned)(m0 >> 32); selm[tok * 4 + 2] = (unsigned)m1; selm[tok * 4 + 3] = (unsigned)(m1 >> 32); }
            }
            __syncthreads();
#pragma unroll
            for (int qt = 0; qt < 2; ++qt) {
                const int tokl = c.wave * 8 + qt * 4 + (c.li >> 2);
#pragma unroll
                for (int w = 0; w < 4; ++w) selw[qt][w] = selm[tokl * 4 + w];
            }
            __syncthreads();
            { const float dummy[2] = {0.f, 0.f}; nsa_accum<false, 0>(c, gt0, dummy, Oc, yrow); }
        }
#endif
#if 1
        {
            float m[2] = {-1e30f, -1e30f}, l[2] = {0.f, 0.f};
            f32x4 O[2][4];
#pragma unroll
            for (int qt = 0; qt < 2; ++qt)
#pragma unroll
                for (int dt = 0; dt < 4; ++dt) O[qt][dt] = (f32x4){0.f, 0.f, 0.f, 0.f};
            nsa_flash<1>(c, p.KSb + (size_t)(b * S) * 128 + g * 64, p.VSb + (size_t)(b * S) * 128 + g * 64, 128, 0, (t0 + 31) >> 6, selw, m, l, O);
            nsa_accum<true, 1>(c, gt1, l, O, yrow);
        }
#endif
#if 1
        {
            float m[2] = {-1e30f, -1e30f}, l[2] = {0.f, 0.f};
            f32x4 O[2][4];
#pragma unroll
            for (int qt = 0; qt < 2; ++qt)
#pragma unroll
                for (int dt = 0; dt < 4; ++dt) O[qt][dt] = (f32x4){0.f, 0.f, 0.f, 0.f};
            const int lo = (t0 >= 511) ? ((t0 - 511) >> 6) : 0;
            nsa_flash<2>(c, p.KWb + (size_t)(b * S) * 128 + g * 64, p.VWb + (size_t)(b * S) * 128 + g * 64, 128, lo, (t0 + 31) >> 6, selw, m, l, O);
            nsa_accum<true, 2>(c, gt2, l, O, yrow);
        }
#endif
    }
}
__device__ __forceinline__ void ph_branch_a(const Params& p, float* sm, int bid, int nb) {
    const bf16_t* P = p.P; float* Z = p.Z; const bf16_t* YA = p.YAb;
    XCD_TILE_LOOP(T / 128, D / 128) {
        const int m0 = tm_ * 128, n0 = tn_ * 128;
        auto ar = [&](int r) { return (const void*)(YA + (size_t)(m0 + r) * 512); };
        auto bc = [&](int c) { return n0 + c; };
        auto ep = [&](int m, int n, f32x4 v) {
            const size_t r = m0 + m; const int c = n0 + n;
            const uint2 gw = *(const uint2*)(P + r * INW + C_GA + c); const f32x4 gq = {bf2f(gw.x & 0xffff), bf2f(gw.x >> 16), bf2f(gw.y & 0xffff), bf2f(gw.y >> 16)};
            f32x4 o;
#pragma unroll
            for (int j = 0; j < 4; ++j) o[j] = sigmoidf_(gq[j]) * v[j];
            *(f32x4*)(Z + r * D + c) = o;
        };
        mgemm_unit<false, false>((char*)sm, 512, ar, p.WBAb, D, bc, ep);
    }
}
__device__ __forceinline__ void ph_branch_b(const Params& p, float* sm, int bid, int nb) {
    const bf16_t* P = p.P; float* Z = p.Z; const bf16_t* YB = p.YBb; bf16_t* Zb = p.Zb;
    XCD_TILE_LOOP(T / 128, D / 128) {
        const int m0 = tm_ * 128, n0 = tn_ * 128;
        auto ar = [&](int r) { return (const void*)(YB + (size_t)(m0 + r) * 512); };
        auto bc = [&](int c) { return n0 + c; };
        auto ep = [&](int m, int n, f32x4 v) {
            const size_t r = m0 + m; const int c = n0 + n;
            const uint2 gw = *(const uint2*)(P + r * INW + C_GB + c); const f32x4 gq = {bf2f(gw.x & 0xffff), bf2f(gw.x >> 16), bf2f(gw.y & 0xffff), bf2f(gw.y >> 16)};
            f32x4 o = *(const f32x4*)(Z + r * D + c);
#pragma unroll
            for (int j = 0; j < 4; ++j) o[j] += sigmoidf_(gq[j]) * v[j];
            uint2 w; w.x = cvtpk(o[0], o[1]); w.y = cvtpk(o[2], o[3]);
            *(uint2*)(Zb + r * D + c) = w;
        };
        mgemm_unit<false, false>((char*)sm, 512, ar, p.WBBb, D, bc, ep);
    }
}
__device__ __forceinline__ void ph_outproj(const Params& p, float* sm, int bid, int nb) {
    const float* x = p.x; float* PRE1 = p.PRE1; const bf16_t* Z = p.Zb;
    XCD_TILE_LOOP(T / 128, D / 128) {
        const int m0 = tm_ * 128, n0 = tn_ * 128;
        auto ar = [&](int r) { return (const void*)(Z + (size_t)(m0 + r) * D); };
        auto bc = [&](int c) { return n0 + c; };
        auto ep = [&](int m, int n, f32x4 v) {
            const size_t r = m0 + m; const int c = n0 + n;
            const f32x4 xv = *(const f32x4*)(x + r * D + c);
            *(f32x4*)(PRE1 + r * D + c) = xv * ALPHA + v;
        };
        mgemm_unit<false, false>((char*)sm, D, ar, p.WOUTb, D, bc, ep);
    }
}
__device__ __forceinline__ void ln_rows(float* sm, int bid, int nb, const float* src, float* dst, unsigned short* dstb, const float* gam, const float* bet) {
    const int tid = threadIdx.x, wave = tid >> 6, lane = tid & 63;
    for (int t = bid; t < T; t += nb) {
        const float4 v = *(const float4*)(src + (size_t)t * D + tid * 4);
        float s = (v.x + v.y) + (v.z + v.w);
        s = wave_sum(s);
        __syncthreads();
        if (lane == 0) sm[wave] = s;
        __syncthreads();
        const float mean = (sm[0] + sm[1] + sm[2] + sm[3]) * (1.0f / D);
        const float dx = v.x - mean, dy = v.y - mean, dz = v.z - mean, dw = v.w - mean;
        float q = (dx * dx + dy * dy) + (dz * dz + dw * dw);
        q = wave_sum(q);
        __syncthreads();
        if (lane == 0) sm[wave] = q;
        __syncthreads();
        const float rstd = rsqrtf((sm[0] + sm[1] + sm[2] + sm[3]) * (1.0f / D) + 1e-5f);
        const float4 gq = *(const float4*)(gam + tid * 4), bq = *(const float4*)(bet + tid * 4);
        const float4 o = make_float4(dx * rstd * gq.x + bq.x, dy * rstd * gq.y + bq.y, dz * rstd * gq.z + bq.z, dw * rstd * gq.w + bq.w);
        *(float4*)(dst + (size_t)t * D + tid * 4) = o;
        uint2 w; w.x = cvtpk(o.x, o.y); w.y = cvtpk(o.z, o.w);
        *(uint2*)(dstb + (size_t)t * D + tid * 4) = w;
    }
}
__device__ __forceinline__ void ph_ln1(const Params& p, float* sm, int bid, int nb) { ln_rows(sm, bid, nb, p.PRE1, p.X1, p.X1b, p.ln1g, p.ln1b); }

__device__ __forceinline__ void ph_router_gemm(const Params& p, float* sm, int bid, int nb) {
    float* L = p.LOGITS; const bf16_t* X1 = p.X1b;
    XCD_TILE_LOOP(T / 128, 2) {
        const int m0 = tm_ * 128, n0 = tn_ * 128;
        auto ar = [&](int r) { return (const void*)(X1 + (size_t)(m0 + r) * D); };
        auto bc = [&](int c) { return n0 + c; };
        auto ep = [&](int m, int n, f32x4 v) { *(f32x4*)(L + (size_t)(m0 + m) * NE + n0 + n) = v; };
        mgemm_unit<false, false>((char*)sm, D, ar, p.RWb, NE, bc, ep);
    }
}
__device__ __forceinline__ void ph_router_sel(const Params& p, float* sm, int bid, int nb) {
    const int tid = threadIdx.x, lane = tid & 63, wave = tid >> 6;
    const float4 bias4 = *(const float4*)(p.rbias + lane * 4);
    for (int t = bid * 4 + wave; t < T; t += nb * 4) {
        const float4 lg = *(const float4*)(p.LOGITS + (size_t)t * NE + lane * 4);
        float sc[4] = {sigmoidf_(lg.x), sigmoidf_(lg.y), sigmoidf_(lg.z), sigmoidf_(lg.w)};
        float ch[4] = {sc[0] + bias4.x, sc[1] + bias4.y, sc[2] + bias4.z, sc[3] + bias4.w};
        float m1 = fmaxf(fmaxf(ch[0], ch[1]), fmaxf(ch[2], ch[3]));
        float m2;
        {
            const float a = fmaxf(ch[0], ch[1]), b = fminf(ch[0], ch[1]), c = fmaxf(ch[2], ch[3]), d = fminf(ch[2], ch[3]);
            m2 = fmaxf(fminf(a, c), fmaxf(b, d));
        }
#pragma unroll
        for (int o = 1; o < 8; o <<= 1) {
            const float o1 = __shfl_xor(m1, o), o2 = __shfl_xor(m2, o);
            const float n1 = fmaxf(m1, o1), n2 = fmaxf(fminf(m1, o1), fmaxf(m2, o2));
            m1 = n1; m2 = n2;
        }
        const float gs = m1 + m2;
        const int grp = lane >> 3;
        int grank = 0;
#pragma unroll
        for (int g = 0; g < 8; ++g) { const float og = __shfl(gs, g * 8); grank += (og > gs || (og == gs && g < grp)) ? 1 : 0; }
        const bool gsel = grank < 4;
        float mc[4];
#pragma unroll
        for (int j = 0; j < 4; ++j) mc[j] = gsel ? ch[j] : -1e30f;
        int myk = -1; float mysc = 0.f, wsum = 0.f;
#pragma unroll 1
        for (int k = 0; k < 8; ++k) {
            float bv = mc[0]; int bi = lane * 4;
#pragma unroll
            for (int j = 1; j < 4; ++j) if (mc[j] > bv) { bv = mc[j]; bi = lane * 4 + j; }
#pragma unroll
            for (int o = 1; o < 64; o <<= 1) {
                const float ov = __shfl_xor(bv, o); const int oi = __shfl_xor(bi, o);
                if (ov > bv || (ov == bv && oi < bi)) { bv = ov; bi = oi; }
            }
            const int own = bi >> 2, jj = bi & 3;
            const float wsc = __shfl((jj == 0) ? sc[0] : (jj == 1) ? sc[1] : (jj == 2) ? sc[2] : sc[3], own);
            if (lane == own) { if (jj == 0) mc[0] = -3e38f; else if (jj == 1) mc[1] = -3e38f; else if (jj == 2) mc[2] = -3e38f; else mc[3] = -3e38f; }
            if (lane == k) { myk = bi; mysc = wsc; }
            wsum += wsc;
        }
        if (lane < 8) {
            const int a = t * 8 + lane;
            p.EIDX[a] = myk;
            p.EW[a] = mysc / wsum * 2.5f;
            const int pos = atomicAdd(p.CNT + myk, 1);
            if (pos < LISTCAP) p.LIST[(size_t)myk * LISTCAP + pos] = a;
        }
    }
}
__device__ __forceinline__ int moe_tile_prefix(const Params& p, int* pre) {
    const int tid = threadIdx.x;
    __syncthreads();
    int c = __hip_atomic_load(p.CNT + tid, __ATOMIC_RELAXED, __HIP_MEMORY_SCOPE_AGENT); if (c > LISTCAP) c = LISTCAP;
    pre[tid + 1] = (c + 127) >> 7;
    if (tid == 0) pre[0] = 0;
    __syncthreads();
    if (tid == 0) { int a = 0; for (int i = 1; i <= 256; ++i) { a += pre[i]; pre[i] = a; } }
    __syncthreads();
    return pre[256];
}
__device__ __forceinline__ int moe_find_expert(const int* pre, int tile) {
    int lo = 0, hi = 255;
    while (lo < hi) { const int mid = (lo + hi + 1) >> 1; if (pre[mid] <= tile) lo = mid; else hi = mid - 1; }
    return lo;
}
__device__ __forceinline__ int glu_col(int j0, int c) { const int wn = c >> 6, ni = (c >> 4) & 3, x = c & 15; return ((ni >> 1) ? 256 : 0) + j0 + wn * 32 + (ni & 1) * 16 + x; }
__device__ __forceinline__ void ph_moe_gu(const Params& p, float* sm, int bid, int nb) {
    int* pre = (int*)sm + 16384;
    int* px = (int*)sm + 16384 + 260;
    (void)moe_tile_prefix(p, pre);
    const int x = bid & 7, par = x >> 2, j0 = (x & 3) * 64;
    if (threadIdx.x == 0) { int a_ = 0; px[0] = 0; for (int i = 0; i < 128; ++i) { a_ += pre[par + 2 * i + 1] - pre[par + 2 * i]; px[i + 1] = a_; } }
    __syncthreads();
    const int nun = px[128];
    for (int ul = bid >> 3; ul < nun; ul += nb >> 3) {
        int lo = 0, hi = 127;
        while (lo < hi) { const int mid = (lo + hi + 1) >> 1; if (px[mid] <= ul) lo = mid; else hi = mid - 1; }
        const int e = par + 2 * lo, mt = ul - px[lo];
        int cnt = __hip_atomic_load(p.CNT + e, __ATOMIC_RELAXED, __HIP_MEMORY_SCOPE_AGENT); if (cnt > LISTCAP) cnt = LISTCAP;
        const int* lst = p.LIST + (size_t)e * LISTCAP + mt * 128;
        const int nrow = cnt - mt * 128;
        const bf16_t* X1 = p.X1b; bf16_t* ACT = p.ACT;
        int* rowA = (int*)sm + 16384 + 512;
        __syncthreads();
        if (threadIdx.x < 128) rowA[threadIdx.x] = lst[(int)threadIdx.x < nrow ? threadIdx.x : 0];
        auto ar = [&](int r) { return (const void*)(X1 + (size_t)(lst[r < nrow ? r : 0] >> 3) * D); };
        auto bc = [&](int c) { return glu_col(j0, c); };
        auto ep = [&](int m, int n, f32x4 v) { if (m < nrow) { const int a = rowA[m]; uint2 w; w.x = cvtpk(v[0], v[1]); w.y = cvtpk(v[2], v[3]); *(uint2*)(ACT + (size_t)a * 256 + j0 + n) = w; } };
        mgemm_unit<true, true>((char*)sm, D, ar, p.egu + (size_t)e * D * 512, 512, bc, ep);
    }
}
__device__ __forceinline__ void ph_moe_down(const Params& p, float* sm, int bid, int nb) {
    int* pre = (int*)sm + 16384;
    const int ntile = moe_tile_prefix(p, pre);
    for (int u = bid; u < ntile * 8; u += nb) {
        const int tile = u >> 3, n0 = (u & 7) * 128;
        const int e = moe_find_expert(pre, tile), mt = tile - pre[e];
        int cnt = __hip_atomic_load(p.CNT + e, __ATOMIC_RELAXED, __HIP_MEMORY_SCOPE_AGENT); if (cnt > LISTCAP) cnt = LISTCAP;
        const int* lst = p.LIST + (size_t)e * LISTCAP + mt * 128;
        const int nrow = cnt - mt * 128;
        const bf16_t* ACT = p.ACT; bf16_t* Y = p.Y; const float* EW = p.EW;
        int* rowA = (int*)sm + 16384 + 512; float* rowW = (float*)sm + 16384 + 640;
        __syncthreads();
        if (threadIdx.x < 128) { const int a_ = lst[(int)threadIdx.x < nrow ? threadIdx.x : 0]; rowA[threadIdx.x] = a_; rowW[threadIdx.x] = EW[a_]; }
        auto ar = [&](int r) { return (const void*)(ACT + (size_t)lst[r < nrow ? r : 0] * 256); };
        auto bc = [&](int c) { return n0 + c; };
        auto ep = [&](int m, int n, f32x4 v) { if (m < nrow) { const int a = rowA[m]; const float w = rowW[m]; uint2 o; o.x = cvtpk(v[0] * w, v[1] * w); o.y = cvtpk(v[2] * w, v[3] * w); *(uint2*)(Y + (size_t)a * D + n0 + n) = o; } };
        mgemm_unit<true, false>((char*)sm, 256, ar, p.edown + (size_t)e * 256 * D, D, bc, ep);
    }
}
__device__ __forceinline__ void ph_shared_gu(const Params& p, float* sm, int bid, int nb) {
    const bf16_t* X1 = p.X1b; bf16_t* ACTS = p.ACTS;
    XCD_TILE_LOOP(T / 128, 4) {
        const int m0 = tm_ * 128, j0 = tn_ * 64;
        auto ar = [&](int r) { return (const void*)(X1 + (size_t)(m0 + r) * D); };
        auto bc = [&](int c) { return glu_col(j0, c); };
        auto ep = [&](int m, int n, f32x4 v) { uint2 w; w.x = cvtpk(v[0], v[1]); w.y = cvtpk(v[2], v[3]); *(uint2*)(ACTS + (size_t)(m0 + m) * 256 + j0 + n) = w; };
        mgemm_unit<false, true>((char*)sm, D, ar, p.SGUb, 512, bc, ep);
    }
}
__device__ __forceinline__ void ph_shared_down(const Params& p, float* sm, int bid, int nb) {
    const bf16_t* ACTS = p.ACTS; float* SH = p.SH;
    XCD_TILE_LOOP(T / 128, 8) {
        const int m0 = tm_ * 128, n0 = tn_ * 128;
        auto ar = [&](int r) { return (const void*)(ACTS + (size_t)(m0 + r) * 256); };
        auto bc = [&](int c) { return n0 + c; };
        auto ep = [&](int m, int n, f32x4 v) { *(f32x4*)(SH + (size_t)(m0 + m) * D + n0 + n) = v; };
        mgemm_unit<false, false>((char*)sm, 256, ar, p.SDOWNb, D, bc, ep);
    }
}
__device__ __forceinline__ void ph_final(const Params& p, float* sm, int bid, int nb) {
    const int tid = threadIdx.x, wave = tid >> 6, lane = tid & 63;
    for (int t = bid; t < T; t += nb) {
        const float4 xv = *(const float4*)(p.X1 + (size_t)t * D + tid * 4);
        float4 v = *(const float4*)(p.SH + (size_t)t * D + tid * 4);
        float4 r = make_float4(0.f, 0.f, 0.f, 0.f);
#pragma unroll
        for (int k = 0; k < 8; ++k) { const uint2 y = *(const uint2*)(p.Y + ((size_t)t * 8 + k) * D + tid * 4); r.x += bf2f(y.x & 0xffff); r.y += bf2f(y.x >> 16); r.z += bf2f(y.y & 0xffff); r.w += bf2f(y.y >> 16); }
        v.x = ALPHA * xv.x + (r.x + v.x); v.y = ALPHA * xv.y + (r.y + v.y); v.z = ALPHA * xv.z + (r.z + v.z); v.w = ALPHA * xv.w + (r.w + v.w);
        float s = (v.x + v.y) + (v.z + v.w);
        s = wave_sum(s);
        __syncthreads();
        if (lane == 0) sm[wave] = s;
        __syncthreads();
        const float mean = (sm[0] + sm[1] + sm[2] + sm[3]) * (1.0f / D);
        const float dx = v.x - mean, dy = v.y - mean, dz = v.z - mean, dw = v.w - mean;
        float q = (dx * dx + dy * dy) + (dz * dz + dw * dw);
        q = wave_sum(q);
        __syncthreads();
        if (lane == 0) sm[wave] = q;
        __syncthreads();
        const float rstd = rsqrtf((sm[0] + sm[1] + sm[2] + sm[3]) * (1.0f / D) + 1e-5f);
        const float4 gq = *(const float4*)(p.ln2g + tid * 4), bq = *(const float4*)(p.ln2b + tid * 4);
        *(float4*)(p.out + (size_t)t * D + tid * 4) = make_float4(dx * rstd * gq.x + bq.x, dy * rstd * gq.y + bq.y, dz * rstd * gq.z + bq.z, dw * rstd * gq.w + bq.w);
    }
}

constexpr int SM_FLOATS = 16384 + 768 + 4;

#define DEF_KERNEL(name) \
    __global__ void __launch_bounds__(NT) k_##name(Params p) { __shared__ __attribute__((aligned(16))) float sm[SM_FLOATS]; ph_##name(p, sm, (int)blockIdx.x, (int)gridDim.x); }


#define XB_TMO      128
#define XB_XCNT(j)  (256  + 64 * (j))
#define XB_XSUB(j)  (1280 + 64 * (j))
#define XB_XGEN(j)  (2304 + 64 * (j))
#define XB_TOP      3328
#define XB_TOPGEN   3392
#define XCD_BAR_WORDS 3456
#define XB_SPIN_CAP (1u << 18)
__device__ __forceinline__ unsigned xb_ld(unsigned* p)              { return __hip_atomic_load(p, __ATOMIC_RELAXED, __HIP_MEMORY_SCOPE_AGENT); }
__device__ __forceinline__ unsigned xb_add(unsigned* p, unsigned v) { return __hip_atomic_fetch_add(p, v, __ATOMIC_RELAXED, __HIP_MEMORY_SCOPE_AGENT); }
__device__ __forceinline__ unsigned xb_xcc_id() { return (unsigned)__builtin_amdgcn_s_getreg((3 << 11) | 20) & 0xFu; }
#define XB_SPIN(cond, bar) do { unsigned _sp = 0; while (cond) { __builtin_amdgcn_s_sleep(1); \
    if ((++_sp & 255u) == 0u) { if (xb_ld(&(bar)[XB_TMO])) break; if (_sp > XB_SPIN_CAP) { atomicAdd(&(bar)[XB_TMO], 1u); break; } } } } while (0)
struct XcdBarrier { unsigned* bar; unsigned x; volatile LAS unsigned* st; };
__device__ __forceinline__ XcdBarrier xcd_barrier_post(unsigned* bar, volatile LAS unsigned* st) {
    XcdBarrier b; b.bar = bar; b.x = xb_xcc_id(); b.st = st;
    if (threadIdx.x == 0) (void)xb_add(&bar[XB_XCNT(b.x)], 1u);
    return b;
}
__device__ __forceinline__ void xcd_barrier_complete(unsigned* bar, unsigned x, unsigned& nloc, unsigned& nx) {
    const unsigned G = gridDim.x * gridDim.y * gridDim.z;
    unsigned sum, cnt, mine, sp = 0u;
    for (;;) {
        sum = 0u; cnt = 0u; mine = 0u;
#pragma unroll
        for (unsigned j = 0; j < 16; ++j) { const unsigned c = xb_ld(&bar[XB_XCNT(j)]); sum += c; cnt += (c > 0u) ? 1u : 0u; mine = (j == x) ? c : mine; }
        if (sum == G) break;
        __builtin_amdgcn_s_sleep(1);
        if ((++sp & 255u) == 0u) { if (xb_ld(&bar[XB_TMO])) break; if (sp > XB_SPIN_CAP) { atomicAdd(&bar[XB_TMO], 1u); break; } }
    }
    nloc = mine > 0u ? mine : 1u; nx = cnt > 0u ? cnt : 1u;
}
__device__ __forceinline__ void xcd_barrier(const XcdBarrier& b) {
    asm volatile("s_waitcnt vmcnt(0)" ::: "memory");
    __syncthreads();
    if (threadIdx.x == 0) {
        unsigned* bar = b.bar;
        __builtin_amdgcn_s_waitcnt(0);
        unsigned nloc = b.st[0], nx = b.st[1];
        if (nloc == 0u) { xcd_barrier_complete(bar, b.x, nloc, nx); b.st[0] = nloc; b.st[1] = nx; }
        const unsigned old = xb_add(&bar[XB_XSUB(b.x)], 1u);
        const unsigned gen = old / nloc;
        if (old + 1u == (gen + 1u) * nloc) {
            __builtin_amdgcn_fence(__ATOMIC_RELEASE, "agent");
            asm volatile("s_waitcnt vmcnt(0)" ::: "memory");
            const unsigned og = xb_add(&bar[XB_TOP], 1u);
            const unsigned tg = og / nx;
            if (og + 1u == (tg + 1u) * nx) xb_add(&bar[XB_TOPGEN], 1u);
            else XB_SPIN(xb_ld(&bar[XB_TOPGEN]) == tg, bar);
            __builtin_amdgcn_fence(__ATOMIC_ACQUIRE, "agent");
            xb_add(&bar[XB_XGEN(b.x)], 1u);
            asm volatile("s_waitcnt vmcnt(0)" ::: "memory");
        } else {
            XB_SPIN(xb_ld(&bar[XB_XGEN(b.x)]) == gen, bar);
            __builtin_amdgcn_fence(__ATOMIC_ACQUIRE, "agent");
            asm volatile("s_waitcnt vmcnt(0)" ::: "memory");
        }
    }
    __syncthreads();
}

namespace cg = cooperative_groups;
__global__ void __launch_bounds__(NT, 2) mega(Params p) {
    __shared__ __attribute__((aligned(16))) float sm[SM_FLOATS];
    unsigned* bar_st = (unsigned*)(sm + SM_FLOATS - 4);
    cg::grid_group grid = cg::this_grid();
    if (threadIdx.x < 4) bar_st[threadIdx.x] = 0u;
    __syncthreads();
    const XcdBarrier xbar = xcd_barrier_post(p.BAR, (volatile LAS unsigned*)bar_st);
#define GSYNC() xcd_barrier(xbar)
    const int bid = (int)blockIdx.x, nb = (int)gridDim.x;
#ifndef PROBE_REP
#define PROBE_REP 0
#endif
#define GROUP(k, ...) { __VA_ARGS__ } if (PROBE_REP == (k)) { __VA_ARGS__ }
    GROUP(1, ph_cvt_x(p, sm, bid, nb); grid.sync(); ph_inproj(p, sm, bid, nb); GSYNC();)
    GROUP(2, ph_prep(p, sm, bid, nb); GSYNC();
             ph_prep_gemm(p, sm, bid, nb); GSYNC();
             ph_cmp2(p, sm, bid, nb); ph_scan_pre(p, sm, bid, nb); GSYNC();
             ph_cmp_rope(p, sm, bid, nb); GSYNC();)
    GROUP(3, if (bid < 16) { __builtin_amdgcn_s_setprio(3); ph_scan_seq(p, sm, bid, 16); __builtin_amdgcn_s_setprio(0); } else if (bid < 256 || bid >= 272) ph_nsa_fast(p, sm, bid - 16, nb - 16);
             GSYNC();)
    GROUP(4, ph_rwkv_post(p, sm, bid, nb); GSYNC();
             ph_branch_a(p, sm, bid, nb); ph_branch_b(p, sm, bid, nb); GSYNC();
             ph_outproj(p, sm, bid, nb); GSYNC();
             ph_ln1(p, sm, bid, nb); GSYNC();)
    GROUP(5, ph_router_gemm(p, sm, bid, nb); ph_shared_gu(p, sm, bid, nb); GSYNC();
             ph_router_sel(p, sm, bid, nb); ph_shared_down(p, sm, bid, nb); GSYNC();)
    GROUP(6, ph_moe_gu(p, sm, bid, nb); GSYNC();
             ph_moe_down(p, sm, bid, nb); GSYNC();)
    ph_final(p, sm, bid, nb);
}
}

extern "C" void kernel_launch(void* const* d_in, const int* in_sizes, int n_in, void* d_out, int out_size, void* d_ws, size_t ws_size, hipStream_t stream) {
    Params p{};
    const float* const* in = (const float* const*)d_in;
    p.x = in[0]; p.w_in = in[1]; p.mu = in[2]; p.w0 = in[3]; p.w2 = in[4]; p.a0 = in[5]; p.a2 = in[6]; p.g2 = in[7]; p.k_k = in[8]; p.k_a = in[9];
    p.r_k = in[10]; p.lnx_w = in[11]; p.lnx_b = in[12]; p.pe_k = in[13]; p.w1_k = in[14]; p.w2_k = in[15]; p.pe_v = in[16]; p.w1_v = in[17]; p.w2_v = in[18];
    p.wba = in[19]; p.wbb = in[20]; p.wout = in[21]; p.ln1g = in[22]; p.ln1b = in[23]; p.rw = in[24]; p.rbias = in[25]; p.egu = in[26]; p.edown = in[27];
    p.sgu = in[28]; p.sdown = in[29]; p.ln2g = in[30]; p.ln2b = in[31];
    p.out = (float*)d_out;
    char* w = (char*)d_ws; size_t off = 0;
    auto carve = [&](size_t bytes) { char* r = w + off; off += (bytes + 255) & ~(size_t)255; return r; };
    p.BAR = (unsigned*)carve(16384);
    p.P = (unsigned short*)carve((size_t)T * INW * 2);
    p.R = (float*)carve((size_t)T * 512 * 4); p.DC = (float*)carve((size_t)T * 512 * 4); p.K2 = (float*)carve((size_t)T * 512 * 4); p.V = (float*)carve((size_t)T * 512 * 4);
    p.KK = (float*)carve((size_t)T * 512 * 4); p.BB = (float*)carve((size_t)T * 512 * 4); p.G = (float*)carve((size_t)T * 512 * 4);
    p.O = (float*)carve((size_t)T * 512 * 4); p.YA = (float*)carve((size_t)T * 512 * 4);
    p.KCraw = (float*)carve((size_t)NCROWS * 64 * 4); p.KCR = (float*)carve((size_t)NCROWS * 64 * 4); p.VC = (float*)carve((size_t)NCROWS * 64 * 4);
    p.Z = (float*)carve((size_t)T * D * 4); p.PRE1 = (float*)carve((size_t)T * D * 4); p.X1 = (float*)carve((size_t)T * D * 4);
    p.LOGITS = (float*)carve((size_t)T * NE * 4); p.EW = (float*)carve((size_t)T * 8 * 4); p.EIDX = (int*)carve((size_t)T * 8 * 4);
    p.LIST = (int*)carve((size_t)NE * LISTCAP * 4); p.CNT = (int*)((char*)d_ws + 14336);
    p.Xb = (unsigned short*)carve((size_t)T * D * 2); p.YAb = (unsigned short*)carve((size_t)T * 512 * 2); p.YBb = (unsigned short*)carve((size_t)T * 512 * 2);
    p.Zb = (unsigned short*)carve((size_t)T * D * 2); p.X1b = (unsigned short*)carve((size_t)T * D * 2);
    p.Qb = (unsigned short*)carve((size_t)T * 512 * 2); p.KSb = (unsigned short*)carve((size_t)T * 128 * 2); p.VSb = (unsigned short*)carve((size_t)T * 128 * 2);
    p.KWb = (unsigned short*)carve((size_t)T * 128 * 2); p.VWb = (unsigned short*)carve((size_t)T * 128 * 2);
    p.KCb = (unsigned short*)carve((size_t)4 * 512 * 64 * 2); p.VCb = (unsigned short*)carve((size_t)4 * 512 * 64 * 2);
    p.GT = (float*)carve((size_t)T * 24 * 4);
    p.WINb = (unsigned short*)carve((size_t)D * INW * 2); p.WBAb = (unsigned short*)carve((size_t)512 * D * 2); p.WBBb = (unsigned short*)carve((size_t)512 * D * 2);
    p.WOUTb = (unsigned short*)carve((size_t)D * D * 2); p.RWb = (unsigned short*)carve((size_t)D * NE * 2); p.SGUb = (unsigned short*)carve((size_t)D * 512 * 2); p.SDOWNb = (unsigned short*)carve((size_t)256 * D * 2);
    p.W1Kb = (unsigned short*)carve((size_t)2048 * 256 * 2); p.W1Vb = (unsigned short*)carve((size_t)2048 * 256 * 2); p.W2Kb = (unsigned short*)carve((size_t)256 * 64 * 2); p.W2Vb = (unsigned short*)carve((size_t)256 * 64 * 2);
    p.LW2b = (unsigned short*)carve((size_t)64 * 512 * 2); p.LA2b = (unsigned short*)carve((size_t)64 * 512 * 2); p.LG2b = (unsigned short*)carve((size_t)128 * 512 * 2);
    p.LORA = (unsigned short*)carve((size_t)T * 256 * 2); p.KCin = (unsigned short*)carve((size_t)4 * S * 64 * 2 + 4096); p.VCin = (unsigned short*)carve((size_t)4 * S * 64 * 2 + 4096);
    p.H1Kb = (unsigned short*)carve((size_t)NCROWS * 256 * 2); p.H1Vb = (unsigned short*)carve((size_t)NCROWS * 256 * 2);
    p.TABC = (float*)carve((size_t)S * 32 * 4); p.TABS = (float*)carve((size_t)S * 32 * 4); p.CB = (float*)carve(2 * 32 * 256 * 4); p.KSH = (float*)carve((size_t)T * 512 * 4);
    p.SCANI = (char*)carve((size_t)8192 * SCI_BYTES);
    p.Rb = (unsigned short*)carve((size_t)T * 512 * 2); p.Vb = (unsigned short*)carve((size_t)T * 512 * 2); p.KSHb = (unsigned short*)carve((size_t)T * 512 * 2); p.KKb = (unsigned short*)carve((size_t)T * 512 * 2);
    p.EWXb = (unsigned short*)carve((size_t)T * 512 * 2); p.K2b = (unsigned short*)carve((size_t)T * 512 * 2); p.BBb = (unsigned short*)carve((size_t)T * 512 * 2); p.Gb = (unsigned short*)carve((size_t)T * 512 * 2);
    p.ACTS = (unsigned short*)carve((size_t)T * 256 * 2); p.SH = (float*)carve((size_t)T * D * 4);
    p.ACT = (unsigned short*)carve((size_t)T * 8 * 256 * 2);
    p.Y = (unsigned short*)carve((size_t)T * 8 * D * 2);
    if (off > ws_size) { fprintf(stderr, "kernel_launch: workspace too small: need %zu have %zu\n", off, ws_size); return; }
    static int grid_blocks = 0;
    if (!grid_blocks) {
        int dev = 0, cus = 0, per_cu = 0;
        hipGetDevice(&dev);
        hipDeviceGetAttribute(&cus, hipDeviceAttributeMultiprocessorCount, dev);
        hipOccupancyMaxActiveBlocksPerMultiprocessor(&per_cu, mega, NT, 0);
        if (per_cu > 2) per_cu = 2;
        if (per_cu < 1) per_cu = 1;
        grid_blocks = cus * per_cu;
    }
    hipMemsetAsync(d_ws, 0, 16384, stream);
    void* args[] = {&p};
    hipError_t e = hipLaunchCooperativeKernel((void*)mega, dim3(grid_blocks), dim3(NT), args, 0, stream);
    if (e != hipSuccess) fprintf(stderr, "cooperative launch failed: %s (grid %d)\n", hipGetErrorString(e), grid_blocks);
}
```
